# Optimizing an MI355X kernel written in HIP

```python
import jax, jax.numpy as jnp
from jax import lax
import numpy as np

D_MODEL = 1024
BATCH = 16
SEQ = 2048
DEPTH = 2

CTX_LEN = 256
GRID_W = 64
ROPE_BASE = 10000.0
NORM_EPS = 1e-6
LN_EPS = 1e-5
NEG_INF = -1e30
N_MOD = 9
FFN_RES = 0.5
D_FF = 2816

A_HEADS = 8
A_KV_HEADS = 2
A_HEAD_DIM = 64
A_WINDOW = 128
A_BLOCK = 128
B_CH = 512
B_KERNEL = 31
A_Q_W = A_HEADS * A_HEAD_DIM
A_KV_W = A_KV_HEADS * A_HEAD_DIM
AB_IN_W = A_Q_W + 2 * A_KV_W + 2 * B_CH
AB_OUT_W = A_Q_W + B_CH

C_HEADS = 8
C_Q_LORA = 256
C_KV_LORA = 256
C_NOPE = 128
C_ROPE = 64
C_V = 128
C_BLOCK = 128

kernel_name = "hybrid_prefix_dit_macaron_block"


def rms_norm(x, g):
    xf = x.astype(jnp.float32)
    y = xf * lax.rsqrt(jnp.mean(xf * xf, axis=-1, keepdims=True) + NORM_EPS)
    return (y * g.astype(jnp.float32)).astype(x.dtype)


def layer_norm(x, g, b):
    xf = x.astype(jnp.float32)
    mu = jnp.mean(xf, axis=-1, keepdims=True)
    xc = xf - mu
    var = jnp.mean(xc * xc, axis=-1, keepdims=True)
    y = xc * lax.rsqrt(var + LN_EPS) * g.astype(jnp.float32) + b.astype(jnp.float32)
    return y.astype(x.dtype)


def modulate(xn, shift, scale):
    return xn * (1 + scale) + shift


def axial_rope_tables(rows, d_rot):
    t = jnp.arange(rows * GRID_W)
    row = (t // GRID_W).astype(jnp.float32)
    col = (t % GRID_W).astype(jnp.float32)
    d_axis = d_rot // 2
    inv_freq = ROPE_BASE ** (-jnp.arange(0, d_axis, 2, dtype=jnp.float32) / d_axis)
    ang_r = row[:, None] * inv_freq
    ang_c = col[:, None] * inv_freq
    ang = jnp.concatenate([ang_r, ang_r, ang_c, ang_c], axis=-1)
    return jnp.cos(ang), jnp.sin(ang)


def apply_rope(x, cos, sin):
    d = x.shape[-1]
    xr = x.reshape(x.shape[:-1] + (2, 2, d // 4))
    rot = jnp.stack([-xr[..., 1, :], xr[..., 0, :]], axis=-2).reshape(x.shape)
    cos = cos[:, None, :].astype(x.dtype)
    sin = sin[:, None, :].astype(x.dtype)
    return x * cos + rot * sin


def swiglu(h, w_in, w_out):
    g, u = jnp.split(h @ w_in, 2, axis=-1)
    return (jax.nn.silu(g) * u) @ w_out


def ffn_sublayer(x, g, shift, scale, gate, w_in, w_out):
    return x + FFN_RES * gate * swiglu(modulate(rms_norm(x, g), shift, scale), w_in, w_out)


def softmax_with_sink(s, sink):
    s_all = jnp.concatenate([s, jnp.broadcast_to(sink, s.shape[:-1] + (1,))], axis=-1)
    return jax.nn.softmax(s_all, axis=-1)[..., :-1]


def attend(q, k, v, ok, sink, scale):
    s = jnp.einsum('bqhgd,bkhd->bhgqk', q, k).astype(jnp.float32) * scale
    if ok is not None:
        s = jnp.where(ok, s, NEG_INF)
    if sink is not None:
        p = softmax_with_sink(s, sink[None, :, :, None, None])
    else:
        p = jax.nn.softmax(s, axis=-1)
    o = jnp.einsum('bhgqk,bkhd->bqhgd', p.astype(v.dtype), v)
    return o.reshape(o.shape[:2] + (-1,))


def window_gqa(q, k, v, kc, vc, sink, scale):
    B, S = q.shape[:2]
    nb = S // A_BLOCK
    L = kc.shape[1]
    pad = ((0, 0), (A_BLOCK, A_BLOCK), (0, 0), (0, 0))
    k_pad = jnp.pad(k, pad)
    v_pad = jnp.pad(v, pad)
    ctx_ok = jnp.ones((A_BLOCK, L), dtype=bool)

    def block(n):
        start = n * A_BLOCK
        q_n = lax.dynamic_slice_in_dim(q, start, A_BLOCK, axis=1)
        k_n = jnp.concatenate([lax.dynamic_slice_in_dim(k_pad, start, 3 * A_BLOCK, axis=1), kc], axis=1)
        v_n = jnp.concatenate([lax.dynamic_slice_in_dim(v_pad, start, 3 * A_BLOCK, axis=1), vc], axis=1)
        q_pos = start + jnp.arange(A_BLOCK)
        k_pos = start - A_BLOCK + jnp.arange(3 * A_BLOCK)
        near = ((jnp.abs(q_pos[:, None] - k_pos[None, :]) <= A_WINDOW)
                & (k_pos >= 0)[None, :] & (k_pos < S)[None, :])
        ok = jnp.concatenate([near, ctx_ok], axis=1)
        return attend(q_n, k_n, v_n, ok, sink, scale)

    o = lax.map(block, jnp.arange(nb))
    return jnp.moveaxis(o, 0, 1).reshape(B, S, -1)


def conformer_conv(u, w_dw, b_dw, ln_g, ln_b):
    a, g = jnp.split(u, 2, axis=-1)
    y = a * jax.nn.sigmoid(g)
    y = lax.conv_general_dilated(
        y, w_dw[:, None, :].astype(y.dtype), window_strides=(1,),
        padding=[(B_KERNEL // 2, B_KERNEL // 2)],
        dimension_numbers=('NWC', 'WIO', 'NWC'),
        feature_group_count=y.shape[-1]) + b_dw
    return jax.nn.silu(layer_norm(y, ln_g, ln_b))


def ab_mixer(xm, hm, w_in, sink, w_dw, b_dw, ln_g, ln_b, w_out, rope, ctx_out):
    B, S, _ = xm.shape
    L = hm.shape[1]
    G = A_HEADS // A_KV_HEADS
    sink = sink.astype(jnp.float32).reshape(A_KV_HEADS, G)
    scale = A_HEAD_DIM ** -0.5
    i_k = A_Q_W
    i_v = i_k + A_KV_W
    i_u = i_v + A_KV_W
    px = xm @ w_in
    ph = hm @ w_in
    qx = apply_rope(px[..., :i_k].reshape(B, S, A_HEADS, A_HEAD_DIM), *rope)
    qx = qx.reshape(B, S, A_KV_HEADS, G, A_HEAD_DIM)
    kx = apply_rope(px[..., i_k:i_v].reshape(B, S, A_KV_HEADS, A_HEAD_DIM), *rope)
    vx = px[..., i_v:i_u].reshape(B, S, A_KV_HEADS, A_HEAD_DIM)
    kh = ph[..., i_k:i_v].reshape(B, L, A_KV_HEADS, A_HEAD_DIM)
    vh = ph[..., i_v:i_u].reshape(B, L, A_KV_HEADS, A_HEAD_DIM)
    ax = window_gqa(qx, kx, vx, kh, vh, sink, scale)
    bx = conformer_conv(px[..., i_u:], w_dw, b_dw, ln_g, ln_b)
    ox = jnp.concatenate([ax, bx], axis=-1) @ w_out
    if not ctx_out:
        return ox, None
    qh = ph[..., :i_k].reshape(B, L, A_KV_HEADS, G, A_HEAD_DIM)
    ah = attend(qh, kh, vh, None, sink, scale)
    bh = conformer_conv(ph[..., i_u:], w_dw, b_dw, ln_g, ln_b)
    oh = jnp.concatenate([ah, bh], axis=-1) @ w_out
    return ox, oh


def mla_q(h, w_dq, g_q, w_uq, rope):
    B, N, _ = h.shape
    cq = rms_norm(h @ w_dq, g_q)
    q = (cq @ w_uq).reshape(B, N, C_HEADS, C_NOPE + C_ROPE)
    q_nope, q_rope = q[..., :C_NOPE], q[..., C_NOPE:]
    if rope is not None:
        q_rope = apply_rope(q_rope, *rope)
    return jnp.concatenate([q_nope, q_rope], axis=-1)


def mla_kv(h, w_dkv, g_kv, w_uk, w_uv, rope):
    B, N, _ = h.shape
    ckv_kr = h @ w_dkv
    ckv = rms_norm(ckv_kr[..., :C_KV_LORA], g_kv)
    k_rope = ckv_kr[..., C_KV_LORA:][:, :, None, :]
    if rope is not None:
        k_rope = apply_rope(k_rope, *rope)
    k_nope = (ckv @ w_uk).reshape(B, N, C_HEADS, C_NOPE)
    v = (ckv @ w_uv).reshape(B, N, C_HEADS, C_V)
    k = jnp.concatenate([k_nope, jnp.broadcast_to(k_rope, (B, N, C_HEADS, C_ROPE))], axis=-1)
    return k, v


def mla_mixer(xm, hm, w_dq, g_q, w_uq, w_dkv, g_kv, w_uk, w_uv, w_o, rope, ctx_out):
    B, S, _ = xm.shape
    nb = S // C_BLOCK
    scale = (C_NOPE + C_ROPE) ** -0.5
    qx = mla_q(xm, w_dq, g_q, w_uq, rope)
    kx, vx = mla_kv(xm, w_dkv, g_kv, w_uk, w_uv, rope)
    kh, vh = mla_kv(hm, w_dkv, g_kv, w_uk, w_uv, None)
    k_all = jnp.concatenate([kx, kh], axis=1)
    v_all = jnp.concatenate([vx, vh], axis=1)

    def block(n):
        q_n = lax.dynamic_slice_in_dim(qx, n * C_BLOCK, C_BLOCK, axis=1)[:, :, :, None, :]
        return attend(q_n, k_all, v_all, None, None, scale)

    o = lax.map(block, jnp.arange(nb))
    ox = jnp.moveaxis(o, 0, 1).reshape(B, S, -1) @ w_o
    if not ctx_out:
        return ox, None
    qh = mla_q(hm, w_dq, g_q, w_uq, None)
    oh = attend(qh[:, :, :, None, :], kh, vh, None, None, scale) @ w_o
    return ox, oh


def setup_inputs(seed: int = 0) -> dict:
    key = jax.random.key(seed)
    ks = jax.random.split(key, 32)
    f32 = jnp.float32
    n_even = (DEPTH + 1) // 2
    n_odd = DEPTH // 2

    def w(k, shape, fan_in, gain=1.0):
        return jax.random.normal(k, shape, f32) * (gain * fan_in ** -0.5)

    def ones_noise(k, shape):
        return 1.0 + 0.02 * jax.random.normal(k, shape, f32)

    def small(k, shape):
        return 0.02 * jax.random.normal(k, shape, f32)

    return {
        "x": jax.random.normal(ks[0], (BATCH, SEQ, D_MODEL), f32),
        "c": jax.random.normal(ks[1], (BATCH, D_MODEL), f32),
        "ctx": jax.random.normal(ks[2], (BATCH, CTX_LEN, D_MODEL), f32),
        "c_ctx": jax.random.normal(ks[3], (D_MODEL,), f32),
        "w_mod": w(ks[4], (DEPTH, D_MODEL, N_MOD * D_MODEL), D_MODEL, 0.5),
        "b_mod": small(ks[5], (DEPTH, N_MOD * D_MODEL)),
        "g_norm": ones_noise(ks[6], (DEPTH, 3, D_MODEL)),
        "ffn_w_in": w(ks[7], (DEPTH, 2, D_MODEL, 2 * D_FF), D_MODEL),
        "ffn_w_out": w(ks[8], (DEPTH, 2, D_FF, D_MODEL), D_FF),
        "ab_w_in": w(ks[9], (n_even, D_MODEL, AB_IN_W), D_MODEL),
        "a_sink": 0.5 * jax.random.normal(ks[10], (n_even, A_HEADS), f32),
        "b_w_dw": w(ks[11], (n_even, B_KERNEL, B_CH), B_KERNEL),
        "b_b_dw": small(ks[12], (n_even, B_CH)),
        "b_ln_g": ones_noise(ks[13], (n_even, B_CH)),
        "b_ln_b": small(ks[14], (n_even, B_CH)),
        "ab_w_out": w(ks[15], (n_even, AB_OUT_W, D_MODEL), AB_OUT_W),
        "c_w_dq": w(ks[16], (n_odd, D_MODEL, C_Q_LORA), D_MODEL),
        "c_g_q": ones_noise(ks[17], (n_odd, C_Q_LORA)),
        "c_w_uq": w(ks[18], (n_odd, C_Q_LORA, C_HEADS * (C_NOPE + C_ROPE)), C_Q_LORA),
        "c_w_dkv": w(ks[19], (n_odd, D_MODEL, C_KV_LORA + C_ROPE), D_MODEL),
        "c_g_kv": ones_noise(ks[20], (n_odd, C_KV_LORA)),
        "c_w_uk": w(ks[21], (n_odd, C_KV_LORA, C_HEADS * C_NOPE), C_KV_LORA),
        "c_w_uv": w(ks[22], (n_odd, C_KV_LORA, C_HEADS * C_V), C_KV_LORA),
        "c_w_o": w(ks[23], (n_odd, C_HEADS * C_V, D_MODEL), C_HEADS * C_V),
        "g_final": ones_noise(ks[24], (D_MODEL,)),
    }


def reference(x, c, ctx, c_ctx, w_mod, b_mod, g_norm, ffn_w_in, ffn_w_out,
              ab_w_in, a_sink, b_w_dw, b_b_dw, b_ln_g, b_ln_b, ab_w_out,
              c_w_dq, c_g_q, c_w_uq, c_w_dkv, c_g_kv, c_w_uk, c_w_uv, c_w_o, g_final):
    rows = x.shape[1] // GRID_W
    rope_a = axial_rope_tables(rows, A_HEAD_DIM)
    rope_c = axial_rope_tables(rows, C_ROPE)
    silu_c = jax.nn.silu(c)
    silu_cc = jax.nn.silu(c_ctx)
    h = ctx
    for i in range(DEPTH):
        last = i == DEPTH - 1
        j = i // 2
        mx = jnp.split((silu_c @ w_mod[i] + b_mod[i])[:, None, :], N_MOD, axis=-1)
        mc = jnp.split((silu_cc @ w_mod[i] + b_mod[i])[None, None, :], N_MOD, axis=-1)
        x = ffn_sublayer(x, g_norm[i, 0], mx[0], mx[1], mx[2], ffn_w_in[i, 0], ffn_w_out[i, 0])
        h = ffn_sublayer(h, g_norm[i, 0], mc[0], mc[1], mc[2], ffn_w_in[i, 0], ffn_w_out[i, 0])
        xm = modulate(rms_norm(x, g_norm[i, 1]), mx[3], mx[4])
        hm = modulate(rms_norm(h, g_norm[i, 1]), mc[3], mc[4])
        if i % 2 == 0:
            ox, oh = ab_mixer(xm, hm, ab_w_in[j], a_sink[j], b_w_dw[j], b_b_dw[j],
                              b_ln_g[j], b_ln_b[j], ab_w_out[j], rope_a, not last)
        else:
            ox, oh = mla_mixer(xm, hm, c_w_dq[j], c_g_q[j], c_w_uq[j], c_w_dkv[j], c_g_kv[j],
                               c_w_uk[j], c_w_uv[j], c_w_o[j], rope_c, not last)
        x = x + mx[5] * ox
        x = ffn_sublayer(x, g_norm[i, 2], mx[6], mx[7], mx[8], ffn_w_in[i, 1], ffn_w_out[i, 1])
        if not last:
            h = h + mc[5] * oh
            h = ffn_sublayer(h, g_norm[i, 2], mc[6], mc[7], mc[8], ffn_w_in[i, 1], ffn_w_out[i, 1])
    return rms_norm(x, g_final)
```

```cpp
#include <hip/hip_runtime.h>
#include <hip/hip_cooperative_groups.h>
#include <cstdio>
#include <cstdint>
namespace cg = cooperative_groups;

#define LAS __attribute__((address_space(3)))
#define DI __device__ __forceinline__
typedef unsigned short bf16_t;
typedef short bf16x8 __attribute__((ext_vector_type(8)));
typedef short s16x4 __attribute__((ext_vector_type(4)));
typedef float f32x4 __attribute__((ext_vector_type(4)));
typedef float f32x16 __attribute__((ext_vector_type(16)));
typedef unsigned u32x4 __attribute__((ext_vector_type(4)));
typedef unsigned u32x2 __attribute__((ext_vector_type(2)));

constexpr int D_MODEL = 1024, BATCH = 16, SEQ = 2048, CTX = 256, D_FF = 2816;
constexpr int MX = BATCH * SEQ;
constexpr int MH = BATCH * CTX;
constexpr int MT = MX + MH;
constexpr int NMOD = 9 * D_MODEL;
constexpr float LOG2E = 1.4426950408889634f;

constexpr size_t MiB = 1u << 20;
constexpr size_t WS_ROPE = 0;
constexpr size_t WS_MOD = 512 * 1024;
constexpr size_t WS_BAR = 1792 * 1024;
constexpr size_t WS_W = 2 * MiB;
constexpr size_t W_IN_BYTES = (size_t)2 * D_FF * D_MODEL * 2;
constexpr size_t W_OUT_BYTES = (size_t)D_MODEL * D_FF * 2;
constexpr size_t WS_WIN = WS_W;
constexpr size_t WS_WOUT = WS_WIN + 4 * W_IN_BYTES;
constexpr size_t WS_WABIN = WS_WOUT + 4 * W_OUT_BYTES;
constexpr size_t WS_WABOUT = WS_WABIN + (size_t)1792 * 1024 * 2;
constexpr size_t WS_WD = WS_WABOUT + (size_t)1024 * 1024 * 2;
constexpr size_t WS_WUQ = WS_WD + (size_t)768 * 1024 * 2;
constexpr size_t WS_WUKV = WS_WUQ + (size_t)1536 * 256 * 2;
constexpr size_t WS_WO = WS_WUKV + (size_t)2048 * 256 * 2;
constexpr size_t WS_WEND = WS_WO + (size_t)1024 * 1536 * 2;
static_assert(WS_WEND <= 80 * MiB, "weights");
constexpr size_t WS_XS = 80 * MiB;
constexpr size_t WS_R = 224 * MiB;
constexpr size_t WS_END = 512 * MiB;
constexpr size_t R_XN = 0;
constexpr size_t R_ACT = 72 * MiB;
constexpr size_t R_PART = 270 * MiB;
constexpr size_t R_CAT = 0;
constexpr size_t R_Q = 72 * MiB;
constexpr size_t R_KV = 108 * MiB;
constexpr size_t R_Y = 126 * MiB;
constexpr size_t R_KN = 0;
constexpr int LDD = 576;
constexpr size_t R_D = 72 * MiB;
constexpr size_t R_Q2 = 113 * MiB;
constexpr size_t R_V = 209 * MiB;
static_assert(R_V + 72 * MiB <= 288 * MiB && R_ACT + 198 * MiB <= 288 * MiB, "R map");

#ifndef PROBE
#define PROBE 0
#endif
constexpr int LDS_BYTES = 135168;

typedef float f32x2c __attribute__((ext_vector_type(2))); typedef __bf16 bf16x2c __attribute__((ext_vector_type(2)));
DI unsigned cvt_pk_bf16(float lo, float hi) { const f32x2c v = {lo, hi}; const bf16x2c b = __builtin_convertvector(v, bf16x2c); return __builtin_bit_cast(unsigned, b); }
DI float bf2f(bf16_t v) { return __uint_as_float((unsigned)v << 16); }
DI float fast_exp2(float x) { return __builtin_amdgcn_exp2f(x); }
DI float fast_rcp(float x) { return __builtin_amdgcn_rcpf(x); }
DI float sigmoid_f(float x) { return fast_rcp(1.f + fast_exp2(-x * LOG2E)); }
DI float wave_sum(float v) {
#pragma unroll
    for (int o = 1; o < 64; o <<= 1) v += __shfl_xor(v, o);
    return v;
}
typedef _Float16 h16x2 __attribute__((ext_vector_type(2)));
DI unsigned cvt_pk_f16(float lo, float hi) { const h16x2 v = {(_Float16)lo, (_Float16)hi}; return __builtin_bit_cast(unsigned, v); }
DI void unpack8h(const u32x4 w, f32x4& a, f32x4& b) {
    const unsigned w0 = w[0], w1 = w[1], w2 = w[2], w3 = w[3];
    const h16x2 p0 = __builtin_bit_cast(h16x2, w0), p1 = __builtin_bit_cast(h16x2, w1), p2 = __builtin_bit_cast(h16x2, w2), p3 = __builtin_bit_cast(h16x2, w3);
    a = (f32x4){(float)p0[0], (float)p0[1], (float)p1[0], (float)p1[1]}; b = (f32x4){(float)p2[0], (float)p2[1], (float)p3[0], (float)p3[1]};
}
DI u32x4 pack8h(const f32x4 a, const f32x4 b) { u32x4 o; o.x = cvt_pk_f16(a[0], a[1]); o.y = cvt_pk_f16(a[2], a[3]); o.z = cvt_pk_f16(b[0], b[1]); o.w = cvt_pk_f16(b[2], b[3]); return o; }
typedef float f32x2 __attribute__((ext_vector_type(2)));
DI float max3f(float a, float b, float c) { return __builtin_fmaxf(__builtin_fmaxf(a, b), c); }
DI u32x2 pack4(f32x4 v) { u32x2 w; w.x = cvt_pk_bf16(v[0], v[1]); w.y = cvt_pk_bf16(v[2], v[3]); return w; }

namespace pg8 {
constexpr int BM = 256, BK = 64, HALF = 128, HTB = HALF * BK * 2, STAGE_BYTES = 8 * HTB, NXCD = 8, WGM = 8;
DI int lds_byte(int r, int c) { const int st = (r >> 4) * 2 + (c >> 5), rr = r & 15, cc = c & 31, ob = rr * 64 + cc * 2; return st * 1024 + (ob ^ (((ob >> 9) & 1) << 5)); }
DI void stage_rc(int b, int& R, int& C) { const int st = b / 1024, sb = b % 1024, swz = sb ^ (((sb >> 9) & 1) << 5); R = (st >> 1) * 16 + swz / 64; C = (st & 1) * 32 + (swz % 64) / 2; }
DI int perm32(int rho) { const int n = rho >> 4, i = rho & 15; return 8 * (i >> 2) + 4 * n + (i & 3); }

struct Unit { int pm, pn, k0, nk; };
struct Gemm { const bf16_t* A; const bf16_t* Bt; int M, N, K, lda, ldb; };

struct StaticOrder {
    int nM, nN, nwg, G, c;
    int ntk;
    DI void init(int M, int N, int K, int G_, int c_) { nM = M / BM; nN = N / BM; nwg = nM * nN; G = G_; c = c_; ntk = K / BK; }
    DI Unit get(int i, bool& ok) const { return at((long)i * G + c, ok); }
    DI Unit at(long L, bool& ok) const {
        Unit u; u.pm = 0; u.pn = 0; u.k0 = 0; u.nk = ntk; ok = L < nwg; if (!ok) return u;
        int wgid = (int)L; { const int q = nwg / NXCD, r = nwg % NXCD, xcd = wgid % NXCD, off = wgid / NXCD; wgid = (xcd < r ? xcd * (q + 1) : r * (q + 1) + (xcd - r) * q) + off; }
        const int nig = WGM * nN, gid = wgid / nig, fm = gid * WGM, gsz = (nM - fm) < WGM ? (nM - fm) : WGM;
        u.pm = fm + ((wgid % nig) % gsz); u.pn = (wgid % nig) / gsz; return u;
    }
};
struct SplitOrder {
    StaticOrder full; int G, c, ntk;
    DI void init(int N, int K, int G_, int c_) { full.init(MX, N, K, G_, c_); G = G_; c = c_; ntk = K / BK; }
    DI Unit get(int i, bool& ok) const {
        const long L = (long)i * G + c;
        if (L < full.nwg) return full.at(L, ok);
        const int q = (int)(L - full.nwg); ok = q < 128;
        Unit u; u.pm = MX / BM + (q >> 3); u.pn = (q >> 1) & 3; const int part = q & 1;
        u.nk = ntk / 2; u.k0 = part * u.nk;
        return u;
    }
};

template <class Epi, class Sched>
DI void gemm_phase(LAS unsigned char* lds, const Gemm g, const Sched& S, const Epi& E) {
    int tid = threadIdx.x; asm volatile("" : "+v"(tid));
    const int wid = __builtin_amdgcn_readfirstlane(tid >> 6), lane = tid & 63, wr = wid >> 2, wc = wid & 3, fr = lane & 15, fq = lane >> 4;
    unsigned voffA[2], voffB[2];
#pragma unroll
    for (int i = 0; i < 2; ++i) { int R, C; stage_rc(tid * 16 + i * 8192, R, C); const int Rb = Epi::PERM ? ((R & ~31) + perm32(R & 31)) : R;
        voffA[i] = (unsigned)(R * g.lda + C) * 2u; voffB[i] = (unsigned)(Rb * g.ldb + C) * 2u; }
    const size_t kstep = (size_t)(BK * 2);
    const size_t hstepA = (size_t)HALF * g.lda * 2, hstepB = (size_t)HALF * g.ldb * 2;
    const size_t tstepA = 2 * hstepA, tstepB = 2 * hstepB;
    const unsigned ldsw = (unsigned)wid * 1024u;
    const int aoff = lds_byte(wr * 64 + fr, fq * 8), boff = lds_byte(wc * 32 + fr, fq * 8);
#define PG8_SA(b, h) (((b) * 2 + (h)) * HTB)
#define PG8_SB(b, h) ((4 + (b) * 2 + (h)) * HTB)
#define PG8_STAGE(bufoff, gbase, voff) do { _Pragma("unroll") for (int _i = 0; _i < 2; ++_i) \
        __builtin_amdgcn_global_load_lds((const unsigned*)((const char*)(gbase) + (voff)[_i]), (LAS unsigned*)(lds + (bufoff) + ldsw + _i * 8192), 16, 0, 0); } while (0)
#define PG8_LDA(dst, b, h) do { _Pragma("unroll") for (int m = 0; m < 4; ++m) _Pragma("unroll") for (int k = 0; k < 2; ++k) dst[m][k] = *(const LAS bf16x8*)(lds + PG8_SA(b, h) + aoff + m * 2048 + k * 1024); } while (0)
#define PG8_LDB(dst, b, h) do { _Pragma("unroll") for (int n = 0; n < 2; ++n) _Pragma("unroll") for (int k = 0; k < 2; ++k) dst[n][k] = *(const LAS bf16x8*)(lds + PG8_SB(b, h) + boff + n * 2048 + k * 1024); } while (0)
#define PG8_MMA(ai, bj, At, Bt) do { __builtin_amdgcn_s_setprio(1); _Pragma("unroll") for (int m = 0; m < 4; ++m) _Pragma("unroll") for (int n = 0; n < 2; ++n) _Pragma("unroll") for (int k = 0; k < 2; ++k) \
        acc[ai][bj][m][n] = __builtin_amdgcn_mfma_f32_16x16x32_bf16(Bt[n][k], At[m][k], acc[ai][bj][m][n], 0, 0, 0); __builtin_amdgcn_s_setprio(0); } while (0)
#define PG8_WAIT_V(n) asm volatile("s_waitcnt vmcnt(" #n ")" ::: "memory")
#define PG8_WAIT_L(n) asm volatile("s_waitcnt lgkmcnt(" #n ")" ::: "memory")
#define PG8_BAR __builtin_amdgcn_s_barrier()
#define PG8_SCHED __builtin_amdgcn_sched_barrier(0)
    int ui = 0; bool ok0;
    Unit cur = S.get(0, ok0), nxt = cur;
    if (!ok0) return;
    f32x4 acc[2][2][4][2];
#pragma unroll
    for (int a = 0; a < 2; ++a)
#pragma unroll
        for (int b = 0; b < 2; ++b)
#pragma unroll
            for (int m = 0; m < 4; ++m)
#pragma unroll
                for (int n = 0; n < 2; ++n) acc[a][b][m][n] = (f32x4){0.f, 0.f, 0.f, 0.f};
    bf16x8 At[4][2], B0[2][2], B1[2][2];
    const char* cA = (const char*)g.A + (size_t)cur.pm * tstepA + (size_t)cur.k0 * kstep; const char* cB = (const char*)g.Bt + (size_t)cur.pn * tstepB + (size_t)cur.k0 * kstep;
    PG8_STAGE(PG8_SB(0, 0), cB, voffB); PG8_STAGE(PG8_SB(0, 1), cB + hstepB, voffB); PG8_STAGE(PG8_SA(0, 0), cA, voffA); PG8_STAGE(PG8_SA(0, 1), cA + hstepA, voffA);
    if (wr == 1) PG8_BAR;
    PG8_WAIT_V(2); PG8_BAR;
    PG8_STAGE(PG8_SB(1, 0), cB + kstep, voffB); PG8_STAGE(PG8_SA(1, 0), cA + kstep, voffA); PG8_STAGE(PG8_SB(1, 1), cB + hstepB + kstep, voffB);
    PG8_WAIT_V(6); PG8_BAR;
    for (;;) {
        bool has_next; nxt = S.get(ui + 1, has_next);
        const char* nA = has_next ? (const char*)g.A + (size_t)nxt.pm * tstepA + (size_t)nxt.k0 * kstep : cA; const char* nB = has_next ? (const char*)g.Bt + (size_t)nxt.pn * tstepB + (size_t)nxt.k0 * kstep : cB;
        const int nt = cur.nk;
        for (int t = 0; t < nt; t += 2) {
            const bool last = (t == nt - 2);
            const char* a1 = cA + (size_t)(t + 1) * kstep;
            const char* a2 = last ? nA : cA + (size_t)(t + 2) * kstep; const char* b2 = last ? nB : cB + (size_t)(t + 2) * kstep;
            const char* a3 = a2 + kstep; const char* b3 = b2 + kstep;
            PG8_LDB(B0, 0, 0); PG8_LDB(B1, 0, 1); PG8_SCHED; PG8_LDA(At, 0, 0); PG8_STAGE(PG8_SA(1, 1), a1 + hstepA, voffA);
            PG8_WAIT_V(8); PG8_WAIT_L(0); PG8_BAR; PG8_MMA(0, 0, At, B0); PG8_MMA(0, 1, At, B1); PG8_BAR; PG8_SCHED;
            PG8_LDA(At, 0, 1); PG8_STAGE(PG8_SB(0, 0), b2, voffB); PG8_STAGE(PG8_SB(0, 1), b2 + hstepB, voffB); PG8_STAGE(PG8_SA(0, 0), a2, voffA);
            PG8_WAIT_V(8); PG8_WAIT_L(0); PG8_BAR; PG8_MMA(1, 0, At, B0); PG8_MMA(1, 1, At, B1); PG8_BAR; PG8_SCHED;
            PG8_LDB(B0, 1, 0); PG8_LDB(B1, 1, 1); PG8_SCHED; PG8_LDA(At, 1, 0); PG8_STAGE(PG8_SA(0, 1), a2 + hstepA, voffA);
            PG8_WAIT_V(8); PG8_WAIT_L(0); PG8_BAR; PG8_MMA(0, 0, At, B0); PG8_MMA(0, 1, At, B1); PG8_BAR; PG8_SCHED;
            PG8_LDA(At, 1, 1); PG8_STAGE(PG8_SB(1, 0), b3, voffB); PG8_STAGE(PG8_SB(1, 1), b3 + hstepB, voffB); PG8_STAGE(PG8_SA(1, 0), a3, voffA);
            PG8_WAIT_V(8); PG8_WAIT_L(0); PG8_BAR; PG8_MMA(1, 0, At, B0); PG8_MMA(1, 1, At, B1); PG8_BAR; PG8_SCHED;
        }
        if (wr == 0) PG8_BAR;
        E(acc, cur, wr, wc, fr, fq);
        if (!has_next) break;
#pragma unroll
        for (int a = 0; a < 2; ++a)
#pragma unroll
            for (int b = 0; b < 2; ++b)
#pragma unroll
                for (int m = 0; m < 4; ++m)
#pragma unroll
                    for (int n = 0; n < 2; ++n) acc[a][b][m][n] = (f32x4){0.f, 0.f, 0.f, 0.f};
        cur = nxt; cA = nA; cB = nB; ++ui;
        if (wr == 1) PG8_BAR;
    }
    PG8_WAIT_V(0);
    PG8_BAR;
#undef PG8_SA
#undef PG8_SB
#undef PG8_STAGE
#undef PG8_LDA
#undef PG8_LDB
#undef PG8_MMA
#undef PG8_WAIT_V
#undef PG8_WAIT_L
#undef PG8_BAR
#undef PG8_SCHED
}

typedef f32x4 Acc[2][2][4][2];

struct EpiPlain {
    static constexpr bool PERM = true;
    bf16_t* O0; bf16_t* O1; int split_tile; int ldc; int ncols_valid;
    DI void operator()(const Acc& acc, const Unit& u, int wr, int wc, int fr, int fq) const {
        asm volatile("" : "+v"(fr), "+v"(fq));
        const int row0 = u.pm * BM + wr * 64 + fr;
        bf16_t* base = O0; int colt = u.pn * BM; if (u.pn >= split_tile) { base = O1; colt -= split_tile * BM; }
        const int col0 = colt + wc * 32 + 8 * fq;
#pragma unroll
        for (int ai = 0; ai < 2; ++ai)
#pragma unroll
            for (int m = 0; m < 4; ++m) { bf16_t* rowp = base + (size_t)(row0 + ai * HALF + m * 16) * ldc + col0;
#pragma unroll
                for (int bj = 0; bj < 2; ++bj) { if (col0 + bj * HALF < ncols_valid) { const f32x4 v0 = acc[ai][bj][m][0], v1 = acc[ai][bj][m][1]; u32x4 w;
                    w.x = cvt_pk_bf16(v0[0], v0[1]); w.y = cvt_pk_bf16(v0[2], v0[3]); w.z = cvt_pk_bf16(v1[0], v1[1]); w.w = cvt_pk_bf16(v1[2], v1[3]);
                    *(u32x4*)(rowp + bj * HALF) = w; } } }
    }
};
struct EpiSwiglu {
    static constexpr bool PERM = true;
    bf16_t* O; int ldc;
    DI void operator()(const Acc& acc, const Unit& u, int wr, int wc, int fr, int fq) const {
        asm volatile("" : "+v"(fr), "+v"(fq));
        const int row0 = u.pm * BM + wr * 64 + fr; const int col0 = u.pn * HALF + wc * 32 + 8 * fq;
#pragma unroll
        for (int ai = 0; ai < 2; ++ai)
#pragma unroll
            for (int m = 0; m < 4; ++m) { bf16_t* rowp = O + (size_t)(row0 + ai * HALF + m * 16) * ldc + col0; float v[8];
#pragma unroll
                for (int n = 0; n < 2; ++n)
#pragma unroll
                    for (int j = 0; j < 4; ++j) { const float gg = acc[ai][0][m][n][j], uu = acc[ai][1][m][n][j]; v[n * 4 + j] = gg * sigmoid_f(gg) * uu; }
                u32x4 w; w.x = cvt_pk_bf16(v[0], v[1]); w.y = cvt_pk_bf16(v[2], v[3]); w.z = cvt_pk_bf16(v[4], v[5]); w.w = cvt_pk_bf16(v[6], v[7]);
                *(u32x4*)rowp = w; }
    }
};
template <bool BASEF32>
struct EpiResid {
    static constexpr bool PERM = true;
    const void* base_x; const void* base_h;
    bf16_t* out; const float* gate;
    float* part; float coef; int pad_;
    DI void operator()(const Acc& acc, const Unit& u, int wr, int wc, int fr, int fq) const {
        asm volatile("" : "+v"(fr), "+v"(fq));
        const int col0 = u.pn * BM + wc * 32 + 8 * fq;
        const int midx = u.pm < (MX / BM) ? (u.pm >> 3) : 16;
        const float* gp = gate + (size_t)midx * NMOD + col0;
        f32x4 gv[2][2];
#pragma unroll
        for (int bj = 0; bj < 2; ++bj)
#pragma unroll
            for (int n = 0; n < 2; ++n) gv[bj][n] = *(const f32x4*)(gp + bj * HALF + n * 4) * coef;
        if (u.k0 != 0) {
            float* pbase = part + (size_t)(u.pm - MX / BM) * BM * D_MODEL;
#pragma unroll
            for (int ai = 0; ai < 2; ++ai)
#pragma unroll
                for (int m = 0; m < 4; ++m) { const size_t off = (size_t)(ai * HALF + wr * 64 + m * 16 + fr) * D_MODEL + col0;
#pragma unroll
                    for (int bj = 0; bj < 2; ++bj)
#pragma unroll
                        for (int n = 0; n < 2; ++n) *(f32x4*)(pbase + off + bj * HALF + n * 4) = gv[bj][n] * acc[ai][bj][m][n]; }
            return;
        }
        const size_t tile_off = u.pm < (MX / BM) ? (size_t)u.pm * BM * D_MODEL : (size_t)(u.pm - MX / BM) * BM * D_MODEL;
        const void* bsel = u.pm < (MX / BM) ? base_x : base_h;
        bf16_t* obase = out + (size_t)u.pm * BM * D_MODEL;
        const size_t off0 = (size_t)(wr * 64 + fr) * D_MODEL + col0;
        if (BASEF32) {
#pragma unroll
            for (int ai = 0; ai < 2; ++ai) { f32x4 bb[4][2][2];
#pragma unroll
                for (int m = 0; m < 4; ++m)
#pragma unroll
                    for (int bj = 0; bj < 2; ++bj) { const float* bp = (const float*)bsel + tile_off + off0 + (size_t)(ai * HALF + m * 16) * D_MODEL + bj * HALF; bb[m][bj][0] = *(const f32x4*)bp; bb[m][bj][1] = *(const f32x4*)(bp + 4); }
#pragma unroll
                for (int m = 0; m < 4; ++m)
#pragma unroll
                    for (int bj = 0; bj < 2; ++bj) { const f32x4 x0 = bb[m][bj][0] + gv[bj][0] * acc[ai][bj][m][0], x1 = bb[m][bj][1] + gv[bj][1] * acc[ai][bj][m][1];
                        *(u32x4*)(obase + off0 + (size_t)(ai * HALF + m * 16) * D_MODEL + bj * HALF) = pack8h(x0, x1); } }
        } else {
            u32x4 bb[2][4][2];
#pragma unroll
            for (int ai = 0; ai < 2; ++ai)
#pragma unroll
                for (int m = 0; m < 4; ++m)
#pragma unroll
                    for (int bj = 0; bj < 2; ++bj) bb[ai][m][bj] = *(const u32x4*)((const bf16_t*)bsel + tile_off + off0 + (size_t)(ai * HALF + m * 16) * D_MODEL + bj * HALF);
#pragma unroll
            for (int ai = 0; ai < 2; ++ai)
#pragma unroll
                for (int m = 0; m < 4; ++m)
#pragma unroll
                    for (int bj = 0; bj < 2; ++bj) { f32x4 b0, b1; unpack8h(bb[ai][m][bj], b0, b1);
                        const f32x4 x0 = b0 + gv[bj][0] * acc[ai][bj][m][0], x1 = b1 + gv[bj][1] * acc[ai][bj][m][1];
                        *(u32x4*)(obase + off0 + (size_t)(ai * HALF + m * 16) * D_MODEL + bj * HALF) = pack8h(x0, x1); }
        }
    }
};
DI void rope4(f32x4& x0, f32x4& x1, const float* rt) {
    const f32x4 A = *(const f32x4*)rt, B = *(const f32x4*)(rt + 4);
    const f32x4 c = {A[0], A[2], B[0], B[2]}, s = {A[1], A[3], B[1], B[3]};
    const f32x4 n0 = x0 * c - x1 * s, n1 = x1 * c + x0 * s; x0 = n0; x1 = n1;
}
struct EpiABIn {
    static constexpr bool PERM = false;
    bf16_t* Q; bf16_t* KV; bf16_t* Y; const float* rope; float qscale;
    DI void operator()(const Acc& acc, const Unit& u, int wr, int wc, int fr, int fq) const {
        asm volatile("" : "+v"(fr), "+v"(fq));
        const int rowt = u.pm * BM + wr * 64 + fr; const bool is_x = u.pm < (MX / BM);
        if (u.pn >= 3) {
            const int col0 = (u.pn - 3) * HALF + wc * 32 + 4 * fq;
#pragma unroll
            for (int ai = 0; ai < 2; ++ai)
#pragma unroll
                for (int m = 0; m < 4; ++m) { bf16_t* rowp = Y + (size_t)(rowt + ai * HALF + m * 16) * 512 + col0;
#pragma unroll
                    for (int n = 0; n < 2; ++n) { f32x4 v;
#pragma unroll
                        for (int j = 0; j < 4; ++j) v[j] = acc[ai][0][m][n][j] * sigmoid_f(acc[ai][1][m][n][j]);
                        *(u32x2*)(rowp + n * 16) = pack4(v); } }
        } else {
            const int a = wc & 1;
#pragma unroll
            for (int ai = 0; ai < 2; ++ai)
#pragma unroll
                for (int m = 0; m < 4; ++m) { const int row = rowt + ai * HALF + m * 16; const float* rt = rope + (size_t)(row & (SEQ - 1)) * 64 + (a * 16 + 4 * fq) * 2;
#pragma unroll
                    for (int bj = 0; bj < 2; ++bj) { f32x4 x0 = acc[ai][bj][m][0], x1 = acc[ai][bj][m][1];
                        const bool do_rope = is_x && !(u.pn == 2 && bj == 1);
                        if (do_rope) rope4(x0, x1, rt);
                        bf16_t* p;
                        if (u.pn < 2) { x0 = x0 * qscale; x1 = x1 * qscale; p = Q + (size_t)row * 512 + u.pn * BM + bj * HALF + wc * 32 + 4 * fq; }
                        else p = KV + (size_t)row * 256 + bj * HALF + wc * 32 + 4 * fq;
                        *(u32x2*)p = pack4(x0); *(u32x2*)(p + 16) = pack4(x1); } }
        }
    }
};
struct EpiUq {
    static constexpr bool PERM = false;
    bf16_t* Q; const float* rope; float qscale;
    DI void operator()(const Acc& acc, const Unit& u, int wr, int wc, int fr, int fq) const {
        asm volatile("" : "+v"(fr), "+v"(fq));
        const int rowt = u.pm * BM + wr * 64 + fr;
#pragma unroll
        for (int ai = 0; ai < 2; ++ai)
#pragma unroll
            for (int m = 0; m < 4; ++m) { const int row = rowt + ai * HALF + m * 16;
#pragma unroll
                for (int bj = 0; bj < 2; ++bj) { const int blk = u.pn * 8 + bj * 4 + wc, bh = blk % 6;
                    f32x4 x0 = acc[ai][bj][m][0], x1 = acc[ai][bj][m][1];
                    if (bh >= 4) rope4(x0, x1, rope + (size_t)(row & (SEQ - 1)) * 64 + ((bh - 4) * 16 + 4 * fq) * 2);
                    x0 = x0 * qscale; x1 = x1 * qscale;
                    bf16_t* p = Q + (size_t)row * 1536 + blk * 32 + 4 * fq;
                    *(u32x2*)p = pack4(x0); *(u32x2*)(p + 16) = pack4(x1); } }
    }
};
}

struct AttnU {
    const bf16_t* Q; int ldq;
    const bf16_t* K1; int ldk1;
    const bf16_t* K2; int ldk2;
    const bf16_t* V; int ldv;
    bf16_t* O; int ldo;
    int nt_lat, lat_row0, kpos0, nt_ctx, ctx_row0, qpos0;
    float m0, l0;
};
#define MFMA32(a, b, c) __builtin_amdgcn_mfma_f32_32x32x16_bf16((a), (b), (c), 0, 0, 0)
typedef short v4i16_t __attribute__((ext_vector_type(4)));
DI s16x4 vtr(const LAS unsigned char* p) { return __builtin_bit_cast(s16x4, __builtin_amdgcn_ds_read_tr16_b64_v4i16((LAS v4i16_t*)p)); }
template <int DQK, int NK1, int DV, bool WINDOW, int DUMMY = 0>
DI void attn_unit(LAS unsigned char* lds, const AttnU& a) {
    constexpr int KSB = (DQK + 8) * 2, VROW = DV * 2 + 64, K_BYTES = 64 * KSB, BUF_BYTES = K_BYTES + 64 * VROW;
    constexpr int C1 = NK1 / 8, C2 = (DQK - NK1) / 8, CV = DV / 8;
    constexpr int L1 = C1 / 8, L2 = C2 / 8, LV = CV / 8, NKK = DQK / 16, NDB = DV / 32;
    int tid = threadIdx.x; asm volatile("" : "+v"(tid));
    const int lane = tid & 63, wid = __builtin_amdgcn_readfirstlane(tid >> 6), r = lane & 31, h = lane >> 5;
    bf16x8 qf[NKK];
    { const bf16_t* qrow = a.Q + (size_t)(wid * 32 + r) * a.ldq + 8 * h;
#pragma unroll
      for (int kk = 0; kk < NKK; ++kk) qf[kk] = *(const bf16x8*)(qrow + 16 * kk); }
    f32x16 o[NDB];
#pragma unroll
    for (int d = 0; d < NDB; ++d)
#pragma unroll
        for (int i = 0; i < 16; ++i) o[d][i] = 0.f;
    float m = a.m0, l = (h == 0) ? a.l0 : 0.f;
    const int nt = a.nt_lat + a.nt_ctx;
    u32x4 k1reg[L1 > 0 ? L1 : 1], k2reg[L2 > 0 ? L2 : 1], vreg[LV];
#define ATT_LOAD(j) do { const int grow_ = ((j) < a.nt_lat ? a.lat_row0 + 64 * (j) : a.ctx_row0 + 64 * ((j) - a.nt_lat)); \
        _Pragma("unroll") for (int i_ = 0; i_ < L1; ++i_) { const int x_ = tid + 512 * i_; k1reg[i_] = *(const u32x4*)(a.K1 + (size_t)(grow_ + x_ / C1) * a.ldk1 + (x_ % C1) * 8); } \
        _Pragma("unroll") for (int i_ = 0; i_ < L2; ++i_) { const int x_ = tid + 512 * i_; k2reg[i_] = *(const u32x4*)(a.K2 + (size_t)(grow_ + x_ / (C2 > 0 ? C2 : 1)) * a.ldk2 + (x_ % (C2 > 0 ? C2 : 1)) * 8); } \
        _Pragma("unroll") for (int i_ = 0; i_ < LV; ++i_) { const int x_ = tid + 512 * i_; vreg[i_] = *(const u32x4*)(a.V + (size_t)(grow_ + x_ / CV) * a.ldv + (x_ % CV) * 8); } } while (0)
#define ATT_STORE(buf) do { LAS unsigned char* Kw_ = lds + (buf) * BUF_BYTES; LAS unsigned char* Vw_ = Kw_ + K_BYTES; \
        _Pragma("unroll") for (int i_ = 0; i_ < L1; ++i_) { const int x_ = tid + 512 * i_; *(LAS u32x4*)(Kw_ + (x_ / C1) * KSB + (x_ % C1) * 16) = k1reg[i_]; } \
        _Pragma("unroll") for (int i_ = 0; i_ < L2; ++i_) { const int x_ = tid + 512 * i_; *(LAS u32x4*)(Kw_ + (x_ / (C2 > 0 ? C2 : 1)) * KSB + (C1 + x_ % (C2 > 0 ? C2 : 1)) * 16) = k2reg[i_]; } \
        _Pragma("unroll") for (int i_ = 0; i_ < LV; ++i_) { const int x_ = tid + 512 * i_; *(LAS u32x4*)(Vw_ + (x_ / CV) * VROW + (x_ % CV) * 16) = vreg[i_]; } } while (0)
    if (wid >= 4) __builtin_amdgcn_s_setprio(1);
    ATT_LOAD(0);
    __syncthreads();
    ATT_STORE(0);
    if (nt > 1) ATT_LOAD(1);
    __syncthreads();
    const int qp = a.qpos0 + wid * 32 + r;
    const int voff = (4 * h + ((lane & 15) >> 2)) * VROW + (16 * ((lane >> 4) & 1) + 4 * (lane & 3)) * 2;
    for (int j = 0; j < nt; ++j) {
        const int cur = j & 1;
        LAS unsigned char* Ks = lds + cur * BUF_BYTES; LAS unsigned char* Vs = Ks + K_BYTES + voff;
        bool active = true;
        const bool lat = j < a.nt_lat;
        if (WINDOW && lat) { const int kt = a.kpos0 + 64 * j, qw = a.qpos0 + wid * 32; active = (kt <= qw + 31 + 128) && (kt + 63 >= qw - 128); }
        if (active && DUMMY != 4) {
            f32x16 p0, p1;
#pragma unroll
            for (int i = 0; i < 16; ++i) { p0[i] = 0.f; p1[i] = 0.f; }
            {
                constexpr int KB = 2, NB = NKK / KB;
                bf16x8 ka[2][KB][2];
#pragma unroll
                for (int q = 0; q < KB; ++q) { ka[0][q][0] = *(const LAS bf16x8*)(Ks + r * KSB + q * 32 + h * 16); ka[0][q][1] = *(const LAS bf16x8*)(Ks + (32 + r) * KSB + q * 32 + h * 16); }
#pragma unroll
                for (int b = 0; b < NB; ++b) {
                    if (b + 1 < NB) {
#pragma unroll
                        for (int q = 0; q < KB; ++q) { const int kk = (b + 1) * KB + q;
                            ka[(b + 1) & 1][q][0] = *(const LAS bf16x8*)(Ks + r * KSB + kk * 32 + h * 16); ka[(b + 1) & 1][q][1] = *(const LAS bf16x8*)(Ks + (32 + r) * KSB + kk * 32 + h * 16); }
                    }
                    __builtin_amdgcn_sched_barrier(0);
#pragma unroll
                    for (int q = 0; q < KB; ++q) { p0 = MFMA32(ka[b & 1][q][0], qf[b * KB + q], p0); p1 = MFMA32(ka[b & 1][q][1], qf[b * KB + q], p1); }
                    __builtin_amdgcn_sched_barrier(0);
                }
            }
            constexpr int NDH = 1;
            s16x4 vlo[NDB][4], vhi[NDB][4];
            if (DUMMY != 2) {
#pragma unroll
            for (int d = 0; d < NDH; ++d)
#pragma unroll
                for (int s2 = 0; s2 < 4; ++s2) { vlo[d][s2] = vtr(Vs + (16 * s2) * VROW + 64 * d); vhi[d][s2] = vtr(Vs + (16 * s2 + 8) * VROW + 64 * d); }
            }
            __builtin_amdgcn_sched_barrier(0);
            if (WINDOW && lat) { const int kb = a.kpos0 + 64 * j + 4 * h;
#pragma unroll
                for (int i = 0; i < 16; ++i) { const int d0 = qp - (kb + (i & 3) + 8 * (i >> 2)); const int d1 = d0 - 32;
                    if (d0 > 128 || d0 < -128) p0[i] = -1e30f; if (d1 > 128 || d1 < -128) p1[i] = -1e30f; } }
            float mxa = max3f(p0[0], p0[1], p1[0]), mxb = max3f(p0[2], p0[3], p1[1]); mxa = max3f(mxa, p1[2], p1[3]);
#pragma unroll
            for (int i = 4; i < 16; i += 4) { mxa = max3f(mxa, p0[i], p0[i + 1]); mxb = max3f(mxb, p0[i + 2], p0[i + 3]); mxa = max3f(mxa, p1[i], p1[i + 1]); mxb = max3f(mxb, p1[i + 2], p1[i + 3]); }
            float mx = fmaxf(mxa, mxb);
            { const auto rr = __builtin_amdgcn_permlane32_swap(__float_as_uint(mx), __float_as_uint(mx), false, false); mx = fmaxf(__uint_as_float(rr[0]), __uint_as_float(rr[1])); }
            if (__any(mx > m + 8.f)) {
                const float mn = fmaxf(m, mx), alpha = fast_exp2(m - mn); m = mn; l *= alpha;
#pragma unroll
                for (int d = 0; d < NDB; ++d)
#pragma unroll
                    for (int i = 0; i < 16; ++i) o[d][i] *= alpha;
            }
            float sum = 0.f;
            if (DUMMY != 3) {
#pragma unroll
            for (int i = 0; i < 16; ++i) { p0[i] = fast_exp2(p0[i] - m); p1[i] = fast_exp2(p1[i] - m); }
            { f32x2 sa = {p0[0], p0[1]}, sb = {p1[0], p1[1]};
#pragma unroll
              for (int i = 2; i < 16; i += 2) { sa += (f32x2){p0[i], p0[i + 1]}; sb += (f32x2){p1[i], p1[i + 1]}; }
              sa += sb; sum = sa[0] + sa[1]; }
            } else sum = 1.f;
            l += sum;
            bf16x8 pb[4];
#pragma unroll
            for (int s = 0; s < 4; ++s) { u32x4 w;
#pragma unroll
                for (int q2 = 0; q2 < 4; ++q2) { const int i = 8 * (s & 1) + 2 * q2; w[q2] = (s < 2) ? cvt_pk_bf16(p0[i], p0[i + 1]) : cvt_pk_bf16(p1[i], p1[i + 1]); }
                pb[s] = __builtin_bit_cast(bf16x8, w); }
            __builtin_amdgcn_sched_barrier(0);
            if (DUMMY == 2) { o[0][0] += __builtin_bit_cast(float, (int)pb[0][0] | ((int)pb[1][1] << 8) | ((int)pb[2][2] << 16) ^ (int)pb[3][3]); }
            else
#pragma unroll
            for (int d = 0; d < NDB; ++d) {
                if (d + 1 < NDB) {
#pragma unroll
                    for (int s2 = 0; s2 < 4; ++s2) { vlo[d + 1][s2] = vtr(Vs + (16 * s2) * VROW + 64 * (d + 1)); vhi[d + 1][s2] = vtr(Vs + (16 * s2 + 8) * VROW + 64 * (d + 1)); }
                }
                __builtin_amdgcn_sched_barrier(0);
#pragma unroll
                for (int s2 = 0; s2 < 4; ++s2) { const bf16x8 av = __builtin_shufflevector(vlo[d][s2], vhi[d][s2], 0, 1, 2, 3, 4, 5, 6, 7); o[d] = MFMA32(av, pb[s2], o[d]); }
                __builtin_amdgcn_sched_barrier(0);
            }
        }
        if (j + 1 < nt) ATT_STORE(cur ^ 1);
        __syncthreads();
        if (j + 2 < nt) ATT_LOAD(j + 2);
    }
#undef ATT_LOAD
#undef ATT_STORE
    __builtin_amdgcn_s_setprio(0);
    { const auto rr = __builtin_amdgcn_permlane32_swap(__float_as_uint(l), __float_as_uint(l), false, false); l = __uint_as_float(rr[0]) + __uint_as_float(rr[1]); }
    const float inv = 1.f / l;
    bf16_t* orow = a.O + (size_t)(wid * 32 + r) * a.ldo;
#pragma unroll
    for (int d = 0; d < NDB; ++d)
#pragma unroll
        for (int g = 0; g < 4; ++g) { f32x4 v = {o[d][4 * g] * inv, o[d][4 * g + 1] * inv, o[d][4 * g + 2] * inv, o[d][4 * g + 3] * inv};
            if (!DUMMY || inv < 0.f) *(u32x2*)(orow + 32 * d + 8 * g + 4 * h) = pack4(v); }
}

DI void conv_unit(LAS unsigned char* lds, const bf16_t* Y, int row_base, int seqlen, int t0, const float* wdw, const float* bdw, const float* lng, const float* lnb, bf16_t* out) {
    int c = threadIdx.x; asm volatile("" : "+v"(c));
    const int lane = c & 63, wid = c >> 6;
    float in[62];
#pragma unroll
    for (int i = 0; i < 62; ++i) { const int t = t0 - 15 + i; in[i] = (t >= 0 && t < seqlen) ? bf2f(Y[(size_t)(row_base + t) * 512 + c]) : 0.f; }
    float w[31];
#pragma unroll
    for (int j = 0; j < 31; ++j) w[j] = wdw[j * 512 + c];
    const float bias = bdw[c];
    LAS float* buf = (LAS float*)lds;
    __syncthreads();
#pragma unroll
    for (int t = 0; t < 32; ++t) { float acc = bias;
#pragma unroll
        for (int j = 0; j < 31; ++j) acc += w[j] * in[t + j];
        buf[t * 516 + c] = acc; }
    __syncthreads();
#pragma unroll
    for (int tt = 0; tt < 4; ++tt) { const int t = wid * 4 + tt;
        const f32x4 v0 = *(const LAS f32x4*)(buf + t * 516 + lane * 8), v1 = *(const LAS f32x4*)(buf + t * 516 + lane * 8 + 4);
        const float mean = wave_sum((v0[0] + v0[1]) + (v0[2] + v0[3]) + (v1[0] + v1[1]) + (v1[2] + v1[3])) * (1.f / 512.f);
        const f32x4 d0 = v0 - mean, d1 = v1 - mean;
        const float var = wave_sum((d0[0] * d0[0] + d0[1] * d0[1]) + (d0[2] * d0[2] + d0[3] * d0[3]) + (d1[0] * d1[0] + d1[1] * d1[1]) + (d1[2] * d1[2] + d1[3] * d1[3])) * (1.f / 512.f);
        const float rstd = 1.f / sqrtf(var + 1e-5f);
        const f32x4 g0 = *(const f32x4*)(lng + lane * 8), g1 = *(const f32x4*)(lng + lane * 8 + 4), b0 = *(const f32x4*)(lnb + lane * 8), b1 = *(const f32x4*)(lnb + lane * 8 + 4);
        f32x4 y0 = d0 * rstd * g0 + b0, y1 = d1 * rstd * g1 + b1;
#pragma unroll
        for (int j = 0; j < 4; ++j) { y0[j] = y0[j] * sigmoid_f(y0[j]); y1[j] = y1[j] * sigmoid_f(y1[j]); }
        u32x4 wv; wv.x = cvt_pk_bf16(y0[0], y0[1]); wv.y = cvt_pk_bf16(y0[2], y0[3]); wv.z = cvt_pk_bf16(y1[0], y1[1]); wv.w = cvt_pk_bf16(y1[2], y1[3]);
        *(u32x4*)(out + (size_t)(row_base + t0 + t) * 1024 + 512 + lane * 8) = wv; }
}


#define XB_TMO      128
#define XB_XCNT(j)  (256  + 64 * (j))
#define XB_XSUB(j)  (1280 + 64 * (j))
#define XB_XGEN(j)  (2304 + 64 * (j))
#define XB_TOP      3328
#define XB_TOPGEN   3392
#define XCD_BAR_WORDS 3456
#define XB_SPIN_CAP (1u << 22)
DI unsigned xb_ld(unsigned* p)              { return __hip_atomic_load(p, __ATOMIC_RELAXED, __HIP_MEMORY_SCOPE_AGENT); }
DI unsigned xb_add(unsigned* p, unsigned v) { return __hip_atomic_fetch_add(p, v, __ATOMIC_RELAXED, __HIP_MEMORY_SCOPE_AGENT); }
DI unsigned xb_xcc_id() { return (unsigned)__builtin_amdgcn_s_getreg((3 << 11) | 20) & 0xFu; }
#define XB_SPIN(cond, bar) do { unsigned _sp = 0; while (cond) { __builtin_amdgcn_s_sleep(1); \
    if ((++_sp & 255u) == 0u) { if (xb_ld(&(bar)[XB_TMO])) break; if (_sp > XB_SPIN_CAP) { atomicAdd(&(bar)[XB_TMO], 1u); break; } } } } while (0)
struct XcdBarrier { unsigned* bar; unsigned x; volatile LAS unsigned* st; };
DI XcdBarrier xcd_barrier_post(unsigned* bar, volatile LAS unsigned* st) {
    XcdBarrier b; b.bar = bar; b.x = xb_xcc_id(); b.st = st;
    if (threadIdx.x == 0) (void)xb_add(&bar[XB_XCNT(b.x)], 1u);
    return b;
}
DI void xcd_barrier_complete(unsigned* bar, unsigned x, unsigned& nloc, unsigned& nx) {
    const unsigned G = gridDim.x * gridDim.y * gridDim.z;
    unsigned sum, cnt, mine, sp = 0u;
    for (;;) {
        sum = 0u; cnt = 0u; mine = 0u;
#pragma unroll
        for (unsigned j = 0; j < 16; ++j) { const unsigned c = xb_ld(&bar[XB_XCNT(j)]); sum += c; cnt += (c > 0u) ? 1u : 0u; mine = (j == x) ? c : mine; }
        if (sum == G) break;
        __builtin_amdgcn_s_sleep(1);
        if ((++sp & 255u) == 0u) { if (xb_ld(&bar[XB_TMO])) break; if (sp > XB_SPIN_CAP) { atomicAdd(&bar[XB_TMO], 1u); break; } }
    }
    nloc = mine > 0u ? mine : 1u; nx = cnt > 0u ? cnt : 1u;
}
DI void xcd_barrier(const XcdBarrier& b) {
    asm volatile("s_waitcnt vmcnt(0)" ::: "memory");
    __syncthreads();
    if (threadIdx.x == 0) {
        unsigned* bar = b.bar;
        __builtin_amdgcn_s_waitcnt(0);
        unsigned nloc = b.st[0], nx = b.st[1];
        if (nloc == 0u) { xcd_barrier_complete(bar, b.x, nloc, nx); b.st[0] = nloc; b.st[1] = nx; }
        const unsigned old = xb_add(&bar[XB_XSUB(b.x)], 1u);
        const unsigned gen = old / nloc;
        if (old + 1u == (gen + 1u) * nloc) {
            __builtin_amdgcn_fence(__ATOMIC_RELEASE, "agent");
            asm volatile("s_waitcnt vmcnt(0)" ::: "memory");
            const unsigned og = xb_add(&bar[XB_TOP], 1u);
            const unsigned tg = og / nx;
            if (og + 1u == (tg + 1u) * nx) xb_add(&bar[XB_TOPGEN], 1u);
            else XB_SPIN(xb_ld(&bar[XB_TOPGEN]) == tg, bar);
            __builtin_amdgcn_fence(__ATOMIC_ACQUIRE, "agent");
            xb_add(&bar[XB_XGEN(b.x)], 1u);
            asm volatile("s_waitcnt vmcnt(0)" ::: "memory");
        } else {
            XB_SPIN(xb_ld(&bar[XB_XGEN(b.x)]) == gen, bar);
            __builtin_amdgcn_fence(__ATOMIC_ACQUIRE, "agent");
            asm volatile("s_waitcnt vmcnt(0)" ::: "memory");
        }
    }
    __syncthreads();
}

struct Job { const float* src; bf16_t* dst; int K, N, ldd, map, row_off, item0; };
constexpr int NJOBS = 16;
struct Args {
    const float* in[25]; float* out; unsigned char* ws;
    Job jobs[NJOBS]; int nitems; int pad;
};

DI int job_rowmap(int map, int row_off, int n0) {
    if (map == 1) return n0 < D_FF ? 256 * (n0 / 128) + (n0 % 128) : 256 * ((n0 - D_FF) / 128) + 128 + ((n0 - D_FF) % 128);
    if (map == 2) return n0 < 768 ? n0 : (n0 < 1280 ? 768 + 256 * ((n0 - 768) / 128) + ((n0 - 768) % 128) : 768 + 256 * ((n0 - 1280) / 128) + 128 + ((n0 - 1280) % 128));
    return row_off + n0;
}
DI void transpose_item(const Job& jb, LAS float* scr, int item, int lane) {
    const int nblk = jb.N / 32, kb = item / nblk, nb = item % nblk, k0 = 64 * kb, n0 = 32 * nb;
    const float* W = jb.src; const int N = jb.N;
    float wv[32];
#pragma unroll
    for (int i = 0; i < 32; ++i) { const int kk = 2 * i + (lane >> 5); wv[i] = W[(size_t)(k0 + kk) * N + n0 + (lane & 31)]; }
#pragma unroll
    for (int i = 0; i < 32; ++i) { const int kk = 2 * i + (lane >> 5); scr[kk * 33 + (lane & 31)] = wv[i]; }
    asm volatile("s_waitcnt lgkmcnt(0)" ::: "memory");
    const int c = lane & 7;
    const int drow0 = job_rowmap(jb.map, jb.row_off, n0);
    const int kd0 = (jb.map == 3) ? (k0 / 128) * 192 + (k0 % 128) : k0;
#pragma unroll
    for (int j = 0; j < 4; ++j) { const int n = (lane >> 3) + 8 * j; const LAS float* s = scr + (8 * c) * 33 + n;
        u32x4 o; o.x = cvt_pk_bf16(s[0 * 33], s[1 * 33]); o.y = cvt_pk_bf16(s[2 * 33], s[3 * 33]); o.z = cvt_pk_bf16(s[4 * 33], s[5 * 33]); o.w = cvt_pk_bf16(s[6 * 33], s[7 * 33]);
        *(u32x4*)(jb.dst + (size_t)(drow0 + n) * jb.ldd + kd0 + 8 * c) = o; }
    asm volatile("s_waitcnt lgkmcnt(0)" ::: "memory");
}

DI void unpack8(const u32x4 w, f32x4& a, f32x4& b) {
    a = (f32x4){__uint_as_float(w.x << 16), __uint_as_float(w.x & 0xffff0000u), __uint_as_float(w.y << 16), __uint_as_float(w.y & 0xffff0000u)};
    b = (f32x4){__uint_as_float(w.z << 16), __uint_as_float(w.z & 0xffff0000u), __uint_as_float(w.w << 16), __uint_as_float(w.w & 0xffff0000u)};
}
DI u32x4 pack8(const f32x4 a, const f32x4 b) { u32x4 o; o.x = cvt_pk_bf16(a[0], a[1]); o.y = cvt_pk_bf16(a[2], a[3]); o.z = cvt_pk_bf16(b[0], b[1]); o.w = cvt_pk_bf16(b[2], b[3]); return o; }
template <bool SRCF32>
DI void norm_mod_row(const void* xrow, const float* g, const float* shift, const float* scale, bf16_t* orow, int lane, const float* addp, bf16_t* wb) {
    f32x4 v[4]; float s = 0.f;
#pragma unroll
    for (int j = 0; j < 2; ++j) { const int c = 8 * (lane + 64 * j);
        if (SRCF32) { v[2 * j] = *(const f32x4*)((const float*)xrow + c); v[2 * j + 1] = *(const f32x4*)((const float*)xrow + c + 4); }
        else unpack8h(*(const u32x4*)((const bf16_t*)xrow + c), v[2 * j], v[2 * j + 1]); }
    if (addp) {
#pragma unroll
        for (int j = 0; j < 2; ++j) { const int c = 8 * (lane + 64 * j); v[2 * j] = v[2 * j] + *(const f32x4*)(addp + c); v[2 * j + 1] = v[2 * j + 1] + *(const f32x4*)(addp + c + 4);
            *(u32x4*)(wb + c) = pack8h(v[2 * j], v[2 * j + 1]); } }
#pragma unroll
    for (int j = 0; j < 4; ++j) s += (v[j][0] * v[j][0] + v[j][1] * v[j][1]) + (v[j][2] * v[j][2] + v[j][3] * v[j][3]);
    const float rstd = 1.f / sqrtf(wave_sum(s) * (1.f / D_MODEL) + 1e-6f);
#pragma unroll
    for (int j = 0; j < 2; ++j) { const int c = 8 * (lane + 64 * j);
        const f32x4 y0 = (v[2 * j] * rstd * *(const f32x4*)(g + c)) * (*(const f32x4*)(scale + c) + 1.f) + *(const f32x4*)(shift + c);
        const f32x4 y1 = (v[2 * j + 1] * rstd * *(const f32x4*)(g + c + 4)) * (*(const f32x4*)(scale + c + 4) + 1.f) + *(const f32x4*)(shift + c + 4);
        *(u32x4*)(orow + c) = pack8(y0, y1); }
}

__global__ void __launch_bounds__(512, 2) fwd_kernel(Args args) {
    extern __shared__ __attribute__((aligned(16))) unsigned char lds_raw[];
    LAS unsigned char* lds = (LAS unsigned char*)lds_raw;
    cg::grid_group grid = cg::this_grid();
    const int G = gridDim.x, bx = blockIdx.x;
    const int vcu = (G % 8 == 0) ? (bx % 8) * (G / 8) + bx / 8 : bx;
    const int NGW = G * 8;
#define FRESH_IDS int tid = threadIdx.x; asm volatile("" : "+v"(tid)); const int lane = tid & 63, wave = __builtin_amdgcn_readfirstlane(tid >> 6); const int gw = vcu * 8 + wave; (void)lane; (void)gw;
    unsigned char* ws = args.ws;
    const float* x_in = args.in[0]; const float* c_in = args.in[1]; const float* ctx_in = args.in[2]; const float* cctx_in = args.in[3];
    const float* w_mod = args.in[4]; const float* b_mod = args.in[5]; const float* g_norm = args.in[6];
    const float* a_sink = args.in[10]; const float* b_w_dw = args.in[11]; const float* b_b_dw = args.in[12]; const float* b_ln_g = args.in[13]; const float* b_ln_b = args.in[14];
    const float* c_g_q = args.in[17]; const float* c_g_kv = args.in[20]; const float* g_final = args.in[24];
    float* rope = (float*)(ws + WS_ROPE); float* mod = (float*)(ws + WS_MOD);
    bf16_t* xs = (bf16_t*)(ws + WS_XS);
    unsigned char* R = ws + WS_R;

    volatile LAS unsigned* bar_st = (volatile LAS unsigned*)(lds + 131072);
    unsigned* bar_words = (unsigned*)(ws + WS_BAR);
    {
        FRESH_IDS
        if (tid < 2) bar_st[tid] = 0u;
        if (bx == 0) for (int i = tid; i < XCD_BAR_WORDS; i += 512) bar_words[i] = 0u;
        LAS float* scr = (LAS float*)(lds + wave * 8704);
        for (int rep = 0; rep < (PROBE == 6 ? 2 : 1); ++rep) {
        __syncthreads();
        for (int it = gw; it < args.nitems; it += NGW) {
            int ji = 0;
#pragma unroll
            for (int q = 1; q < NJOBS; ++q) if (it >= args.jobs[q].item0) ji = q;
            Job jb = args.jobs[0];
#pragma unroll
            for (int q = 1; q < NJOBS; ++q) if (ji == q) jb = args.jobs[q];
            transpose_item(jb, scr, it - jb.item0, lane);
        }
        { bf16_t* wd = (bf16_t*)(ws + WS_WD) + (size_t)576 * 1024; const int n16 = 192 * 1024 / 8;
          for (int i = bx * 512 + tid; i < n16; i += G * 512) ((u32x4*)wd)[i] = (u32x4){0u, 0u, 0u, 0u};
          bf16_t* wo = (bf16_t*)(ws + WS_WO);
          for (int i = bx * 512 + tid; i < 1024 * 8 * 8; i += G * 512) { const int row = i >> 6, hh = (i >> 3) & 7, ch = i & 7; *(u32x4*)(wo + (size_t)row * 1536 + hh * 192 + 128 + ch * 8) = (u32x4){0u, 0u, 0u, 0u}; } }
        for (int i = bx * 512 + tid; i < SEQ * 32; i += G * 512) { const int t = i >> 5, ai = i & 31, a = ai >> 4, ii = ai & 15;
            const float inv_freq = powf(10000.0f, -(float)(2 * ii) / 32.0f); const float pos = a == 0 ? (float)(t >> 6) : (float)(t & 63); const float ang = pos * inv_freq;
            rope[2 * i] = cosf(ang); rope[2 * i + 1] = sinf(ang); }
        __syncthreads();
        LAS float* sl = (LAS float*)lds;
        LAS float* red = (LAS float*)(lds + 17 * 1024 * 4);
        for (int i = tid; i < 17 * 1024; i += 512) { const float v = i < 16 * 1024 ? c_in[i] : cctx_in[i - 16 * 1024]; sl[i] = v / (1.f + expf(-v)); }
        __syncthreads();
        const int ks = tid >> 5, col = tid & 31;
        for (int u = vcu; u < 2 * (NMOD / 32); u += G) { const int l = u / (NMOD / 32), c0 = (u % (NMOD / 32)) * 32;
            float acc[17];
#pragma unroll
            for (int r = 0; r < 17; ++r) acc[r] = 0.f;
            const float* wp = w_mod + (size_t)l * D_MODEL * NMOD + (size_t)(ks * 64) * NMOD + c0 + col;
#pragma unroll 4
            for (int k = 0; k < 64; ++k) { const float wv = wp[(size_t)k * NMOD];
#pragma unroll
                for (int r = 0; r < 17; ++r) acc[r] += sl[r * 1024 + ks * 64 + k] * wv; }
#pragma unroll
            for (int r = 0; r < 17; ++r) red[(ks * 17 + r) * 32 + col] = acc[r];
            __syncthreads();
            for (int i = tid; i < 17 * 32; i += 512) { const int r = i >> 5, cc = i & 31; float s = b_mod[l * NMOD + c0 + cc];
#pragma unroll
                for (int q = 0; q < 16; ++q) s += red[(q * 17 + r) * 32 + cc];
                mod[((size_t)l * 17 + r) * NMOD + c0 + cc] = s; }
            __syncthreads();
        }
        }
    }
    grid.sync();
    const XcdBarrier xbar = xcd_barrier_post(bar_words, bar_st);
#define GSYNC() xcd_barrier(xbar)

#define NORM_PHASE(F32, LAYER, WHICH, SRCX, SRCH, DST, MROWS) do { FRESH_IDS \
        const float* g_ = g_norm + ((LAYER) * 3 + (WHICH)) * D_MODEL; const float* modl_ = mod + (size_t)(LAYER) * 17 * NMOD + (size_t)(3 * (WHICH)) * D_MODEL; \
        for (int row_ = gw; row_ < (MROWS); row_ += NGW) { const int mi_ = row_ < MX ? row_ / SEQ : 16; \
            const void* xr_ = row_ < MX ? (const void*)((SRCX) + (size_t)row_ * D_MODEL) : (const void*)((SRCH) + (size_t)(row_ - MX) * D_MODEL); \
            norm_mod_row<F32>(xr_, g_, modl_ + (size_t)mi_ * NMOD, modl_ + (size_t)mi_ * NMOD + D_MODEL, (DST) + (size_t)row_ * D_MODEL, lane, (!((LAYER) == 0 && (WHICH) == 0) && row_ >= MX) ? (const float*)(R + R_PART) + (size_t)(row_ - MX) * D_MODEL : (const float*)nullptr, xs + (size_t)row_ * D_MODEL); } } while (0)

#define FFN_PHASES(F32, LAYER, WHICH, S, SRCX, SRCH, MROWS) do { \
        NORM_PHASE(F32, LAYER, WHICH, SRCX, SRCH, (bf16_t*)(R + R_XN), MROWS); \
        GSYNC(); \
        if (PROBE == 2) { pg8::Gemm g_{(const bf16_t*)(R + R_XN), (const bf16_t*)(ws + WS_WIN + (size_t)((LAYER) * 2 + (S)) * W_IN_BYTES), (MROWS), 2 * D_FF, D_MODEL, D_MODEL, D_MODEL}; \
          pg8::StaticOrder S_; S_.init((MROWS), 2 * D_FF, D_MODEL, G, bx); pg8::EpiSwiglu E_{(bf16_t*)(R + R_ACT), D_FF}; pg8::gemm_phase(lds, g_, S_, E_); GSYNC(); } \
        { pg8::Gemm g_{(const bf16_t*)(R + R_XN), (const bf16_t*)(ws + WS_WIN + (size_t)((LAYER) * 2 + (S)) * W_IN_BYTES), (MROWS), 2 * D_FF, D_MODEL, D_MODEL, D_MODEL}; \
          pg8::StaticOrder S_; S_.init((MROWS), 2 * D_FF, D_MODEL, G, bx); pg8::EpiSwiglu E_{(bf16_t*)(R + R_ACT), D_FF}; pg8::gemm_phase(lds, g_, S_, E_); } \
        GSYNC(); \
        { pg8::Gemm g_{(const bf16_t*)(R + R_ACT), (const bf16_t*)(ws + WS_WOUT + (size_t)((LAYER) * 2 + (S)) * W_OUT_BYTES), (MROWS), D_MODEL, D_FF, D_FF, D_FF}; \
          pg8::EpiResid<F32> E_{(SRCX), (SRCH), xs, mod + (size_t)(LAYER) * 17 * NMOD + (size_t)(3 * (WHICH) + 2) * D_MODEL, (float*)(R + R_PART), 0.5f, 0}; \
          if ((MROWS) == MT) { pg8::SplitOrder S_; S_.init(D_MODEL, D_FF, G, bx); pg8::gemm_phase(lds, g_, S_, E_); } \
          else { pg8::StaticOrder S_; S_.init((MROWS), D_MODEL, D_FF, G, bx); pg8::gemm_phase(lds, g_, S_, E_); } } \
        GSYNC(); if (PROBE == 5) { GSYNC(); GSYNC(); GSYNC(); GSYNC(); GSYNC(); } } while (0)

    const bf16_t* xs_h = xs + (size_t)MX * D_MODEL;
    FFN_PHASES(true, 0, 0, 0, x_in, ctx_in, MT);
    NORM_PHASE(false, 0, 1, xs, xs_h, (bf16_t*)(R + R_XN), MT);
    GSYNC();
    { pg8::Gemm g_{(const bf16_t*)(R + R_XN), (const bf16_t*)(ws + WS_WABIN), MT, 1792, D_MODEL, D_MODEL, D_MODEL};
      pg8::StaticOrder S_; S_.init(MT, 1792, D_MODEL, G, bx);
      pg8::EpiABIn E_{(bf16_t*)(R + R_Q), (bf16_t*)(R + R_KV), (bf16_t*)(R + R_Y), rope, 0.125f * LOG2E}; pg8::gemm_phase(lds, g_, S_, E_); }
    GSYNC();
    {
        const bf16_t* Qb = (const bf16_t*)(R + R_Q); const bf16_t* KVb = (const bf16_t*)(R + R_KV); bf16_t* cat = (bf16_t*)(R + R_CAT);
        for (int rep = 0; rep < (PROBE == 4 ? 2 : 1); ++rep) {
        const int apw = (1152 + G - 1) / G;
        for (int u = vcu * apw; u < vcu * apw + apw; ++u) {
            if (u >= 1152) break;
            AttnU a; int b, hq;
            if (u < 1024) { b = u >> 6; hq = (u >> 3) & 7; const int qb = u & 7; const int q0 = qb * 256;
                const int lo = q0 - 128 < 0 ? 0 : q0 - 128, hi = q0 + 384 > SEQ ? SEQ : q0 + 384;
                a.Q = Qb + (size_t)(b * SEQ + q0) * 512 + hq * 64; a.O = cat + (size_t)(b * SEQ + q0) * 1024 + hq * 64;
                a.nt_lat = (hi - lo) / 64; a.lat_row0 = b * SEQ + lo; a.kpos0 = lo; a.qpos0 = q0;
            } else { const int v = u - 1024; b = v >> 3; hq = v & 7;
                a.Q = Qb + (size_t)(MX + b * CTX) * 512 + hq * 64; a.O = cat + (size_t)(MX + b * CTX) * 1024 + hq * 64;
                a.nt_lat = 0; a.lat_row0 = 0; a.kpos0 = 0; a.qpos0 = 0; }
            a.ldq = 512; a.ldo = 1024; const int hkv = hq >> 2;
            a.K1 = KVb + hkv * 64; a.ldk1 = 256; a.K2 = a.K1; a.ldk2 = 256; a.V = KVb + 128 + hkv * 64; a.ldv = 256;
            a.nt_ctx = 4; a.ctx_row0 = MX + b * CTX; a.m0 = a_sink[hq] * LOG2E; a.l0 = 1.f;
            attn_unit<64, 64, 64, true>(lds, a);
        }
        __syncthreads();
        for (int u = vcu; u < 1152; u += G) { int row_base, seqlen, t0;
            if (u < 1024) { row_base = (u >> 6) * SEQ; seqlen = SEQ; t0 = (u & 63) * 32; } else { const int v = u - 1024; row_base = MX + (v >> 3) * CTX; seqlen = CTX; t0 = (v & 7) * 32; }
            conv_unit(lds, (const bf16_t*)(R + R_Y), row_base, seqlen, t0, b_w_dw, b_b_dw, b_ln_g, b_ln_b, cat); }
        }
    }
    GSYNC();
    { pg8::Gemm g_{(const bf16_t*)(R + R_CAT), (const bf16_t*)(ws + WS_WABOUT), MT, D_MODEL, D_MODEL, D_MODEL, D_MODEL};
      pg8::SplitOrder S_; S_.init(D_MODEL, D_MODEL, G, bx);
      pg8::EpiResid<false> E_{xs, xs_h, xs, mod + (size_t)5 * D_MODEL, (float*)(R + R_PART), 1.0f, 0}; pg8::gemm_phase(lds, g_, S_, E_); }
    GSYNC();
    FFN_PHASES(false, 0, 2, 1, xs, xs_h, MT);

    FFN_PHASES(false, 1, 0, 0, xs, xs_h, MT);
    NORM_PHASE(false, 1, 1, xs, xs_h, (bf16_t*)(R + R_XN), MT);
    GSYNC();
    { pg8::Gemm g_{(const bf16_t*)(R + R_XN), (const bf16_t*)(ws + WS_WD), MT, 768, D_MODEL, D_MODEL, D_MODEL};
      pg8::StaticOrder S_; S_.init(MT, 768, D_MODEL, G, bx);
      pg8::EpiPlain E_{(bf16_t*)(R + R_D), (bf16_t*)(R + R_D), 1000, LDD, LDD}; pg8::gemm_phase(lds, g_, S_, E_); }
    GSYNC();
    {
        FRESH_IDS
        bf16_t* Db = (bf16_t*)(R + R_D);
        for (int row = gw; row < MT; row += NGW) { bf16_t* dr = Db + (size_t)row * LDD;
            const u32x2 qa = ((const u32x2*)dr)[lane], ka = ((const u32x2*)(dr + 256))[lane]; const float kr = bf2f(dr[512 + lane]);
            f32x4 q = {__uint_as_float(qa.x << 16), __uint_as_float(qa.x & 0xffff0000u), __uint_as_float(qa.y << 16), __uint_as_float(qa.y & 0xffff0000u)};
            f32x4 k = {__uint_as_float(ka.x << 16), __uint_as_float(ka.x & 0xffff0000u), __uint_as_float(ka.y << 16), __uint_as_float(ka.y & 0xffff0000u)};
            const float rq = 1.f / sqrtf(wave_sum((q[0] * q[0] + q[1] * q[1]) + (q[2] * q[2] + q[3] * q[3])) * (1.f / 256.f) + 1e-6f);
            const float rk = 1.f / sqrtf(wave_sum((k[0] * k[0] + k[1] * k[1]) + (k[2] * k[2] + k[3] * k[3])) * (1.f / 256.f) + 1e-6f);
            q = q * rq * ((const f32x4*)c_g_q)[lane]; k = k * rk * ((const f32x4*)c_g_kv)[lane];
            float kro = kr;
            const float partner = __shfl_xor(kr, 16);
            if (row < MX) { const int t = row & (SEQ - 1); const float cs = rope[(size_t)t * 64 + ((lane >> 5) * 16 + (lane & 15)) * 2], sn = rope[(size_t)t * 64 + ((lane >> 5) * 16 + (lane & 15)) * 2 + 1];
                const float rot = (lane & 16) ? partner : -partner; kro = kr * cs + rot * sn; }
            ((u32x2*)dr)[lane] = pack4(q); ((u32x2*)(dr + 256))[lane] = pack4(k); dr[512 + lane] = (bf16_t)(cvt_pk_bf16(kro, 0.f) & 0xffffu); }
    }
    GSYNC();
    { pg8::Gemm g_{(const bf16_t*)(R + R_D), (const bf16_t*)(ws + WS_WUQ), MX, 1536, 256, LDD, 256};
      pg8::StaticOrder S_; S_.init(MX, 1536, 256, G, bx);
      pg8::EpiUq E_{(bf16_t*)(R + R_Q2), rope, 0.07216878364870322f * LOG2E}; pg8::gemm_phase(lds, g_, S_, E_); }
    { pg8::Gemm g_{(const bf16_t*)(R + R_D) + 256, (const bf16_t*)(ws + WS_WUKV), MT, 2048, 256, LDD, 256};
      pg8::StaticOrder S_; S_.init(MT, 2048, 256, G, bx);
      pg8::EpiPlain E_{(bf16_t*)(R + R_KN), (bf16_t*)(R + R_V), 4, D_MODEL, 1 << 30}; pg8::gemm_phase(lds, g_, S_, E_); }
    GSYNC();
    {
        bf16_t* Q2 = (bf16_t*)(R + R_Q2); const bf16_t* Kn = (const bf16_t*)(R + R_KN); const bf16_t* Db = (const bf16_t*)(R + R_D); const bf16_t* Vb = (const bf16_t*)(R + R_V);
        const int mpw = (1024 + G - 1) / G;
        for (int u = vcu * mpw; u < vcu * mpw + mpw; ++u) { if (u >= 1024) break; const int b = u >> 6, hh = (u >> 3) & 7, qb = u & 7;
            AttnU a; a.Q = Q2 + (size_t)(b * SEQ + qb * 256) * 1536 + hh * 192; a.ldq = 1536; a.O = Q2 + (size_t)(b * SEQ + qb * 256) * 1536 + hh * 192; a.ldo = 1536;
            a.K1 = Kn + hh * 128; a.ldk1 = D_MODEL; a.K2 = Db + 512; a.ldk2 = LDD; a.V = Vb + hh * 128; a.ldv = D_MODEL;
            a.nt_lat = SEQ / 64; a.lat_row0 = b * SEQ; a.kpos0 = 0; a.nt_ctx = 4; a.ctx_row0 = MX + b * CTX; a.qpos0 = 0; a.m0 = -1e30f; a.l0 = 0.f;
            if (PROBE == 1) attn_unit<192, 128, 128, false, 1>(lds, a);
            if (PROBE == 7) attn_unit<192, 128, 128, false, 4>(lds, a);
            if (PROBE == 8) attn_unit<192, 128, 128, false, 3>(lds, a);
            if (PROBE == 9) attn_unit<192, 128, 128, false, 2>(lds, a);
            attn_unit<192, 128, 128, false>(lds, a); }
        __syncthreads();
    }
    GSYNC();
    { pg8::Gemm g_{(const bf16_t*)(R + R_Q2), (const bf16_t*)(ws + WS_WO), MX, D_MODEL, 1536, 1536, 1536};
      pg8::StaticOrder S_; S_.init(MX, D_MODEL, 1536, G, bx);
      pg8::EpiResid<false> E_{xs, xs_h, xs, mod + (size_t)17 * NMOD + (size_t)5 * D_MODEL, (float*)(R + R_PART), 1.0f, 0}; pg8::gemm_phase(lds, g_, S_, E_); }
    GSYNC();
    FFN_PHASES(false, 1, 2, 1, xs, xs_h, MX);
    FRESH_IDS
    for (int row = gw; row < MX; row += NGW) { const bf16_t* xr = xs + (size_t)row * D_MODEL;
        f32x4 v[4]; float sq = 0.f;
#pragma unroll
        for (int j = 0; j < 2; ++j) unpack8h(*(const u32x4*)(xr + 8 * (lane + 64 * j)), v[2 * j], v[2 * j + 1]);
#pragma unroll
        for (int j = 0; j < 4; ++j) sq += (v[j][0] * v[j][0] + v[j][1] * v[j][1]) + (v[j][2] * v[j][2] + v[j][3] * v[j][3]);
        const float rstd = 1.f / sqrtf(wave_sum(sq) * (1.f / D_MODEL) + 1e-6f);
        float* orow = args.out + (size_t)row * D_MODEL;
#pragma unroll
        for (int j = 0; j < 2; ++j) { const int c = 8 * (lane + 64 * j);
            *(f32x4*)(orow + c) = v[2 * j] * rstd * *(const f32x4*)(g_final + c); *(f32x4*)(orow + c + 4) = v[2 * j + 1] * rstd * *(const f32x4*)(g_final + c + 4); } }
}

extern "C" void kernel_launch(void* const* d_in, const int* in_sizes, int n_in, void* d_out, int out_size, void* d_ws, size_t ws_size, hipStream_t stream) {
    static int grid = 0;
    if (grid == 0) {
        if (n_in != 25 || ws_size < WS_END || out_size != MX * D_MODEL) { fprintf(stderr, "kernel_launch: unexpected shapes: n_in %d ws %zu out %d\n", n_in, ws_size, out_size); grid = -1; return; }
        int dev = 0, cus = 0, per_cu = 0;
        if (hipGetDevice(&dev) != hipSuccess || hipDeviceGetAttribute(&cus, hipDeviceAttributeMultiprocessorCount, dev) != hipSuccess) { grid = -1; return; }
        if (hipFuncSetAttribute((const void*)fwd_kernel, hipFuncAttributeMaxDynamicSharedMemorySize, LDS_BYTES) != hipSuccess) { fprintf(stderr, "kernel_launch: hipFuncSetAttribute failed\n"); grid = -1; return; }
        if (hipOccupancyMaxActiveBlocksPerMultiprocessor(&per_cu, (const void*)fwd_kernel, 512, LDS_BYTES) != hipSuccess || per_cu < 1) { fprintf(stderr, "kernel_launch: occupancy query says %d\n", per_cu); per_cu = 1; }
        (void)hipGetLastError();
        grid = cus;
    }
    if (grid < 0) return;
    Args a{};
    for (int i = 0; i < 25; ++i) a.in[i] = (const float*)d_in[i];
    a.out = (float*)d_out; a.ws = (unsigned char*)d_ws;
    unsigned char* ws = (unsigned char*)d_ws;
    int nj = 0, items = 0;
    auto add = [&](const float* src, size_t dst_off, int K, int N, int ldd, int map, int row_off) {
        Job& j = a.jobs[nj++]; j.src = src; j.dst = (bf16_t*)(ws + dst_off); j.K = K; j.N = N; j.ldd = ldd; j.map = map; j.row_off = row_off; j.item0 = items; items += (K / 64) * (N / 32); };
    const float* ffn_w_in = (const float*)d_in[7]; const float* ffn_w_out = (const float*)d_in[8];
    for (int i = 0; i < 4; ++i) add(ffn_w_in + (size_t)i * D_MODEL * 2 * D_FF, WS_WIN + i * W_IN_BYTES, D_MODEL, 2 * D_FF, D_MODEL, 1, 0);
    for (int i = 0; i < 4; ++i) add(ffn_w_out + (size_t)i * D_FF * D_MODEL, WS_WOUT + i * W_OUT_BYTES, D_FF, D_MODEL, D_FF, 0, 0);
    add((const float*)d_in[9], WS_WABIN, D_MODEL, 1792, D_MODEL, 2, 0);
    add((const float*)d_in[15], WS_WABOUT, D_MODEL, D_MODEL, D_MODEL, 0, 0);
    add((const float*)d_in[16], WS_WD, D_MODEL, 256, D_MODEL, 0, 0);
    add((const float*)d_in[19], WS_WD, D_MODEL, 320, D_MODEL, 0, 256);
    add((const float*)d_in[18], WS_WUQ, 256, 1536, 256, 0, 0);
    add((const float*)d_in[21], WS_WUKV, 256, 1024, 256, 0, 0);
    add((const float*)d_in[22], WS_WUKV, 256, 1024, 256, 0, 1024);
    add((const float*)d_in[23], WS_WO, D_MODEL, D_MODEL, 1536, 3, 0);
    a.nitems = items;
    void* kargs[] = {&a};
    hipError_t e = hipLaunchCooperativeKernel((const void*)fwd_kernel, dim3(grid), dim3(512), kargs, LDS_BYTES, stream);
    if (e != hipSuccess) fprintf(stderr, "kernel_launch: cooperative launch failed: %s (grid %d)\n", hipGetErrorString(e), grid);
}
```

```cpp
#include <hip/hip_runtime.h>
#include <hip/hip_cooperative_groups.h>
#include <cstdio>
#include <cstdint>
namespace cg = cooperative_groups;

#define LAS __attribute__((address_space(3)))
#define DI __device__ __forceinline__
typedef unsigned short bf16_t;
typedef short bf16x8 __attribute__((ext_vector_type(8)));
typedef short s16x4 __attribute__((ext_vector_type(4)));
typedef float f32x4 __attribute__((ext_vector_type(4)));
typedef float f32x16 __attribute__((ext_vector_type(16)));
typedef unsigned u32x4 __attribute__((ext_vector_type(4)));
typedef unsigned u32x2 __attribute__((ext_vector_type(2)));

constexpr int D_MODEL = 1024, BATCH = 16, SEQ = 2048, CTX = 256, D_FF = 2816;
constexpr int MX = BATCH * SEQ;
constexpr int MH = BATCH * CTX;
constexpr int MT = MX + MH;
constexpr int NMOD = 9 * D_MODEL;
constexpr float LOG2E = 1.4426950408889634f;

constexpr size_t MiB = 1u << 20;
constexpr size_t WS_ROPE = 0;
constexpr size_t WS_MOD = 512 * 1024;
constexpr size_t WS_BAR = 1792 * 1024;
constexpr size_t WS_W = 2 * MiB;
constexpr size_t W_IN_BYTES = (size_t)2 * D_FF * D_MODEL * 2;
constexpr size_t W_OUT_BYTES = (size_t)D_MODEL * D_FF * 2;
constexpr size_t WS_WIN = WS_W;
constexpr size_t WS_WOUT = WS_WIN + 4 * W_IN_BYTES;
constexpr size_t WS_WABIN = WS_WOUT + 4 * W_OUT_BYTES;
constexpr size_t WS_WABOUT = WS_WABIN + (size_t)1792 * 1024 * 2;
constexpr size_t WS_WD = WS_WABOUT + (size_t)1024 * 1024 * 2;
constexpr size_t WS_WUQ = WS_WD + (size_t)768 * 1024 * 2;
constexpr size_t WS_WUKV = WS_WUQ + (size_t)1536 * 256 * 2;
constexpr size_t WS_WO = WS_WUKV + (size_t)2048 * 256 * 2;
constexpr size_t WS_WEND = WS_WO + (size_t)1024 * 1536 * 2;
static_assert(WS_WEND <= 80 * MiB, "weights");
constexpr size_t WS_XS = 80 * MiB;
constexpr size_t WS_R = 224 * MiB;
constexpr size_t WS_END = 512 * MiB;
constexpr size_t R_XN = 0;
constexpr size_t R_ACT = 72 * MiB;
constexpr size_t R_PART = 270 * MiB;
constexpr size_t R_CAT = 0;
constexpr size_t R_Q = 72 * MiB;
constexpr size_t R_KV = 108 * MiB;
constexpr size_t R_Y = 126 * MiB;
constexpr size_t R_KN = 0;
constexpr int LDD = 576;
constexpr size_t R_D = 72 * MiB;
constexpr size_t R_Q2 = 113 * MiB;
constexpr size_t R_V = 209 * MiB;
static_assert(R_V + 72 * MiB <= 288 * MiB && R_ACT + 198 * MiB <= 288 * MiB, "R map");

#ifndef PROBE
#define PROBE 0
#endif
constexpr int LDS_BYTES = 135168;

typedef float f32x2c __attribute__((ext_vector_type(2))); typedef __bf16 bf16x2c __attribute__((ext_vector_type(2)));
DI unsigned cvt_pk_bf16(float lo, float hi) { const f32x2c v = {lo, hi}; const bf16x2c b = __builtin_convertvector(v, bf16x2c); return __builtin_bit_cast(unsigned, b); }
DI float bf2f(bf16_t v) { return __uint_as_float((unsigned)v << 16); }
DI float fast_exp2(float x) { return __builtin_amdgcn_exp2f(x); }
DI float fast_rcp(float x) { return __builtin_amdgcn_rcpf(x); }
DI float sigmoid_f(float x) { return fast_rcp(1.f + fast_exp2(-x * LOG2E)); }
DI float wave_sum(float v) {
#pragma unroll
    for (int o = 1; o < 64; o <<= 1) v += __shfl_xor(v, o);
    return v;
}
typedef _Float16 h16x2 __attribute__((ext_vector_type(2)));
DI unsigned cvt_pk_f16(float lo, float hi) { const h16x2 v = {(_Float16)lo, (_Float16)hi}; return __builtin_bit_cast(unsigned, v); }
DI void unpack8h(const u32x4 w, f32x4& a, f32x4& b) {
    const unsigned w0 = w[0], w1 = w[1], w2 = w[2], w3 = w[3];
    const h16x2 p0 = __builtin_bit_cast(h16x2, w0), p1 = __builtin_bit_cast(h16x2, w1), p2 = __builtin_bit_cast(h16x2, w2), p3 = __builtin_bit_cast(h16x2, w3);
    a = (f32x4){(float)p0[0], (float)p0[1], (float)p1[0], (float)p1[1]}; b = (f32x4){(float)p2[0], (float)p2[1], (float)p3[0], (float)p3[1]};
}
DI u32x4 pack8h(const f32x4 a, const f32x4 b) { u32x4 o; o.x = cvt_pk_f16(a[0], a[1]); o.y = cvt_pk_f16(a[2], a[3]); o.z = cvt_pk_f16(b[0], b[1]); o.w = cvt_pk_f16(b[2], b[3]); return o; }
typedef float f32x2 __attribute__((ext_vector_type(2)));
DI float max3f(float a, float b, float c) { return __builtin_fmaxf(__builtin_fmaxf(a, b), c); }
DI void unpack8(const u32x4 w, f32x4& a, f32x4& b) {
    a = (f32x4){__uint_as_float(w.x << 16), __uint_as_float(w.x & 0xffff0000u), __uint_as_float(w.y << 16), __uint_as_float(w.y & 0xffff0000u)};
    b = (f32x4){__uint_as_float(w.z << 16), __uint_as_float(w.z & 0xffff0000u), __uint_as_float(w.w << 16), __uint_as_float(w.w & 0xffff0000u)};
}
DI u32x4 pack8(const f32x4 a, const f32x4 b) { u32x4 o; o.x = cvt_pk_bf16(a[0], a[1]); o.y = cvt_pk_bf16(a[2], a[3]); o.z = cvt_pk_bf16(b[0], b[1]); o.w = cvt_pk_bf16(b[2], b[3]); return o; }
DI u32x2 pack4(f32x4 v) { u32x2 w; w.x = cvt_pk_bf16(v[0], v[1]); w.y = cvt_pk_bf16(v[2], v[3]); return w; }

namespace pg8 {
constexpr int BM = 256, BK = 64, HALF = 128, HTB = HALF * BK * 2, STAGE_BYTES = 8 * HTB, NXCD = 8, WGM = 8;
DI int lds_byte(int r, int c) { const int st = (r >> 4) * 2 + (c >> 5), rr = r & 15, cc = c & 31, ob = rr * 64 + cc * 2; return st * 1024 + (ob ^ (((ob >> 9) & 1) << 5)); }
DI void stage_rc(int b, int& R, int& C) { const int st = b / 1024, sb = b % 1024, swz = sb ^ (((sb >> 9) & 1) << 5); R = (st >> 1) * 16 + swz / 64; C = (st & 1) * 32 + (swz % 64) / 2; }
DI int perm32(int rho) { const int n = rho >> 4, i = rho & 15; return 8 * (i >> 2) + 4 * n + (i & 3); }

struct Unit { int pm, pn, k0, nk; };
struct Gemm { const bf16_t* A; const bf16_t* Bt; int M, N, K, lda, ldb; };

struct StaticOrder {
    int nM, nN, nwg, G, c;
    int ntk;
    DI void init(int M, int N, int K, int G_, int c_) { nM = M / BM; nN = N / BM; nwg = nM * nN; G = G_; c = c_; ntk = K / BK; }
    DI Unit get(int i, bool& ok) const { return at((long)i * G + c, ok); }
    DI Unit at(long L, bool& ok) const {
        Unit u; u.pm = 0; u.pn = 0; u.k0 = 0; u.nk = ntk; ok = L < nwg; if (!ok) return u;
        int wgid = (int)L; { const int q = nwg / NXCD, r = nwg % NXCD, xcd = wgid % NXCD, off = wgid / NXCD; wgid = (xcd < r ? xcd * (q + 1) : r * (q + 1) + (xcd - r) * q) + off; }
        const int nig = WGM * nN, gid = wgid / nig, fm = gid * WGM, gsz = (nM - fm) < WGM ? (nM - fm) : WGM;
        u.pm = fm + ((wgid % nig) % gsz); u.pn = (wgid % nig) / gsz; return u;
    }
};
struct SplitOrder {
    StaticOrder full; int G, c, ntk;
    DI void init(int N, int K, int G_, int c_) { full.init(MX, N, K, G_, c_); G = G_; c = c_; ntk = K / BK; }
    DI Unit get(int i, bool& ok) const {
        const long L = (long)i * G + c;
        if (L < full.nwg) return full.at(L, ok);
        const int q = (int)(L - full.nwg); ok = q < 128;
        Unit u; u.pm = MX / BM + (q >> 3); u.pn = (q >> 1) & 3; const int part = q & 1;
        u.nk = ntk / 2; u.k0 = part * u.nk;
        return u;
    }
};

template <class Epi, class Sched>
DI void gemm_phase(LAS unsigned char* lds, const Gemm g, const Sched& S, const Epi& E) {
    int tid = threadIdx.x; asm volatile("" : "+v"(tid));
    const int wid = __builtin_amdgcn_readfirstlane(tid >> 6), lane = tid & 63, wr = wid >> 2, wc = wid & 3, fr = lane & 15, fq = lane >> 4;
    unsigned voffA[2], voffB[2];
#pragma unroll
    for (int i = 0; i < 2; ++i) { int R, C; stage_rc(tid * 16 + i * 8192, R, C); const int Rb = Epi::PERM ? ((R & ~31) + perm32(R & 31)) : R;
        voffA[i] = (unsigned)(R * g.lda + C) * 2u; voffB[i] = (unsigned)(Rb * g.ldb + C) * 2u; }
    const size_t kstep = (size_t)(BK * 2);
    const size_t hstepA = (size_t)HALF * g.lda * 2, hstepB = (size_t)HALF * g.ldb * 2;
    const size_t tstepA = 2 * hstepA, tstepB = 2 * hstepB;
    const unsigned ldsw = (unsigned)wid * 1024u;
    const int aoff = lds_byte(wr * 64 + fr, fq * 8), boff = lds_byte(wc * 32 + fr, fq * 8);
#define PG8_SA(b, h) (((b) * 2 + (h)) * HTB)
#define PG8_SB(b, h) ((4 + (b) * 2 + (h)) * HTB)
#define PG8_STAGE(bufoff, gbase, voff) do { _Pragma("unroll") for (int _i = 0; _i < 2; ++_i) \
        __builtin_amdgcn_global_load_lds((const unsigned*)((const char*)(gbase) + (voff)[_i]), (LAS unsigned*)(lds + (bufoff) + ldsw + _i * 8192), 16, 0, 0); } while (0)
#define PG8_LDA(dst, b, h) do { _Pragma("unroll") for (int m = 0; m < 4; ++m) _Pragma("unroll") for (int k = 0; k < 2; ++k) dst[m][k] = *(const LAS bf16x8*)(lds + PG8_SA(b, h) + aoff + m * 2048 + k * 1024); } while (0)
#define PG8_LDB(dst, b, h) do { _Pragma("unroll") for (int n = 0; n < 2; ++n) _Pragma("unroll") for (int k = 0; k < 2; ++k) dst[n][k] = *(const LAS bf16x8*)(lds + PG8_SB(b, h) + boff + n * 2048 + k * 1024); } while (0)
#define PG8_MMA(ai, bj, At, Bt) do { __builtin_amdgcn_s_setprio(1); _Pragma("unroll") for (int m = 0; m < 4; ++m) _Pragma("unroll") for (int n = 0; n < 2; ++n) _Pragma("unroll") for (int k = 0; k < 2; ++k) \
        acc[ai][bj][m][n] = __builtin_amdgcn_mfma_f32_16x16x32_bf16(Bt[n][k], At[m][k], acc[ai][bj][m][n], 0, 0, 0); __builtin_amdgcn_s_setprio(0); } while (0)
#define PG8_WAIT_V(n) asm volatile("s_waitcnt vmcnt(" #n ")" ::: "memory")
#define PG8_WAIT_L(n) asm volatile("s_waitcnt lgkmcnt(" #n ")" ::: "memory")
#define PG8_BAR __builtin_amdgcn_s_barrier()
#define PG8_SCHED __builtin_amdgcn_sched_barrier(0)
    int ui = 0; bool ok0;
    Unit cur = S.get(0, ok0), nxt = cur;
    if (!ok0) return;
    f32x4 acc[2][2][4][2];
#pragma unroll
    for (int a = 0; a < 2; ++a)
#pragma unroll
        for (int b = 0; b < 2; ++b)
#pragma unroll
            for (int m = 0; m < 4; ++m)
#pragma unroll
                for (int n = 0; n < 2; ++n) acc[a][b][m][n] = (f32x4){0.f, 0.f, 0.f, 0.f};
    bf16x8 At[4][2], B0[2][2], B1[2][2];
    const char* cA = (const char*)g.A + (size_t)cur.pm * tstepA + (size_t)cur.k0 * kstep; const char* cB = (const char*)g.Bt + (size_t)cur.pn * tstepB + (size_t)cur.k0 * kstep;
    PG8_STAGE(PG8_SB(0, 0), cB, voffB); PG8_STAGE(PG8_SB(0, 1), cB + hstepB, voffB); PG8_STAGE(PG8_SA(0, 0), cA, voffA); PG8_STAGE(PG8_SA(0, 1), cA + hstepA, voffA);
    if (wr == 1) PG8_BAR;
    PG8_WAIT_V(2); PG8_BAR;
    PG8_STAGE(PG8_SB(1, 0), cB + kstep, voffB); PG8_STAGE(PG8_SA(1, 0), cA + kstep, voffA); PG8_STAGE(PG8_SB(1, 1), cB + hstepB + kstep, voffB);
    PG8_WAIT_V(6); PG8_BAR;
    for (;;) {
        bool has_next; nxt = S.get(ui + 1, has_next);
        const char* nA = has_next ? (const char*)g.A + (size_t)nxt.pm * tstepA + (size_t)nxt.k0 * kstep : cA; const char* nB = has_next ? (const char*)g.Bt + (size_t)nxt.pn * tstepB + (size_t)nxt.k0 * kstep : cB;
        const int nt = cur.nk;
        for (int t = 0; t < nt; t += 2) {
            const bool last = (t == nt - 2);
            const char* a1 = cA + (size_t)(t + 1) * kstep;
            const char* a2 = last ? nA : cA + (size_t)(t + 2) * kstep; const char* b2 = last ? nB : cB + (size_t)(t + 2) * kstep;
            const char* a3 = a2 + kstep; const char* b3 = b2 + kstep;
            PG8_LDB(B0, 0, 0); PG8_LDB(B1, 0, 1); PG8_SCHED; PG8_LDA(At, 0, 0); PG8_STAGE(PG8_SA(1, 1), a1 + hstepA, voffA);
            PG8_WAIT_V(8); PG8_WAIT_L(0); PG8_BAR; PG8_MMA(0, 0, At, B0); PG8_MMA(0, 1, At, B1); PG8_BAR; PG8_SCHED;
            PG8_LDA(At, 0, 1); PG8_STAGE(PG8_SB(0, 0), b2, voffB); PG8_STAGE(PG8_SB(0, 1), b2 + hstepB, voffB); PG8_STAGE(PG8_SA(0, 0), a2, voffA);
            PG8_WAIT_V(8); PG8_WAIT_L(0); PG8_BAR; PG8_MMA(1, 0, At, B0); PG8_MMA(1, 1, At, B1); PG8_BAR; PG8_SCHED;
            PG8_LDB(B0, 1, 0); PG8_LDB(B1, 1, 1); PG8_SCHED; PG8_LDA(At, 1, 0); PG8_STAGE(PG8_SA(0, 1), a2 + hstepA, voffA);
            PG8_WAIT_V(8); PG8_WAIT_L(0); PG8_BAR; PG8_MMA(0, 0, At, B0); PG8_MMA(0, 1, At, B1); PG8_BAR; PG8_SCHED;
            PG8_LDA(At, 1, 1); PG8_STAGE(PG8_SB(1, 0), b3, voffB); PG8_STAGE(PG8_SB(1, 1), b3 + hstepB, voffB); PG8_STAGE(PG8_SA(1, 0), a3, voffA);
            PG8_WAIT_V(8); PG8_WAIT_L(0); PG8_BAR; PG8_MMA(1, 0, At, B0); PG8_MMA(1, 1, At, B1); PG8_BAR; PG8_SCHED;
        }
        if (wr == 0) PG8_BAR;
        E(acc, cur, wr, wc, fr, fq);
        if (!has_next) break;
#pragma unroll
        for (int a = 0; a < 2; ++a)
#pragma unroll
            for (int b = 0; b < 2; ++b)
#pragma unroll
                for (int m = 0; m < 4; ++m)
#pragma unroll
                    for (int n = 0; n < 2; ++n) acc[a][b][m][n] = (f32x4){0.f, 0.f, 0.f, 0.f};
        cur = nxt; cA = nA; cB = nB; ++ui;
        if (wr == 1) PG8_BAR;
    }
    PG8_WAIT_V(0);
    PG8_BAR;
#undef PG8_SA
#undef PG8_SB
#undef PG8_STAGE
#undef PG8_LDA
#undef PG8_LDB
#undef PG8_MMA
#undef PG8_WAIT_V
#undef PG8_WAIT_L
#undef PG8_BAR
#undef PG8_SCHED
}

typedef f32x4 Acc[2][2][4][2];

struct EpiPlain {
    static constexpr bool PERM = true;
    bf16_t* O0; bf16_t* O1; int split_tile; int ldc; int ncols_valid;
    DI void operator()(const Acc& acc, const Unit& u, int wr, int wc, int fr, int fq) const {
        asm volatile("" : "+v"(fr), "+v"(fq));
        const int row0 = u.pm * BM + wr * 64 + fr;
        bf16_t* base = O0; int colt = u.pn * BM; if (u.pn >= split_tile) { base = O1; colt -= split_tile * BM; }
        const int col0 = colt + wc * 32 + 8 * fq;
#pragma unroll
        for (int ai = 0; ai < 2; ++ai)
#pragma unroll
            for (int m = 0; m < 4; ++m) { bf16_t* rowp = base + (size_t)(row0 + ai * HALF + m * 16) * ldc + col0;
#pragma unroll
                for (int bj = 0; bj < 2; ++bj) { if (col0 + bj * HALF < ncols_valid) { const f32x4 v0 = acc[ai][bj][m][0], v1 = acc[ai][bj][m][1]; u32x4 w;
                    w.x = cvt_pk_bf16(v0[0], v0[1]); w.y = cvt_pk_bf16(v0[2], v0[3]); w.z = cvt_pk_bf16(v1[0], v1[1]); w.w = cvt_pk_bf16(v1[2], v1[3]);
                    *(u32x4*)(rowp + bj * HALF) = w; } } }
    }
};
struct EpiSwiglu {
    static constexpr bool PERM = true;
    bf16_t* O; int ldc;
    DI void operator()(const Acc& acc, const Unit& u, int wr, int wc, int fr, int fq) const {
        asm volatile("" : "+v"(fr), "+v"(fq));
        const int row0 = u.pm * BM + wr * 64 + fr; const int col0 = u.pn * HALF + wc * 32 + 8 * fq;
#pragma unroll
        for (int ai = 0; ai < 2; ++ai)
#pragma unroll
            for (int m = 0; m < 4; ++m) { bf16_t* rowp = O + (size_t)(row0 + ai * HALF + m * 16) * ldc + col0; float v[8];
#pragma unroll
                for (int n = 0; n < 2; ++n)
#pragma unroll
                    for (int j = 0; j < 4; ++j) { const float gg = acc[ai][0][m][n][j], uu = acc[ai][1][m][n][j]; v[n * 4 + j] = gg * sigmoid_f(gg) * uu; }
                u32x4 w; w.x = cvt_pk_bf16(v[0], v[1]); w.y = cvt_pk_bf16(v[2], v[3]); w.z = cvt_pk_bf16(v[4], v[5]); w.w = cvt_pk_bf16(v[6], v[7]);
                *(u32x4*)rowp = w; }
    }
};
template <bool BASEF32>
struct EpiResid {
    static constexpr bool PERM = true;
    const void* base_x; const void* base_h;
    bf16_t* out; const float* gate;
    float* part; float coef; int pad_;
    DI void operator()(const Acc& acc, const Unit& u, int wr, int wc, int fr, int fq) const {
        asm volatile("" : "+v"(fr), "+v"(fq));
        const int col0 = u.pn * BM + wc * 32 + 8 * fq;
        const int midx = u.pm < (MX / BM) ? (u.pm >> 3) : 16;
        const float* gp = gate + (size_t)midx * NMOD + col0;
        f32x4 gv[2][2];
#pragma unroll
        for (int bj = 0; bj < 2; ++bj)
#pragma unroll
            for (int n = 0; n < 2; ++n) gv[bj][n] = *(const f32x4*)(gp + bj * HALF + n * 4) * coef;
        if (u.k0 != 0) {
            float* pbase = part + (size_t)(u.pm - MX / BM) * BM * D_MODEL;
#pragma unroll
            for (int ai = 0; ai < 2; ++ai)
#pragma unroll
                for (int m = 0; m < 4; ++m) { const size_t off = (size_t)(ai * HALF + wr * 64 + m * 16 + fr) * D_MODEL + col0;
#pragma unroll
                    for (int bj = 0; bj < 2; ++bj)
#pragma unroll
                        for (int n = 0; n < 2; ++n) *(f32x4*)(pbase + off + bj * HALF + n * 4) = gv[bj][n] * acc[ai][bj][m][n]; }
            return;
        }
        const size_t tile_off = u.pm < (MX / BM) ? (size_t)u.pm * BM * D_MODEL : (size_t)(u.pm - MX / BM) * BM * D_MODEL;
        const void* bsel = u.pm < (MX / BM) ? base_x : base_h;
        bf16_t* obase = out + (size_t)u.pm * BM * D_MODEL;
        const size_t off0 = (size_t)(wr * 64 + fr) * D_MODEL + col0;
        if (BASEF32) {
#pragma unroll
            for (int ai = 0; ai < 2; ++ai) { f32x4 bb[4][2][2];
#pragma unroll
                for (int m = 0; m < 4; ++m)
#pragma unroll
                    for (int bj = 0; bj < 2; ++bj) { const float* bp = (const float*)bsel + tile_off + off0 + (size_t)(ai * HALF + m * 16) * D_MODEL + bj * HALF; bb[m][bj][0] = *(const f32x4*)bp; bb[m][bj][1] = *(const f32x4*)(bp + 4); }
#pragma unroll
                for (int m = 0; m < 4; ++m)
#pragma unroll
                    for (int bj = 0; bj < 2; ++bj) { const f32x4 x0 = bb[m][bj][0] + gv[bj][0] * acc[ai][bj][m][0], x1 = bb[m][bj][1] + gv[bj][1] * acc[ai][bj][m][1];
                        *(u32x4*)(obase + off0 + (size_t)(ai * HALF + m * 16) * D_MODEL + bj * HALF) = pack8h(x0, x1); } }
        } else {
            u32x4 bb[2][4][2];
#pragma unroll
            for (int ai = 0; ai < 2; ++ai)
#pragma unroll
                for (int m = 0; m < 4; ++m)
#pragma unroll
                    for (int bj = 0; bj < 2; ++bj) bb[ai][m][bj] = *(const u32x4*)((const bf16_t*)bsel + tile_off + off0 + (size_t)(ai * HALF + m * 16) * D_MODEL + bj * HALF);
#pragma unroll
            for (int ai = 0; ai < 2; ++ai)
#pragma unroll
                for (int m = 0; m < 4; ++m)
#pragma unroll
                    for (int bj = 0; bj < 2; ++bj) { f32x4 b0, b1; unpack8h(bb[ai][m][bj], b0, b1);
                        const f32x4 x0 = b0 + gv[bj][0] * acc[ai][bj][m][0], x1 = b1 + gv[bj][1] * acc[ai][bj][m][1];
                        *(u32x4*)(obase + off0 + (size_t)(ai * HALF + m * 16) * D_MODEL + bj * HALF) = pack8h(x0, x1); }
        }
    }
};
DI void rope8(f32x4& x0, f32x4& x1, const float* rt, int fq) {
    const float* cp = rt + 2 * ((8 * fq) & 15);
    const f32x4 A = *(const f32x4*)cp, B = *(const f32x4*)(cp + 4), C = *(const f32x4*)(cp + 8), D = *(const f32x4*)(cp + 12);
    const f32x4 c0 = {A[0], A[2], B[0], B[2]}, s0 = {A[1], A[3], B[1], B[3]}, c1 = {C[0], C[2], D[0], D[2]}, s1 = {C[1], C[3], D[1], D[3]};
    const bool lo = fq < 2;
    f32x4 p0, p1;
#pragma unroll
    for (int j = 0; j < 4; ++j) {
        const auto r0 = __builtin_amdgcn_permlane32_swap(__float_as_uint(x0[j]), __float_as_uint(x0[j]), false, false);
        const auto r1 = __builtin_amdgcn_permlane32_swap(__float_as_uint(x1[j]), __float_as_uint(x1[j]), false, false);
        p0[j] = __uint_as_float(lo ? r0[1] : r0[0]); p1[j] = __uint_as_float(lo ? r1[1] : r1[0]); }
    const float sg = lo ? -1.f : 1.f;
    x0 = x0 * c0 + (p0 * s0) * sg; x1 = x1 * c1 + (p1 * s1) * sg;
}
struct EpiABIn {
    static constexpr bool PERM = true;
    bf16_t* Q; bf16_t* KV; bf16_t* Y; const float* rope; float qscale;
    DI void operator()(const Acc& acc, const Unit& u, int wr, int wc, int fr, int fq) const {
        asm volatile("" : "+v"(fr), "+v"(fq));
        const int rowt = u.pm * BM + wr * 64 + fr; const bool is_x = u.pm < (MX / BM);
        if (u.pn >= 3) {
            const int col0 = (u.pn - 3) * HALF + wc * 32 + 8 * fq;
#pragma unroll
            for (int ai = 0; ai < 2; ++ai)
#pragma unroll
                for (int m = 0; m < 4; ++m) { f32x4 v0, v1;
#pragma unroll
                    for (int j = 0; j < 4; ++j) { v0[j] = acc[ai][0][m][0][j] * sigmoid_f(acc[ai][1][m][0][j]); v1[j] = acc[ai][0][m][1][j] * sigmoid_f(acc[ai][1][m][1][j]); }
                    *(u32x4*)(Y + (size_t)(rowt + ai * HALF + m * 16) * 512 + col0) = pack8(v0, v1); }
        } else {
            const int a = wc & 1;
#pragma unroll
            for (int ai = 0; ai < 2; ++ai)
#pragma unroll
                for (int m = 0; m < 4; ++m) { const int row = rowt + ai * HALF + m * 16; const float* rt = rope + (size_t)(row & (SEQ - 1)) * 64 + a * 32;
#pragma unroll
                    for (int bj = 0; bj < 2; ++bj) { f32x4 x0 = acc[ai][bj][m][0], x1 = acc[ai][bj][m][1];
                        const bool do_rope = is_x && !(u.pn == 2 && bj == 1);
                        if (do_rope) rope8(x0, x1, rt, fq);
                        bf16_t* p;
                        if (u.pn < 2) { x0 = x0 * qscale; x1 = x1 * qscale; p = Q + (size_t)row * 512 + u.pn * BM + bj * HALF + wc * 32 + 8 * fq; }
                        else p = KV + (size_t)row * 256 + bj * HALF + wc * 32 + 8 * fq;
                        *(u32x4*)p = pack8(x0, x1); } }
        }
    }
};
struct EpiUq {
    static constexpr bool PERM = true;
    bf16_t* Q; const float* rope; float qscale;
    DI void operator()(const Acc& acc, const Unit& u, int wr, int wc, int fr, int fq) const {
        asm volatile("" : "+v"(fr), "+v"(fq));
        const int rowt = u.pm * BM + wr * 64 + fr;
#pragma unroll
        for (int ai = 0; ai < 2; ++ai)
#pragma unroll
            for (int m = 0; m < 4; ++m) { const int row = rowt + ai * HALF + m * 16;
#pragma unroll
                for (int bj = 0; bj < 2; ++bj) { const int blk = u.pn * 8 + bj * 4 + wc, bh = blk % 6;
                    f32x4 x0 = acc[ai][bj][m][0], x1 = acc[ai][bj][m][1];
                    if (bh >= 4) rope8(x0, x1, rope + (size_t)(row & (SEQ - 1)) * 64 + (bh - 4) * 32, fq);
                    x0 = x0 * qscale; x1 = x1 * qscale;
                    *(u32x4*)(Q + (size_t)row * 1536 + blk * 32 + 8 * fq) = pack8(x0, x1); } }
    }
};
}

struct AttnU {
    const bf16_t* Q; int ldq;
    const bf16_t* K1; int ldk1;
    const bf16_t* K2; int ldk2;
    const bf16_t* V; int ldv;
    bf16_t* O; int ldo;
    int nt_lat, lat_row0, kpos0, nt_ctx, ctx_row0, qpos0;
    float m0, l0;
};
#define MFMA32(a, b, c) __builtin_amdgcn_mfma_f32_32x32x16_bf16((a), (b), (c), 0, 0, 0)
typedef short v4i16_t __attribute__((ext_vector_type(4)));
DI s16x4 vtr(const LAS unsigned char* p) { return __builtin_bit_cast(s16x4, __builtin_amdgcn_ds_read_tr16_b64_v4i16((LAS v4i16_t*)p)); }
template <int DQK, int NK1, int DV, bool WINDOW, int DUMMY = 0>
DI void attn_unit(LAS unsigned char* lds, const AttnU& a) {
    constexpr int KSB = (DQK + 8) * 2, VROW = DV * 2 + 64, K_BYTES = 64 * KSB, BUF_BYTES = K_BYTES + 64 * VROW;
    constexpr int C1 = NK1 / 8, C2 = (DQK - NK1) / 8, CV = DV / 8;
    constexpr int L1 = C1 / 8, L2 = C2 / 8, LV = CV / 8, NKK = DQK / 16, NDB = DV / 32;
    int tid = threadIdx.x; asm volatile("" : "+v"(tid));
    const int lane = tid & 63, wid = __builtin_amdgcn_readfirstlane(tid >> 6), r = lane & 31, h = lane >> 5;
    bf16x8 qf[NKK];
    { const bf16_t* qrow = a.Q + (size_t)(wid * 32 + r) * a.ldq + 8 * h;
#pragma unroll
      for (int kk = 0; kk < NKK; ++kk) qf[kk] = *(const bf16x8*)(qrow + 16 * kk); }
    f32x16 o[NDB];
#pragma unroll
    for (int d = 0; d < NDB; ++d)
#pragma unroll
        for (int i = 0; i < 16; ++i) o[d][i] = 0.f;
    float m = a.m0, l = (h == 0) ? a.l0 : 0.f;
    const int nt = a.nt_lat + a.nt_ctx;
    u32x4 k1reg[L1 > 0 ? L1 : 1], k2reg[L2 > 0 ? L2 : 1], vreg[LV];
#define ATT_LOAD(j) do { const int grow_ = ((j) < a.nt_lat ? a.lat_row0 + 64 * (j) : a.ctx_row0 + 64 * ((j) - a.nt_lat)); \
        _Pragma("unroll") for (int i_ = 0; i_ < L1; ++i_) { const int x_ = tid + 512 * i_; k1reg[i_] = *(const u32x4*)(a.K1 + (size_t)(grow_ + x_ / C1) * a.ldk1 + (x_ % C1) * 8); } \
        _Pragma("unroll") for (int i_ = 0; i_ < L2; ++i_) { const int x_ = tid + 512 * i_; k2reg[i_] = *(const u32x4*)(a.K2 + (size_t)(grow_ + x_ / (C2 > 0 ? C2 : 1)) * a.ldk2 + (x_ % (C2 > 0 ? C2 : 1)) * 8); } \
        _Pragma("unroll") for (int i_ = 0; i_ < LV; ++i_) { const int x_ = tid + 512 * i_; vreg[i_] = *(const u32x4*)(a.V + (size_t)(grow_ + x_ / CV) * a.ldv + (x_ % CV) * 8); } } while (0)
#define ATT_STORE(buf) do { LAS unsigned char* Kw_ = lds + (buf) * BUF_BYTES; LAS unsigned char* Vw_ = Kw_ + K_BYTES; \
        _Pragma("unroll") for (int i_ = 0; i_ < L1; ++i_) { const int x_ = tid + 512 * i_; *(LAS u32x4*)(Kw_ + (x_ / C1) * KSB + (x_ % C1) * 16) = k1reg[i_]; } \
        _Pragma("unroll") for (int i_ = 0; i_ < L2; ++i_) { const int x_ = tid + 512 * i_; *(LAS u32x4*)(Kw_ + (x_ / (C2 > 0 ? C2 : 1)) * KSB + (C1 + x_ % (C2 > 0 ? C2 : 1)) * 16) = k2reg[i_]; } \
        _Pragma("unroll") for (int i_ = 0; i_ < LV; ++i_) { const int x_ = tid + 512 * i_; *(LAS u32x4*)(Vw_ + (x_ / CV) * VROW + (x_ % CV) * 16) = vreg[i_]; } } while (0)
    if (wid >= 4) __builtin_amdgcn_s_setprio(1);
    ATT_LOAD(0);
    __syncthreads();
    ATT_STORE(0);
    if (nt > 1) ATT_LOAD(1);
    __syncthreads();
    const int qp = a.qpos0 + wid * 32 + r;
    const int voff = (4 * h + ((lane & 15) >> 2)) * VROW + (16 * ((lane >> 4) & 1) + 4 * (lane & 3)) * 2;
    for (int j = 0; j < nt; ++j) {
        const int cur = j & 1;
        LAS unsigned char* Ks = lds + cur * BUF_BYTES; LAS unsigned char* Vs = Ks + K_BYTES + voff;
        bool active = true;
        const bool lat = j < a.nt_lat;
        if (WINDOW && lat) { const int kt = a.kpos0 + 64 * j, qw = a.qpos0 + wid * 32; active = (kt <= qw + 31 + 128) && (kt + 63 >= qw - 128); }
        if (active && DUMMY != 4) {
            f32x16 p0, p1;
#pragma unroll
            for (int i = 0; i < 16; ++i) { p0[i] = 0.f; p1[i] = 0.f; }
            {
                constexpr int KB = 2, NB = NKK / KB;
                bf16x8 ka[2][KB][2];
#pragma unroll
                for (int q = 0; q < KB; ++q) { ka[0][q][0] = *(const LAS bf16x8*)(Ks + r * KSB + q * 32 + h * 16); ka[0][q][1] = *(const LAS bf16x8*)(Ks + (32 + r) * KSB + q * 32 + h * 16); }
#pragma unroll
                for (int b = 0; b < NB; ++b) {
                    if (b + 1 < NB) {
#pragma unroll
                        for (int q = 0; q < KB; ++q) { const int kk = (b + 1) * KB + q;
                            ka[(b + 1) & 1][q][0] = *(const LAS bf16x8*)(Ks + r * KSB + kk * 32 + h * 16); ka[(b + 1) & 1][q][1] = *(const LAS bf16x8*)(Ks + (32 + r) * KSB + kk * 32 + h * 16); }
                    }
                    __builtin_amdgcn_sched_barrier(0);
#pragma unroll
                    for (int q = 0; q < KB; ++q) { p0 = MFMA32(ka[b & 1][q][0], qf[b * KB + q], p0); p1 = MFMA32(ka[b & 1][q][1], qf[b * KB + q], p1); }
                    __builtin_amdgcn_sched_barrier(0);
                }
            }
            constexpr int NDH = 1;
            s16x4 vlo[NDB][4], vhi[NDB][4];
            if (DUMMY != 2) {
#pragma unroll
            for (int d = 0; d < NDH; ++d)
#pragma unroll
                for (int s2 = 0; s2 < 4; ++s2) { vlo[d][s2] = vtr(Vs + (16 * s2) * VROW + 64 * d); vhi[d][s2] = vtr(Vs + (16 * s2 + 8) * VROW + 64 * d); }
            }
            __builtin_amdgcn_sched_barrier(0);
            if (WINDOW && lat) { const int kb = a.kpos0 + 64 * j + 4 * h;
#pragma unroll
                for (int i = 0; i < 16; ++i) { const int d0 = qp - (kb + (i & 3) + 8 * (i >> 2)); const int d1 = d0 - 32;
                    if (d0 > 128 || d0 < -128) p0[i] = -1e30f; if (d1 > 128 || d1 < -128) p1[i] = -1e30f; } }
            float mxa = max3f(p0[0], p0[1], p1[0]), mxb = max3f(p0[2], p0[3], p1[1]); mxa = max3f(mxa, p1[2], p1[3]);
#pragma unroll
            for (int i = 4; i < 16; i += 4) { mxa = max3f(mxa, p0[i], p0[i + 1]); mxb = max3f(mxb, p0[i + 2], p0[i + 3]); mxa = max3f(mxa, p1[i], p1[i + 1]); mxb = max3f(mxb, p1[i + 2], p1[i + 3]); }
            float mx = fmaxf(mxa, mxb);
            { const auto rr = __builtin_amdgcn_permlane32_swap(__float_as_uint(mx), __float_as_uint(mx), false, false); mx = fmaxf(__uint_as_float(rr[0]), __uint_as_float(rr[1])); }
            if (__any(mx > m + 8.f)) {
                const float mn = fmaxf(m, mx), alpha = fast_exp2(m - mn); m = mn; l *= alpha;
#pragma unroll
                for (int d = 0; d < NDB; ++d)
#pragma unroll
                    for (int i = 0; i < 16; ++i) o[d][i] *= alpha;
            }
            float sum = 0.f;
            if (DUMMY != 3) {
#pragma unroll
            for (int i = 0; i < 16; ++i) { p0[i] = fast_exp2(p0[i] - m); p1[i] = fast_exp2(p1[i] - m); }
            { f32x2 sa = {p0[0], p0[1]}, sb = {p1[0], p1[1]};
#pragma unroll
              for (int i = 2; i < 16; i += 2) { sa += (f32x2){p0[i], p0[i + 1]}; sb += (f32x2){p1[i], p1[i + 1]}; }
              sa += sb; sum = sa[0] + sa[1]; }
            } else sum = 1.f;
            l += sum;
            bf16x8 pb[4];
#pragma unroll
            for (int s = 0; s < 4; ++s) { u32x4 w;
#pragma unroll
                for (int q2 = 0; q2 < 4; ++q2) { const int i = 8 * (s & 1) + 2 * q2; w[q2] = (s < 2) ? cvt_pk_bf16(p0[i], p0[i + 1]) : cvt_pk_bf16(p1[i], p1[i + 1]); }
                pb[s] = __builtin_bit_cast(bf16x8, w); }
            __builtin_amdgcn_sched_barrier(0);
            if (DUMMY == 2) { o[0][0] += __builtin_bit_cast(float, (int)pb[0][0] | ((int)pb[1][1] << 8) | ((int)pb[2][2] << 16) ^ (int)pb[3][3]); }
            else
#pragma unroll
            for (int d = 0; d < NDB; ++d) {
                if (d + 1 < NDB) {
#pragma unroll
                    for (int s2 = 0; s2 < 4; ++s2) { vlo[d + 1][s2] = vtr(Vs + (16 * s2) * VROW + 64 * (d + 1)); vhi[d + 1][s2] = vtr(Vs + (16 * s2 + 8) * VROW + 64 * (d + 1)); }
                }
                __builtin_amdgcn_sched_barrier(0);
#pragma unroll
                for (int s2 = 0; s2 < 4; ++s2) { const bf16x8 av = __builtin_shufflevector(vlo[d][s2], vhi[d][s2], 0, 1, 2, 3, 4, 5, 6, 7); o[d] = MFMA32(av, pb[s2], o[d]); }
                __builtin_amdgcn_sched_barrier(0);
            }
        }
        if (j + 1 < nt) ATT_STORE(cur ^ 1);
        __syncthreads();
        if (j + 2 < nt) ATT_LOAD(j + 2);
    }
#undef ATT_LOAD
#undef ATT_STORE
    __builtin_amdgcn_s_setprio(0);
    { const auto rr = __builtin_amdgcn_permlane32_swap(__float_as_uint(l), __float_as_uint(l), false, false); l = __uint_as_float(rr[0]) + __uint_as_float(rr[1]); }
    const float inv = 1.f / l;
    bf16_t* orow = a.O + (size_t)(wid * 32 + r) * a.ldo;
#pragma unroll
    for (int d = 0; d < NDB; ++d)
#pragma unroll
        for (int g = 0; g < 4; ++g) { f32x4 v = {o[d][4 * g] * inv, o[d][4 * g + 1] * inv, o[d][4 * g + 2] * inv, o[d][4 * g + 3] * inv};
            if (!DUMMY || inv < 0.f) *(u32x2*)(orow + 32 * d + 8 * g + 4 * h) = pack4(v); }
}

DI void conv_unit(LAS unsigned char* lds, const bf16_t* Y, int row_base, int seqlen, int t0, const float* wdw, const float* bdw, const float* lng, const float* lnb, bf16_t* out) {
    int c = threadIdx.x; asm volatile("" : "+v"(c));
    const int lane = c & 63, wid = c >> 6;
    float in[62];
#pragma unroll
    for (int i = 0; i < 62; ++i) { const int t = t0 - 15 + i; in[i] = (t >= 0 && t < seqlen) ? bf2f(Y[(size_t)(row_base + t) * 512 + c]) : 0.f; }
    float w[31];
#pragma unroll
    for (int j = 0; j < 31; ++j) w[j] = wdw[j * 512 + c];
    const float bias = bdw[c];
    LAS float* buf = (LAS float*)lds;
    __syncthreads();
#pragma unroll
    for (int t = 0; t < 32; ++t) { float acc = bias;
#pragma unroll
        for (int j = 0; j < 31; ++j) acc += w[j] * in[t + j];
        buf[t * 516 + c] = acc; }
    __syncthreads();
#pragma unroll
    for (int tt = 0; tt < 4; ++tt) { const int t = wid * 4 + tt;
        const f32x4 v0 = *(const LAS f32x4*)(buf + t * 516 + lane * 8), v1 = *(const LAS f32x4*)(buf + t * 516 + lane * 8 + 4);
        const float mean = wave_sum((v0[0] + v0[1]) + (v0[2] + v0[3]) + (v1[0] + v1[1]) + (v1[2] + v1[3])) * (1.f / 512.f);
        const f32x4 d0 = v0 - mean, d1 = v1 - mean;
        const float var = wave_sum((d0[0] * d0[0] + d0[1] * d0[1]) + (d0[2] * d0[2] + d0[3] * d0[3]) + (d1[0] * d1[0] + d1[1] * d1[1]) + (d1[2] * d1[2] + d1[3] * d1[3])) * (1.f / 512.f);
        const float rstd = 1.f / sqrtf(var + 1e-5f);
        const f32x4 g0 = *(const f32x4*)(lng + lane * 8), g1 = *(const f32x4*)(lng + lane * 8 + 4), b0 = *(const f32x4*)(lnb + lane * 8), b1 = *(const f32x4*)(lnb + lane * 8 + 4);
        f32x4 y0 = d0 * rstd * g0 + b0, y1 = d1 * rstd * g1 + b1;
#pragma unroll
        for (int j = 0; j < 4; ++j) { y0[j] = y0[j] * sigmoid_f(y0[j]); y1[j] = y1[j] * sigmoid_f(y1[j]); }
        u32x4 wv; wv.x = cvt_pk_bf16(y0[0], y0[1]); wv.y = cvt_pk_bf16(y0[2], y0[3]); wv.z = cvt_pk_bf16(y1[0], y1[1]); wv.w = cvt_pk_bf16(y1[2], y1[3]);
        *(u32x4*)(out + (size_t)(row_base + t0 + t) * 1024 + 512 + lane * 8) = wv; }
}


#define XB_TMO      128
#define XB_XCNT(j)  (256  + 64 * (j))
#define XB_XSUB(j)  (1280 + 64 * (j))
#define XB_XGEN(j)  (2304 + 64 * (j))
#define XB_TOP      3328
#define XB_TOPGEN   3392
#define XCD_BAR_WORDS 3456
#define XB_SPIN_CAP (1u << 22)
DI unsigned xb_ld(unsigned* p)              { return __hip_atomic_load(p, __ATOMIC_RELAXED, __HIP_MEMORY_SCOPE_AGENT); }
DI unsigned xb_add(unsigned* p, unsigned v) { return __hip_atomic_fetch_add(p, v, __ATOMIC_RELAXED, __HIP_MEMORY_SCOPE_AGENT); }
DI unsigned xb_xcc_id() { return (unsigned)__builtin_amdgcn_s_getreg((3 << 11) | 20) & 0xFu; }
#define XB_SPIN(cond, bar) do { unsigned _sp = 0; while (cond) { __builtin_amdgcn_s_sleep(1); \
    if ((++_sp & 255u) == 0u) { if (xb_ld(&(bar)[XB_TMO])) break; if (_sp > XB_SPIN_CAP) { atomicAdd(&(bar)[XB_TMO], 1u); break; } } } } while (0)
struct XcdBarrier { unsigned* bar; unsigned x; volatile LAS unsigned* st; };
DI XcdBarrier xcd_barrier_post(unsigned* bar, volatile LAS unsigned* st) {
    XcdBarrier b; b.bar = bar; b.x = xb_xcc_id(); b.st = st;
    if (threadIdx.x == 0) (void)xb_add(&bar[XB_XCNT(b.x)], 1u);
    return b;
}
DI void xcd_barrier_complete(unsigned* bar, unsigned x, unsigned& nloc, unsigned& nx) {
    const unsigned G = gridDim.x * gridDim.y * gridDim.z;
    unsigned sum, cnt, mine, sp = 0u;
    for (;;) {
        sum = 0u; cnt = 0u; mine = 0u;
#pragma unroll
        for (unsigned j = 0; j < 16; ++j) { const unsigned c = xb_ld(&bar[XB_XCNT(j)]); sum += c; cnt += (c > 0u) ? 1u : 0u; mine = (j == x) ? c : mine; }
        if (sum == G) break;
        __builtin_amdgcn_s_sleep(1);
        if ((++sp & 255u) == 0u) { if (xb_ld(&bar[XB_TMO])) break; if (sp > XB_SPIN_CAP) { atomicAdd(&bar[XB_TMO], 1u); break; } }
    }
    nloc = mine > 0u ? mine : 1u; nx = cnt > 0u ? cnt : 1u;
}
DI void xcd_barrier(const XcdBarrier& b) {
    asm volatile("s_waitcnt vmcnt(0)" ::: "memory");
    __syncthreads();
    if (threadIdx.x == 0) {
        unsigned* bar = b.bar;
        __builtin_amdgcn_s_waitcnt(0);
        unsigned nloc = b.st[0], nx = b.st[1];
        if (nloc == 0u) { xcd_barrier_complete(bar, b.x, nloc, nx); b.st[0] = nloc; b.st[1] = nx; }
        const unsigned old = xb_add(&bar[XB_XSUB(b.x)], 1u);
        const unsigned gen = old / nloc;
        if (old + 1u == (gen + 1u) * nloc) {
            __builtin_amdgcn_fence(__ATOMIC_RELEASE, "agent");
            asm volatile("s_waitcnt vmcnt(0)" ::: "memory");
            const unsigned og = xb_add(&bar[XB_TOP], 1u);
            const unsigned tg = og / nx;
            if (og + 1u == (tg + 1u) * nx) xb_add(&bar[XB_TOPGEN], 1u);
            else XB_SPIN(xb_ld(&bar[XB_TOPGEN]) == tg, bar);
            __builtin_amdgcn_fence(__ATOMIC_ACQUIRE, "agent");
            xb_add(&bar[XB_XGEN(b.x)], 1u);
            asm volatile("s_waitcnt vmcnt(0)" ::: "memory");
        } else {
            XB_SPIN(xb_ld(&bar[XB_XGEN(b.x)]) == gen, bar);
            __builtin_amdgcn_fence(__ATOMIC_ACQUIRE, "agent");
            asm volatile("s_waitcnt vmcnt(0)" ::: "memory");
        }
    }
    __syncthreads();
}

struct Job { const float* src; bf16_t* dst; int K, N, ldd, map, row_off, item0; };
constexpr int NJOBS = 16;
struct Args {
    const float* in[25]; float* out; unsigned char* ws;
    Job jobs[NJOBS]; int nitems; int pad;
};

DI int job_rowmap(int map, int row_off, int n0) {
    if (map == 1) return n0 < D_FF ? 256 * (n0 / 128) + (n0 % 128) : 256 * ((n0 - D_FF) / 128) + 128 + ((n0 - D_FF) % 128);
    if (map == 2) return n0 < 768 ? n0 : (n0 < 1280 ? 768 + 256 * ((n0 - 768) / 128) + ((n0 - 768) % 128) : 768 + 256 * ((n0 - 1280) / 128) + 128 + ((n0 - 1280) % 128));
    return row_off + n0;
}
DI void transpose_item(const Job& jb, LAS float* scr, int item, int lane) {
    const int nblk = jb.N / 32, kb = item / nblk, nb = item % nblk, k0 = 64 * kb, n0 = 32 * nb;
    const float* W = jb.src; const int N = jb.N;
    float wv[32];
#pragma unroll
    for (int i = 0; i < 32; ++i) { const int kk = 2 * i + (lane >> 5); wv[i] = W[(size_t)(k0 + kk) * N + n0 + (lane & 31)]; }
#pragma unroll
    for (int i = 0; i < 32; ++i) { const int kk = 2 * i + (lane >> 5); scr[kk * 33 + (lane & 31)] = wv[i]; }
    asm volatile("s_waitcnt lgkmcnt(0)" ::: "memory");
    const int c = lane & 7;
    const int drow0 = job_rowmap(jb.map, jb.row_off, n0);
    const int kd0 = (jb.map == 3) ? (k0 / 128) * 192 + (k0 % 128) : k0;
#pragma unroll
    for (int j = 0; j < 4; ++j) { const int n = (lane >> 3) + 8 * j; const LAS float* s = scr + (8 * c) * 33 + n;
        u32x4 o; o.x = cvt_pk_bf16(s[0 * 33], s[1 * 33]); o.y = cvt_pk_bf16(s[2 * 33], s[3 * 33]); o.z = cvt_pk_bf16(s[4 * 33], s[5 * 33]); o.w = cvt_pk_bf16(s[6 * 33], s[7 * 33]);
        *(u32x4*)(jb.dst + (size_t)(drow0 + n) * jb.ldd + kd0 + 8 * c) = o; }
    asm volatile("s_waitcnt lgkmcnt(0)" ::: "memory");
}

template <bool SRCF32>
DI void norm_mod_row(const void* xrow, const float* g, const float* shift, const float* scale, bf16_t* orow, int lane, const float* addp, bf16_t* wb) {
    f32x4 v[4]; float s = 0.f;
#pragma unroll
    for (int j = 0; j < 2; ++j) { const int c = 8 * (lane + 64 * j);
        if (SRCF32) { v[2 * j] = *(const f32x4*)((const float*)xrow + c); v[2 * j + 1] = *(const f32x4*)((const float*)xrow + c + 4); }
        else unpack8h(*(const u32x4*)((const bf16_t*)xrow + c), v[2 * j], v[2 * j + 1]); }
    if (addp) {
#pragma unroll
        for (int j = 0; j < 2; ++j) { const int c = 8 * (lane + 64 * j); v[2 * j] = v[2 * j] + *(const f32x4*)(addp + c); v[2 * j + 1] = v[2 * j + 1] + *(const f32x4*)(addp + c + 4);
            *(u32x4*)(wb + c) = pack8h(v[2 * j], v[2 * j + 1]); } }
#pragma unroll
    for (int j = 0; j < 4; ++j) s += (v[j][0] * v[j][0] + v[j][1] * v[j][1]) + (v[j][2] * v[j][2] + v[j][3] * v[j][3]);
    const float rstd = 1.f / sqrtf(wave_sum(s) * (1.f / D_MODEL) + 1e-6f);
#pragma unroll
    for (int j = 0; j < 2; ++j) { const int c = 8 * (lane + 64 * j);
        const f32x4 y0 = (v[2 * j] * rstd * *(const f32x4*)(g + c)) * (*(const f32x4*)(scale + c) + 1.f) + *(const f32x4*)(shift + c);
        const f32x4 y1 = (v[2 * j + 1] * rstd * *(const f32x4*)(g + c + 4)) * (*(const f32x4*)(scale + c + 4) + 1.f) + *(const f32x4*)(shift + c + 4);
        *(u32x4*)(orow + c) = pack8(y0, y1); }
}

__global__ void __launch_bounds__(512, 2) fwd_kernel(Args args) {
    extern __shared__ __attribute__((aligned(16))) unsigned char lds_raw[];
    LAS unsigned char* lds = (LAS unsigned char*)lds_raw;
    cg::grid_group grid = cg::this_grid();
    const int G = gridDim.x, bx = blockIdx.x;
    const int vcu = (G % 8 == 0) ? (bx % 8) * (G / 8) + bx / 8 : bx;
    const int NGW = G * 8;
#define FRESH_IDS int tid = threadIdx.x; asm volatile("" : "+v"(tid)); const int lane = tid & 63, wave = __builtin_amdgcn_readfirstlane(tid >> 6); const int gw = vcu * 8 + wave; (void)lane; (void)gw;
    unsigned char* ws = args.ws;
    const float* x_in = args.in[0]; const float* c_in = args.in[1]; const float* ctx_in = args.in[2]; const float* cctx_in = args.in[3];
    const float* w_mod = args.in[4]; const float* b_mod = args.in[5]; const float* g_norm = args.in[6];
    const float* a_sink = args.in[10]; const float* b_w_dw = args.in[11]; const float* b_b_dw = args.in[12]; const float* b_ln_g = args.in[13]; const float* b_ln_b = args.in[14];
    const float* c_g_q = args.in[17]; const float* c_g_kv = args.in[20]; const float* g_final = args.in[24];
    float* rope = (float*)(ws + WS_ROPE); float* mod = (float*)(ws + WS_MOD);
    bf16_t* xs = (bf16_t*)(ws + WS_XS);
    unsigned char* R = ws + WS_R;

    volatile LAS unsigned* bar_st = (volatile LAS unsigned*)(lds + 131072);
    unsigned* bar_words = (unsigned*)(ws + WS_BAR);
    {
        FRESH_IDS
        if (tid < 2) bar_st[tid] = 0u;
        if (bx == 0) for (int i = tid; i < XCD_BAR_WORDS; i += 512) bar_words[i] = 0u;
        LAS float* scr = (LAS float*)(lds + wave * 8704);
        for (int rep = 0; rep < (PROBE == 6 ? 2 : 1); ++rep) {
        __syncthreads();
        for (int it = gw; it < args.nitems; it += NGW) {
            int ji = 0;
#pragma unroll
            for (int q = 1; q < NJOBS; ++q) if (it >= args.jobs[q].item0) ji = q;
            Job jb = args.jobs[0];
#pragma unroll
            for (int q = 1; q < NJOBS; ++q) if (ji == q) jb = args.jobs[q];
            transpose_item(jb, scr, it - jb.item0, lane);
        }
        { bf16_t* wd = (bf16_t*)(ws + WS_WD) + (size_t)576 * 1024; const int n16 = 192 * 1024 / 8;
          for (int i = bx * 512 + tid; i < n16; i += G * 512) ((u32x4*)wd)[i] = (u32x4){0u, 0u, 0u, 0u};
          bf16_t* wo = (bf16_t*)(ws + WS_WO);
          for (int i = bx * 512 + tid; i < 1024 * 8 * 8; i += G * 512) { const int row = i >> 6, hh = (i >> 3) & 7, ch = i & 7; *(u32x4*)(wo + (size_t)row * 1536 + hh * 192 + 128 + ch * 8) = (u32x4){0u, 0u, 0u, 0u}; } }
        for (int i = bx * 512 + tid; i < SEQ * 32; i += G * 512) { const int t = i >> 5, ai = i & 31, a = ai >> 4, ii = ai & 15;
            const float inv_freq = powf(10000.0f, -(float)(2 * ii) / 32.0f); const float pos = a == 0 ? (float)(t >> 6) : (float)(t & 63); const float ang = pos * inv_freq;
            rope[2 * i] = cosf(ang); rope[2 * i + 1] = sinf(ang); }
        __syncthreads();
        LAS float* sl = (LAS float*)lds;
        LAS float* red = (LAS float*)(lds + 17 * 1024 * 4);
        for (int i = tid; i < 17 * 1024; i += 512) { const float v = i < 16 * 1024 ? c_in[i] : cctx_in[i - 16 * 1024]; sl[i] = v / (1.f + expf(-v)); }
        __syncthreads();
        const int ks = tid >> 5, col = tid & 31;
        for (int u = vcu; u < 2 * (NMOD / 32); u += G) { const int l = u / (NMOD / 32), c0 = (u % (NMOD / 32)) * 32;
            float acc[17];
#pragma unroll
            for (int r = 0; r < 17; ++r) acc[r] = 0.f;
            const float* wp = w_mod + (size_t)l * D_MODEL * NMOD + (size_t)(ks * 64) * NMOD + c0 + col;
#pragma unroll 4
            for (int k = 0; k < 64; ++k) { const float wv = wp[(size_t)k * NMOD];
#pragma unroll
                for (int r = 0; r < 17; ++r) acc[r] += sl[r * 1024 + ks * 64 + k] * wv; }
#pragma unroll
            for (int r = 0; r < 17; ++r) red[(ks * 17 + r) * 32 + col] = acc[r];
            __syncthreads();
            for (int i = tid; i < 17 * 32; i += 512) { const int r = i >> 5, cc = i & 31; float s = b_mod[l * NMOD + c0 + cc];
#pragma unroll
                for (int q = 0; q < 16; ++q) s += red[(q * 17 + r) * 32 + cc];
                mod[((size_t)l * 17 + r) * NMOD + c0 + cc] = s; }
            __syncthreads();
        }
        }
    }
    grid.sync();
    const XcdBarrier xbar = xcd_barrier_post(bar_words, bar_st);
#define GSYNC() xcd_barrier(xbar)

#define NORM_PHASE(F32, LAYER, WHICH, SRCX, SRCH, DST, MROWS) do { FRESH_IDS \
        const float* g_ = g_norm + ((LAYER) * 3 + (WHICH)) * D_MODEL; const float* modl_ = mod + (size_t)(LAYER) * 17 * NMOD + (size_t)(3 * (WHICH)) * D_MODEL; \
        for (int row_ = gw; row_ < (MROWS); row_ += NGW) { const int mi_ = row_ < MX ? row_ / SEQ : 16; \
            const void* xr_ = row_ < MX ? (const void*)((SRCX) + (size_t)row_ * D_MODEL) : (const void*)((SRCH) + (size_t)(row_ - MX) * D_MODEL); \
            norm_mod_row<F32>(xr_, g_, modl_ + (size_t)mi_ * NMOD, modl_ + (size_t)mi_ * NMOD + D_MODEL, (DST) + (size_t)row_ * D_MODEL, lane, (!((LAYER) == 0 && (WHICH) == 0) && row_ >= MX) ? (const float*)(R + R_PART) + (size_t)(row_ - MX) * D_MODEL : (const float*)nullptr, xs + (size_t)row_ * D_MODEL); } } while (0)

#define FFN_PHASES(F32, LAYER, WHICH, S, SRCX, SRCH, MROWS) do { \
        NORM_PHASE(F32, LAYER, WHICH, SRCX, SRCH, (bf16_t*)(R + R_XN), MROWS); \
        GSYNC(); \
        if (PROBE == 2) { pg8::Gemm g_{(const bf16_t*)(R + R_XN), (const bf16_t*)(ws + WS_WIN + (size_t)((LAYER) * 2 + (S)) * W_IN_BYTES), (MROWS), 2 * D_FF, D_MODEL, D_MODEL, D_MODEL}; \
          pg8::StaticOrder S_; S_.init((MROWS), 2 * D_FF, D_MODEL, G, bx); pg8::EpiSwiglu E_{(bf16_t*)(R + R_ACT), D_FF}; pg8::gemm_phase(lds, g_, S_, E_); GSYNC(); } \
        { pg8::Gemm g_{(const bf16_t*)(R + R_XN), (const bf16_t*)(ws + WS_WIN + (size_t)((LAYER) * 2 + (S)) * W_IN_BYTES), (MROWS), 2 * D_FF, D_MODEL, D_MODEL, D_MODEL}; \
          pg8::StaticOrder S_; S_.init((MROWS), 2 * D_FF, D_MODEL, G, bx); pg8::EpiSwiglu E_{(bf16_t*)(R + R_ACT), D_FF}; pg8::gemm_phase(lds, g_, S_, E_); } \
        GSYNC(); \
        { pg8::Gemm g_{(const bf16_t*)(R + R_ACT), (const bf16_t*)(ws + WS_WOUT + (size_t)((LAYER) * 2 + (S)) * W_OUT_BYTES), (MROWS), D_MODEL, D_FF, D_FF, D_FF}; \
          pg8::EpiResid<F32> E_{(SRCX), (SRCH), xs, mod + (size_t)(LAYER) * 17 * NMOD + (size_t)(3 * (WHICH) + 2) * D_MODEL, (float*)(R + R_PART), 0.5f, 0}; \
          if ((MROWS) == MT) { pg8::SplitOrder S_; S_.init(D_MODEL, D_FF, G, bx); pg8::gemm_phase(lds, g_, S_, E_); } \
          else { pg8::StaticOrder S_; S_.init((MROWS), D_MODEL, D_FF, G, bx); pg8::gemm_phase(lds, g_, S_, E_); } } \
        GSYNC(); if (PROBE == 5) { GSYNC(); GSYNC(); GSYNC(); GSYNC(); GSYNC(); } } while (0)

    const bf16_t* xs_h = xs + (size_t)MX * D_MODEL;
    FFN_PHASES(true, 0, 0, 0, x_in, ctx_in, MT);
    NORM_PHASE(false, 0, 1, xs, xs_h, (bf16_t*)(R + R_XN), MT);
    GSYNC();
    { pg8::Gemm g_{(const bf16_t*)(R + R_XN), (const bf16_t*)(ws + WS_WABIN), MT, 1792, D_MODEL, D_MODEL, D_MODEL};
      pg8::StaticOrder S_; S_.init(MT, 1792, D_MODEL, G, bx);
      pg8::EpiABIn E_{(bf16_t*)(R + R_Q), (bf16_t*)(R + R_KV), (bf16_t*)(R + R_Y), rope, 0.125f * LOG2E}; pg8::gemm_phase(lds, g_, S_, E_); }
    GSYNC();
    {
        const bf16_t* Qb = (const bf16_t*)(R + R_Q); const bf16_t* KVb = (const bf16_t*)(R + R_KV); bf16_t* cat = (bf16_t*)(R + R_CAT);
        for (int rep = 0; rep < (PROBE == 4 ? 2 : 1); ++rep) {
        const int apw = (1152 + G - 1) / G;
        for (int u = vcu * apw; u < vcu * apw + apw; ++u) {
            if (u >= 1152) break;
            AttnU a; int b, hq;
            if (u < 1024) { b = u >> 6; hq = (u >> 3) & 7; const int qb = u & 7; const int q0 = qb * 256;
                const int lo = q0 - 128 < 0 ? 0 : q0 - 128, hi = q0 + 384 > SEQ ? SEQ : q0 + 384;
                a.Q = Qb + (size_t)(b * SEQ + q0) * 512 + hq * 64; a.O = cat + (size_t)(b * SEQ + q0) * 1024 + hq * 64;
                a.nt_lat = (hi - lo) / 64; a.lat_row0 = b * SEQ + lo; a.kpos0 = lo; a.qpos0 = q0;
            } else { const int v = u - 1024; b = v >> 3; hq = v & 7;
                a.Q = Qb + (size_t)(MX + b * CTX) * 512 + hq * 64; a.O = cat + (size_t)(MX + b * CTX) * 1024 + hq * 64;
                a.nt_lat = 0; a.lat_row0 = 0; a.kpos0 = 0; a.qpos0 = 0; }
            a.ldq = 512; a.ldo = 1024; const int hkv = hq >> 2;
            a.K1 = KVb + hkv * 64; a.ldk1 = 256; a.K2 = a.K1; a.ldk2 = 256; a.V = KVb + 128 + hkv * 64; a.ldv = 256;
            a.nt_ctx = 4; a.ctx_row0 = MX + b * CTX; a.m0 = a_sink[hq] * LOG2E; a.l0 = 1.f;
            attn_unit<64, 64, 64, true>(lds, a);
        }
        __syncthreads();
        for (int u = vcu; u < 1152; u += G) { int row_base, seqlen, t0;
            if (u < 1024) { row_base = (u >> 6) * SEQ; seqlen = SEQ; t0 = (u & 63) * 32; } else { const int v = u - 1024; row_base = MX + (v >> 3) * CTX; seqlen = CTX; t0 = (v & 7) * 32; }
            conv_unit(lds, (const bf16_t*)(R + R_Y), row_base, seqlen, t0, b_w_dw, b_b_dw, b_ln_g, b_ln_b, cat); }
        }
    }
    GSYNC();
    { pg8::Gemm g_{(const bf16_t*)(R + R_CAT), (const bf16_t*)(ws + WS_WABOUT), MT, D_MODEL, D_MODEL, D_MODEL, D_MODEL};
      pg8::SplitOrder S_; S_.init(D_MODEL, D_MODEL, G, bx);
      pg8::EpiResid<false> E_{xs, xs_h, xs, mod + (size_t)5 * D_MODEL, (float*)(R + R_PART), 1.0f, 0}; pg8::gemm_phase(lds, g_, S_, E_); }
    GSYNC();
    FFN_PHASES(false, 0, 2, 1, xs, xs_h, MT);

    FFN_PHASES(false, 1, 0, 0, xs, xs_h, MT);
    NORM_PHASE(false, 1, 1, xs, xs_h, (bf16_t*)(R + R_XN), MT);
    GSYNC();
    { pg8::Gemm g_{(const bf16_t*)(R + R_XN), (const bf16_t*)(ws + WS_WD), MT, 768, D_MODEL, D_MODEL, D_MODEL};
      pg8::StaticOrder S_; S_.init(MT, 768, D_MODEL, G, bx);
      pg8::EpiPlain E_{(bf16_t*)(R + R_D), (bf16_t*)(R + R_D), 1000, LDD, LDD}; pg8::gemm_phase(lds, g_, S_, E_); }
    GSYNC();
    {
        FRESH_IDS
        bf16_t* Db = (bf16_t*)(R + R_D);
        for (int row = gw; row < MT; row += NGW) { bf16_t* dr = Db + (size_t)row * LDD;
            const u32x2 qa = ((const u32x2*)dr)[lane], ka = ((const u32x2*)(dr + 256))[lane]; const float kr = bf2f(dr[512 + lane]);
            f32x4 q = {__uint_as_float(qa.x << 16), __uint_as_float(qa.x & 0xffff0000u), __uint_as_float(qa.y << 16), __uint_as_float(qa.y & 0xffff0000u)};
            f32x4 k = {__uint_as_float(ka.x << 16), __uint_as_float(ka.x & 0xffff0000u), __uint_as_float(ka.y << 16), __uint_as_float(ka.y & 0xffff0000u)};
            const float rq = 1.f / sqrtf(wave_sum((q[0] * q[0] + q[1] * q[1]) + (q[2] * q[2] + q[3] * q[3])) * (1.f / 256.f) + 1e-6f);
            const float rk = 1.f / sqrtf(wave_sum((k[0] * k[0] + k[1] * k[1]) + (k[2] * k[2] + k[3] * k[3])) * (1.f / 256.f) + 1e-6f);
            q = q * rq * ((const f32x4*)c_g_q)[lane]; k = k * rk * ((const f32x4*)c_g_kv)[lane];
            float kro = kr;
            const float partner = __shfl_xor(kr, 16);
            if (row < MX) { const int t = row & (SEQ - 1); const float cs = rope[(size_t)t * 64 + ((lane >> 5) * 16 + (lane & 15)) * 2], sn = rope[(size_t)t * 64 + ((lane >> 5) * 16 + (lane & 15)) * 2 + 1];
                const float rot = (lane & 16) ? partner : -partner; kro = kr * cs + rot * sn; }
            ((u32x2*)dr)[lane] = pack4(q); ((u32x2*)(dr + 256))[lane] = pack4(k); dr[512 + lane] = (bf16_t)(cvt_pk_bf16(kro, 0.f) & 0xffffu); }
    }
    GSYNC();
    { pg8::Gemm g_{(const bf16_t*)(R + R_D), (const bf16_t*)(ws + WS_WUQ), MX, 1536, 256, LDD, 256};
      pg8::StaticOrder S_; S_.init(MX, 1536, 256, G, bx);
      pg8::EpiUq E_{(bf16_t*)(R + R_Q2), rope, 0.07216878364870322f * LOG2E}; pg8::gemm_phase(lds, g_, S_, E_); }
    { pg8::Gemm g_{(const bf16_t*)(R + R_D) + 256, (const bf16_t*)(ws + WS_WUKV), MT, 2048, 256, LDD, 256};
      pg8::StaticOrder S_; S_.init(MT, 2048, 256, G, bx);
      pg8::EpiPlain E_{(bf16_t*)(R + R_KN), (bf16_t*)(R + R_V), 4, D_MODEL, 1 << 30}; pg8::gemm_phase(lds, g_, S_, E_); }
    GSYNC();
    {
        bf16_t* Q2 = (bf16_t*)(R + R_Q2); const bf16_t* Kn = (const bf16_t*)(R + R_KN); const bf16_t* Db = (const bf16_t*)(R + R_D); const bf16_t* Vb = (const bf16_t*)(R + R_V);
        const int mpw = (1024 + G - 1) / G;
        for (int u = vcu * mpw; u < vcu * mpw + mpw; ++u) { if (u >= 1024) break; const int b = u >> 6, hh = (u >> 3) & 7, qb = u & 7;
            AttnU a; a.Q = Q2 + (size_t)(b * SEQ + qb * 256) * 1536 + hh * 192; a.ldq = 1536; a.O = Q2 + (size_t)(b * SEQ + qb * 256) * 1536 + hh * 192; a.ldo = 1536;
            a.K1 = Kn + hh * 128; a.ldk1 = D_MODEL; a.K2 = Db + 512; a.ldk2 = LDD; a.V = Vb + hh * 128; a.ldv = D_MODEL;
            a.nt_lat = SEQ / 64; a.lat_row0 = b * SEQ; a.kpos0 = 0; a.nt_ctx = 4; a.ctx_row0 = MX + b * CTX; a.qpos0 = 0; a.m0 = -1e30f; a.l0 = 0.f;
            if (PROBE == 1) attn_unit<192, 128, 128, false, 1>(lds, a);
            if (PROBE == 7) attn_unit<192, 128, 128, false, 4>(lds, a);
            if (PROBE == 8) attn_unit<192, 128, 128, false, 3>(lds, a);
            if (PROBE == 9) attn_unit<192, 128, 128, false, 2>(lds, a);
            attn_unit<192, 128, 128, false>(lds, a); }
        __syncthreads();
    }
    GSYNC();
    { pg8::Gemm g_{(const bf16_t*)(R + R_Q2), (const bf16_t*)(ws + WS_WO), MX, D_MODEL, 1536, 1536, 1536};
      pg8::StaticOrder S_; S_.init(MX, D_MODEL, 1536, G, bx);
      pg8::EpiResid<false> E_{xs, xs_h, xs, mod + (size_t)17 * NMOD + (size_t)5 * D_MODEL, (float*)(R + R_PART), 1.0f, 0}; pg8::gemm_phase(lds, g_, S_, E_); }
    GSYNC();
    FFN_PHASES(false, 1, 2, 1, xs, xs_h, MX);
    FRESH_IDS
    for (int row = gw; row < MX; row += NGW) { const bf16_t* xr = xs + (size_t)row * D_MODEL;
        f32x4 v[4]; float sq = 0.f;
#pragma unroll
        for (int j = 0; j < 2; ++j) unpack8h(*(const u32x4*)(xr + 8 * (lane + 64 * j)), v[2 * j], v[2 * j + 1]);
#pragma unroll
        for (int j = 0; j < 4; ++j) sq += (v[j][0] * v[j][0] + v[j][1] * v[j][1]) + (v[j][2] * v[j][2] + v[j][3] * v[j][3]);
        const float rstd = 1.f / sqrtf(wave_sum(sq) * (1.f / D_MODEL) + 1e-6f);
        float* orow = args.out + (size_t)row * D_MODEL;
#pragma unroll
        for (int j = 0; j < 2; ++j) { const int c = 8 * (lane + 64 * j);
            *(f32x4*)(orow + c) = v[2 * j] * rstd * *(const f32x4*)(g_final + c); *(f32x4*)(orow + c + 4) = v[2 * j + 1] * rstd * *(const f32x4*)(g_final + c + 4); } }
}

extern "C" void kernel_launch(void* const* d_in, const int* in_sizes, int n_in, void* d_out, int out_size, void* d_ws, size_t ws_size, hipStream_t stream) {
    static int grid = 0;
    if (grid == 0) {
        if (n_in != 25 || ws_size < WS_END || out_size != MX * D_MODEL) { fprintf(stderr, "kernel_launch: unexpected shapes: n_in %d ws %zu out %d\n", n_in, ws_size, out_size); grid = -1; return; }
        int dev = 0, cus = 0, per_cu = 0;
        if (hipGetDevice(&dev) != hipSuccess || hipDeviceGetAttribute(&cus, hipDeviceAttributeMultiprocessorCount, dev) != hipSuccess) { grid = -1; return; }
        if (hipFuncSetAttribute((const void*)fwd_kernel, hipFuncAttributeMaxDynamicSharedMemorySize, LDS_BYTES) != hipSuccess) { fprintf(stderr, "kernel_launch: hipFuncSetAttribute failed\n"); grid = -1; return; }
        if (hipOccupancyMaxActiveBlocksPerMultiprocessor(&per_cu, (const void*)fwd_kernel, 512, LDS_BYTES) != hipSuccess || per_cu < 1) { fprintf(stderr, "kernel_launch: occupancy query says %d\n", per_cu); per_cu = 1; }
        (void)hipGetLastError();
        grid = cus;
    }
    if (grid < 0) return;
    Args a{};
    for (int i = 0; i < 25; ++i) a.in[i] = (const float*)d_in[i];
    a.out = (float*)d_out; a.ws = (unsigned char*)d_ws;
    unsigned char* ws = (unsigned char*)d_ws;
    int nj = 0, items = 0;
    auto add = [&](const float* src, size_t dst_off, int K, int N, int ldd, int map, int row_off) {
        Job& j = a.jobs[nj++]; j.src = src; j.dst = (bf16_t*)(ws + dst_off); j.K = K; j.N = N; j.ldd = ldd; j.map = map; j.row_off = row_off; j.item0 = items; items += (K / 64) * (N / 32); };
    const float* ffn_w_in = (const float*)d_in[7]; const float* ffn_w_out = (const float*)d_in[8];
    for (int i = 0; i < 4; ++i) add(ffn_w_in + (size_t)i * D_MODEL * 2 * D_FF, WS_WIN + i * W_IN_BYTES, D_MODEL, 2 * D_FF, D_MODEL, 1, 0);
    for (int i = 0; i < 4; ++i) add(ffn_w_out + (size_t)i * D_FF * D_MODEL, WS_WOUT + i * W_OUT_BYTES, D_FF, D_MODEL, D_FF, 0, 0);
    add((const float*)d_in[9], WS_WABIN, D_MODEL, 1792, D_MODEL, 2, 0);
    add((const float*)d_in[15], WS_WABOUT, D_MODEL, D_MODEL, D_MODEL, 0, 0);
    add((const float*)d_in[16], WS_WD, D_MODEL, 256, D_MODEL, 0, 0);
    add((const float*)d_in[19], WS_WD, D_MODEL, 320, D_MODEL, 0, 256);
    add((const float*)d_in[18], WS_WUQ, 256, 1536, 256, 0, 0);
    add((const float*)d_in[21], WS_WUKV, 256, 1024, 256, 0, 0);
    add((const float*)d_in[22], WS_WUKV, 256, 1024, 256, 0, 1024);
    add((const float*)d_in[23], WS_WO, D_MODEL, D_MODEL, 1536, 3, 0);
    a.nitems = items;
    void* kargs[] = {&a};
    hipError_t e = hipLaunchCooperativeKernel((const void*)fwd_kernel, dim3(grid), dim3(512), kargs, LDS_BYTES, stream);
    if (e != hipSuccess) fprintf(stderr, "kernel_launch: cooperative launch failed: %s (grid %d)\n", hipGetErrorString(e), grid);
}
```

```cpp
#include <hip/hip_runtime.h>
#include <hip/hip_cooperative_groups.h>
#include <cstdio>
#include <cstdint>
namespace cg = cooperative_groups;

#define LAS __attribute__((address_space(3)))
#define DI __device__ __forceinline__
typedef unsigned short bf16_t;
typedef short bf16x8 __attribute__((ext_vector_type(8)));
typedef short s16x4 __attribute__((ext_vector_type(4)));
typedef float f32x4 __attribute__((ext_vector_type(4)));
typedef float f32x16 __attribute__((ext_vector_type(16)));
typedef unsigned u32x4 __attribute__((ext_vector_type(4)));
typedef unsigned u32x2 __attribute__((ext_vector_type(2)));

constexpr int D_MODEL = 1024, BATCH = 16, SEQ = 2048, CTX = 256, D_FF = 2816;
constexpr int MX = BATCH * SEQ;
constexpr int MH = BATCH * CTX;
constexpr int MT = MX + MH;
constexpr int NMOD = 9 * D_MODEL;
constexpr float LOG2E = 1.4426950408889634f;

constexpr size_t MiB = 1u << 20;
constexpr size_t WS_ROPE = 0;
constexpr size_t WS_MOD = 512 * 1024;
constexpr size_t WS_BAR = 1792 * 1024;
constexpr size_t WS_W = 2 * MiB;
constexpr size_t W_IN_BYTES = (size_t)2 * D_FF * D_MODEL * 2;
constexpr size_t W_OUT_BYTES = (size_t)D_MODEL * D_FF * 2;
constexpr size_t WS_WIN = WS_W;
constexpr size_t WS_WOUT = WS_WIN + 4 * W_IN_BYTES;
constexpr size_t WS_WABIN = WS_WOUT + 4 * W_OUT_BYTES;
constexpr size_t WS_WABOUT = WS_WABIN + (size_t)1792 * 1024 * 2;
constexpr size_t WS_WD = WS_WABOUT + (size_t)1024 * 1024 * 2;
constexpr size_t WS_WUQ = WS_WD + (size_t)768 * 1024 * 2;
constexpr size_t WS_WUKV = WS_WUQ + (size_t)1536 * 256 * 2;
constexpr size_t WS_WO = WS_WUKV + (size_t)2048 * 256 * 2;
constexpr size_t WS_WEND = WS_WO + (size_t)1024 * 1536 * 2;
static_assert(WS_WEND <= 80 * MiB, "weights");
constexpr size_t WS_XS = 80 * MiB;
constexpr size_t WS_R = 224 * MiB;
constexpr size_t WS_END = 512 * MiB;
constexpr size_t R_XN = 0;
constexpr size_t R_ACT = 72 * MiB;
constexpr size_t R_PART = 270 * MiB;
constexpr size_t R_CAT = 0;
constexpr size_t R_Q = 72 * MiB;
constexpr size_t R_KV = 108 * MiB;
constexpr size_t R_Y = 126 * MiB;
constexpr size_t R_KN = 0;
constexpr int LDD = 576;
constexpr size_t R_D = 72 * MiB;
constexpr size_t R_Q2 = 113 * MiB;
constexpr size_t R_V = 209 * MiB;
static_assert(R_V + 72 * MiB <= 288 * MiB && R_ACT + 198 * MiB <= 288 * MiB, "R map");

#ifndef PROBE
#define PROBE 0
#endif
constexpr int LDS_BYTES = 135168;

typedef float f32x2c __attribute__((ext_vector_type(2))); typedef __bf16 bf16x2c __attribute__((ext_vector_type(2)));
DI unsigned cvt_pk_bf16(float lo, float hi) { const f32x2c v = {lo, hi}; const bf16x2c b = __builtin_convertvector(v, bf16x2c); return __builtin_bit_cast(unsigned, b); }
DI float bf2f(bf16_t v) { return __uint_as_float((unsigned)v << 16); }
DI float fast_exp2(float x) { return __builtin_amdgcn_exp2f(x); }
DI float fast_rcp(float x) { return __builtin_amdgcn_rcpf(x); }
DI float sigmoid_f(float x) { return fast_rcp(1.f + fast_exp2(-x * LOG2E)); }
DI float wave_sum(float v) {
#pragma unroll
    for (int o = 1; o < 64; o <<= 1) v += __shfl_xor(v, o);
    return v;
}
typedef _Float16 h16x2 __attribute__((ext_vector_type(2)));
DI unsigned cvt_pk_f16(float lo, float hi) { const h16x2 v = {(_Float16)lo, (_Float16)hi}; return __builtin_bit_cast(unsigned, v); }
DI void unpack8h(const u32x4 w, f32x4& a, f32x4& b) {
    const unsigned w0 = w[0], w1 = w[1], w2 = w[2], w3 = w[3];
    const h16x2 p0 = __builtin_bit_cast(h16x2, w0), p1 = __builtin_bit_cast(h16x2, w1), p2 = __builtin_bit_cast(h16x2, w2), p3 = __builtin_bit_cast(h16x2, w3);
    a = (f32x4){(float)p0[0], (float)p0[1], (float)p1[0], (float)p1[1]}; b = (f32x4){(float)p2[0], (float)p2[1], (float)p3[0], (float)p3[1]};
}
DI u32x4 pack8h(const f32x4 a, const f32x4 b) { u32x4 o; o.x = cvt_pk_f16(a[0], a[1]); o.y = cvt_pk_f16(a[2], a[3]); o.z = cvt_pk_f16(b[0], b[1]); o.w = cvt_pk_f16(b[2], b[3]); return o; }
typedef float f32x2 __attribute__((ext_vector_type(2)));
DI float max3f(float a, float b, float c) { return __builtin_fmaxf(__builtin_fmaxf(a, b), c); }
DI void unpack8(const u32x4 w, f32x4& a, f32x4& b) {
    a = (f32x4){__uint_as_float(w.x << 16), __uint_as_float(w.x & 0xffff0000u), __uint_as_float(w.y << 16), __uint_as_float(w.y & 0xffff0000u)};
    b = (f32x4){__uint_as_float(w.z << 16), __uint_as_float(w.z & 0xffff0000u), __uint_as_float(w.w << 16), __uint_as_float(w.w & 0xffff0000u)};
}
DI u32x4 pack8(const f32x4 a, const f32x4 b) { u32x4 o; o.x = cvt_pk_bf16(a[0], a[1]); o.y = cvt_pk_bf16(a[2], a[3]); o.z = cvt_pk_bf16(b[0], b[1]); o.w = cvt_pk_bf16(b[2], b[3]); return o; }
DI u32x2 pack4(f32x4 v) { u32x2 w; w.x = cvt_pk_bf16(v[0], v[1]); w.y = cvt_pk_bf16(v[2], v[3]); return w; }

namespace pg8 {
constexpr int BM = 256, BK = 64, HALF = 128, HTB = HALF * BK * 2, STAGE_BYTES = 8 * HTB, NXCD = 8, WGM = 8;
DI int lds_byte(int r, int c) { const int st = (r >> 4) * 2 + (c >> 5), rr = r & 15, cc = c & 31, ob = rr * 64 + cc * 2; return st * 1024 + (ob ^ (((ob >> 9) & 1) << 5)); }
DI void stage_rc(int b, int& R, int& C) { const int st = b / 1024, sb = b % 1024, swz = sb ^ (((sb >> 9) & 1) << 5); R = (st >> 1) * 16 + swz / 64; C = (st & 1) * 32 + (swz % 64) / 2; }
DI int perm32(int rho) { const int n = rho >> 4, i = rho & 15; return 8 * (i >> 2) + 4 * n + (i & 3); }

struct Unit { int pm, pn, k0, nk; };
struct Gemm { const bf16_t* A; const bf16_t* Bt; int M, N, K, lda, ldb; int amode = 0; };

struct StaticOrder {
    int nM, nN, nwg, G, c;
    int ntk;
    DI void init(int M, int N, int K, int G_, int c_) { nM = M / BM; nN = N / BM; nwg = nM * nN; G = G_; c = c_; ntk = K / BK; }
    DI Unit get(int i, bool& ok) const { return at((long)i * G + c, ok); }
    DI Unit at(long L, bool& ok) const {
        Unit u; u.pm = 0; u.pn = 0; u.k0 = 0; u.nk = ntk; ok = L < nwg; if (!ok) return u;
        int wgid = (int)L; { const int q = nwg / NXCD, r = nwg % NXCD, xcd = wgid % NXCD, off = wgid / NXCD; wgid = (xcd < r ? xcd * (q + 1) : r * (q + 1) + (xcd - r) * q) + off; }
        const int nig = WGM * nN, gid = wgid / nig, fm = gid * WGM, gsz = (nM - fm) < WGM ? (nM - fm) : WGM;
        u.pm = fm + ((wgid % nig) % gsz); u.pn = (wgid % nig) / gsz; return u;
    }
};
struct SplitOrder {
    StaticOrder full; int G, c, ntk;
    DI void init(int N, int K, int G_, int c_) { full.init(MX, N, K, G_, c_); G = G_; c = c_; ntk = K / BK; }
    DI Unit get(int i, bool& ok) const {
        const long L = (long)i * G + c;
        if (L < full.nwg) return full.at(L, ok);
        const int q = (int)(L - full.nwg); ok = q < 128;
        Unit u; u.pm = MX / BM + (q >> 3); u.pn = (q >> 1) & 3; const int part = q & 1;
        u.nk = ntk / 2; u.k0 = part * u.nk;
        return u;
    }
};

template <class Epi, class Sched>
DI void gemm_phase(LAS unsigned char* lds, const Gemm g, const Sched& S, const Epi& E) {
    int tid = threadIdx.x; asm volatile("" : "+v"(tid));
    const int wid = __builtin_amdgcn_readfirstlane(tid >> 6), lane = tid & 63, wr = wid >> 2, wc = wid & 3, fr = lane & 15, fq = lane >> 4;
    unsigned voffA[2], voffB[2];
#pragma unroll
    for (int i = 0; i < 2; ++i) { int R, C; stage_rc(tid * 16 + i * 8192, R, C); const int Rb = Epi::PERM ? ((R & ~31) + perm32(R & 31)) : R;
        voffA[i] = (unsigned)(R * g.lda + C) * 2u; voffB[i] = (unsigned)(Rb * g.ldb + C) * 2u; }
    const size_t kstep = (size_t)(BK * 2);
    const size_t hstepA = (size_t)HALF * g.lda * 2, hstepB = (size_t)HALF * g.ldb * 2;
    const size_t tstepA = 2 * hstepA, tstepB = 2 * hstepB;
    const unsigned ldsw = (unsigned)wid * 1024u;
    const int aoff = lds_byte(wr * 64 + fr, fq * 8), boff = lds_byte(wc * 32 + fr, fq * 8);
#define PG8_SA(b, h) (((b) * 2 + (h)) * HTB)
#define PG8_SB(b, h) ((4 + (b) * 2 + (h)) * HTB)
#define PG8_STAGE(bufoff, gbase, voff) do { _Pragma("unroll") for (int _i = 0; _i < 2; ++_i) \
        __builtin_amdgcn_global_load_lds((const unsigned*)((const char*)(gbase) + (voff)[_i]), (LAS unsigned*)(lds + (bufoff) + ldsw + _i * 8192), 16, 0, 0); } while (0)
#define PG8_LDA(dst, b, h) do { _Pragma("unroll") for (int m = 0; m < 4; ++m) _Pragma("unroll") for (int k = 0; k < 2; ++k) dst[m][k] = *(const LAS bf16x8*)(lds + PG8_SA(b, h) + aoff + m * 2048 + k * 1024); } while (0)
#define PG8_LDB(dst, b, h) do { _Pragma("unroll") for (int n = 0; n < 2; ++n) _Pragma("unroll") for (int k = 0; k < 2; ++k) dst[n][k] = *(const LAS bf16x8*)(lds + PG8_SB(b, h) + boff + n * 2048 + k * 1024); } while (0)
#define PG8_MMA(ai, bj, At, Bt) do { __builtin_amdgcn_s_setprio(1); _Pragma("unroll") for (int m = 0; m < 4; ++m) _Pragma("unroll") for (int n = 0; n < 2; ++n) _Pragma("unroll") for (int k = 0; k < 2; ++k) \
        acc[ai][bj][m][n] = __builtin_amdgcn_mfma_f32_16x16x32_bf16(Bt[n][k], At[m][k], acc[ai][bj][m][n], 0, 0, 0); __builtin_amdgcn_s_setprio(0); } while (0)
#define PG8_WAIT_V(n) asm volatile("s_waitcnt vmcnt(" #n ")" ::: "memory")
#define PG8_WAIT_L(n) asm volatile("s_waitcnt lgkmcnt(" #n ")" ::: "memory")
#define PG8_BAR __builtin_amdgcn_s_barrier()
#define PG8_SCHED __builtin_amdgcn_sched_barrier(0)
    int ui = 0; bool ok0;
    Unit cur = S.get(0, ok0), nxt = cur;
    if (!ok0) return;
    f32x4 acc[2][2][4][2];
#pragma unroll
    for (int a = 0; a < 2; ++a)
#pragma unroll
        for (int b = 0; b < 2; ++b)
#pragma unroll
            for (int m = 0; m < 4; ++m)
#pragma unroll
                for (int n = 0; n < 2; ++n) acc[a][b][m][n] = (f32x4){0.f, 0.f, 0.f, 0.f};
    bf16x8 At[4][2], B0[2][2], B1[2][2];
    const char* cA = (const char*)g.A + (size_t)cur.pm * tstepA + (size_t)cur.k0 * kstep; const char* cB = (const char*)g.Bt + (size_t)cur.pn * tstepB + (size_t)cur.k0 * kstep;
    PG8_STAGE(PG8_SB(0, 0), cB, voffB); PG8_STAGE(PG8_SB(0, 1), cB + hstepB, voffB); PG8_STAGE(PG8_SA(0, 0), cA, voffA); PG8_STAGE(PG8_SA(0, 1), cA + hstepA, voffA);
    if (wr == 1) PG8_BAR;
    PG8_WAIT_V(2); PG8_BAR;
    PG8_STAGE(PG8_SB(1, 0), cB + kstep, voffB); PG8_STAGE(PG8_SA(1, 0), cA + kstep, voffA); PG8_STAGE(PG8_SB(1, 1), cB + hstepB + kstep, voffB);
    PG8_WAIT_V(6); PG8_BAR;
    for (;;) {
        bool has_next; nxt = S.get(ui + 1, has_next);
        const char* nA = has_next ? (const char*)g.A + (size_t)nxt.pm * tstepA + (size_t)nxt.k0 * kstep : cA; const char* nB = has_next ? (const char*)g.Bt + (size_t)nxt.pn * tstepB + (size_t)nxt.k0 * kstep : cB;
        const int nt = cur.nk;
        for (int t = 0; t < nt; t += 2) {
            const bool last = (t == nt - 2);
            const char* a1 = cA + (g.amode ? (size_t)(t + 1 + (t >> 1)) * kstep : (size_t)(t + 1) * kstep);
            const char* a2 = last ? nA : cA + (g.amode ? (size_t)(t + 2 + ((t + 2) >> 1)) * kstep : (size_t)(t + 2) * kstep); const char* b2 = last ? nB : cB + (size_t)(t + 2) * kstep;
            const char* a3 = a2 + kstep; const char* b3 = b2 + kstep;
            PG8_LDB(B0, 0, 0); PG8_LDB(B1, 0, 1); PG8_SCHED; PG8_LDA(At, 0, 0); PG8_STAGE(PG8_SA(1, 1), a1 + hstepA, voffA);
            PG8_WAIT_V(8); PG8_WAIT_L(0); PG8_BAR; PG8_MMA(0, 0, At, B0); PG8_MMA(0, 1, At, B1); PG8_BAR; PG8_SCHED;
            PG8_LDA(At, 0, 1); PG8_STAGE(PG8_SB(0, 0), b2, voffB); PG8_STAGE(PG8_SB(0, 1), b2 + hstepB, voffB); PG8_STAGE(PG8_SA(0, 0), a2, voffA);
            PG8_WAIT_V(8); PG8_WAIT_L(0); PG8_BAR; PG8_MMA(1, 0, At, B0); PG8_MMA(1, 1, At, B1); PG8_BAR; PG8_SCHED;
            PG8_LDB(B0, 1, 0); PG8_LDB(B1, 1, 1); PG8_SCHED; PG8_LDA(At, 1, 0); PG8_STAGE(PG8_SA(0, 1), a2 + hstepA, voffA);
            PG8_WAIT_V(8); PG8_WAIT_L(0); PG8_BAR; PG8_MMA(0, 0, At, B0); PG8_MMA(0, 1, At, B1); PG8_BAR; PG8_SCHED;
            PG8_LDA(At, 1, 1); PG8_STAGE(PG8_SB(1, 0), b3, voffB); PG8_STAGE(PG8_SB(1, 1), b3 + hstepB, voffB); PG8_STAGE(PG8_SA(1, 0), a3, voffA);
            PG8_WAIT_V(8); PG8_WAIT_L(0); PG8_BAR; PG8_MMA(1, 0, At, B0); PG8_MMA(1, 1, At, B1); PG8_BAR; PG8_SCHED;
        }
        if (wr == 0) PG8_BAR;
        E(acc, cur, wr, wc, fr, fq);
        if (!has_next) break;
#pragma unroll
        for (int a = 0; a < 2; ++a)
#pragma unroll
            for (int b = 0; b < 2; ++b)
#pragma unroll
                for (int m = 0; m < 4; ++m)
#pragma unroll
                    for (int n = 0; n < 2; ++n) acc[a][b][m][n] = (f32x4){0.f, 0.f, 0.f, 0.f};
        cur = nxt; cA = nA; cB = nB; ++ui;
        if (wr == 1) PG8_BAR;
    }
    PG8_WAIT_V(0);
    PG8_BAR;
#undef PG8_SA
#undef PG8_SB
#undef PG8_STAGE
#undef PG8_LDA
#undef PG8_LDB
#undef PG8_MMA
#undef PG8_WAIT_V
#undef PG8_WAIT_L
#undef PG8_BAR
#undef PG8_SCHED
}

typedef f32x4 Acc[2][2][4][2];

struct EpiPlain {
    static constexpr bool PERM = true;
    bf16_t* O0; bf16_t* O1; int split_tile; int ldc; int ncols_valid;
    DI void operator()(const Acc& acc, const Unit& u, int wr, int wc, int fr, int fq) const {
        asm volatile("" : "+v"(fr), "+v"(fq));
        const int row0 = u.pm * BM + wr * 64 + fr;
        bf16_t* base = O0; int colt = u.pn * BM; if (u.pn >= split_tile) { base = O1; colt -= split_tile * BM; }
        const int col0 = colt + wc * 32 + 8 * fq;
#pragma unroll
        for (int ai = 0; ai < 2; ++ai)
#pragma unroll
            for (int m = 0; m < 4; ++m) { bf16_t* rowp = base + (size_t)(row0 + ai * HALF + m * 16) * ldc + col0;
#pragma unroll
                for (int bj = 0; bj < 2; ++bj) { if (col0 + bj * HALF < ncols_valid) { const f32x4 v0 = acc[ai][bj][m][0], v1 = acc[ai][bj][m][1]; u32x4 w;
                    w.x = cvt_pk_bf16(v0[0], v0[1]); w.y = cvt_pk_bf16(v0[2], v0[3]); w.z = cvt_pk_bf16(v1[0], v1[1]); w.w = cvt_pk_bf16(v1[2], v1[3]);
                    *(u32x4*)(rowp + bj * HALF) = w; } } }
    }
};
struct EpiSwiglu {
    static constexpr bool PERM = true;
    bf16_t* O; int ldc;
    DI void operator()(const Acc& acc, const Unit& u, int wr, int wc, int fr, int fq) const {
        asm volatile("" : "+v"(fr), "+v"(fq));
        const int row0 = u.pm * BM + wr * 64 + fr; const int col0 = u.pn * HALF + wc * 32 + 8 * fq;
#pragma unroll
        for (int ai = 0; ai < 2; ++ai)
#pragma unroll
            for (int m = 0; m < 4; ++m) { bf16_t* rowp = O + (size_t)(row0 + ai * HALF + m * 16) * ldc + col0; float v[8];
#pragma unroll
                for (int n = 0; n < 2; ++n)
#pragma unroll
                    for (int j = 0; j < 4; ++j) { const float gg = acc[ai][0][m][n][j], uu = acc[ai][1][m][n][j]; v[n * 4 + j] = gg * sigmoid_f(gg) * uu; }
                u32x4 w; w.x = cvt_pk_bf16(v[0], v[1]); w.y = cvt_pk_bf16(v[2], v[3]); w.z = cvt_pk_bf16(v[4], v[5]); w.w = cvt_pk_bf16(v[6], v[7]);
                *(u32x4*)rowp = w; }
    }
};
template <bool BASEF32>
struct EpiResid {
    static constexpr bool PERM = true;
    const void* base_x; const void* base_h;
    bf16_t* out; const float* gate;
    float* part; float coef; int pad_;
    DI void operator()(const Acc& acc, const Unit& u, int wr, int wc, int fr, int fq) const {
        asm volatile("" : "+v"(fr), "+v"(fq));
        const int col0 = u.pn * BM + wc * 32 + 8 * fq;
        const int midx = u.pm < (MX / BM) ? (u.pm >> 3) : 16;
        const float* gp = gate + (size_t)midx * NMOD + col0;
        f32x4 gv[2][2];
#pragma unroll
        for (int bj = 0; bj < 2; ++bj)
#pragma unroll
            for (int n = 0; n < 2; ++n) gv[bj][n] = *(const f32x4*)(gp + bj * HALF + n * 4) * coef;
        if (u.k0 != 0) {
            float* pbase = part + (size_t)(u.pm - MX / BM) * BM * D_MODEL;
#pragma unroll
            for (int ai = 0; ai < 2; ++ai)
#pragma unroll
                for (int m = 0; m < 4; ++m) { const size_t off = (size_t)(ai * HALF + wr * 64 + m * 16 + fr) * D_MODEL + col0;
#pragma unroll
                    for (int bj = 0; bj < 2; ++bj)
#pragma unroll
                        for (int n = 0; n < 2; ++n) *(f32x4*)(pbase + off + bj * HALF + n * 4) = gv[bj][n] * acc[ai][bj][m][n]; }
            return;
        }
        const size_t tile_off = u.pm < (MX / BM) ? (size_t)u.pm * BM * D_MODEL : (size_t)(u.pm - MX / BM) * BM * D_MODEL;
        const void* bsel = u.pm < (MX / BM) ? base_x : base_h;
        bf16_t* obase = out + (size_t)u.pm * BM * D_MODEL;
        const size_t off0 = (size_t)(wr * 64 + fr) * D_MODEL + col0;
        if (BASEF32) {
#pragma unroll
            for (int ai = 0; ai < 2; ++ai) { f32x4 bb[4][2][2];
#pragma unroll
                for (int m = 0; m < 4; ++m)
#pragma unroll
                    for (int bj = 0; bj < 2; ++bj) { const float* bp = (const float*)bsel + tile_off + off0 + (size_t)(ai * HALF + m * 16) * D_MODEL + bj * HALF; bb[m][bj][0] = *(const f32x4*)bp; bb[m][bj][1] = *(const f32x4*)(bp + 4); }
#pragma unroll
                for (int m = 0; m < 4; ++m)
#pragma unroll
                    for (int bj = 0; bj < 2; ++bj) { const f32x4 x0 = bb[m][bj][0] + gv[bj][0] * acc[ai][bj][m][0], x1 = bb[m][bj][1] + gv[bj][1] * acc[ai][bj][m][1];
                        *(u32x4*)(obase + off0 + (size_t)(ai * HALF + m * 16) * D_MODEL + bj * HALF) = pack8h(x0, x1); } }
        } else {
            u32x4 bb[2][4][2];
#pragma unroll
            for (int ai = 0; ai < 2; ++ai)
#pragma unroll
                for (int m = 0; m < 4; ++m)
#pragma unroll
                    for (int bj = 0; bj < 2; ++bj) bb[ai][m][bj] = *(const u32x4*)((const bf16_t*)bsel + tile_off + off0 + (size_t)(ai * HALF + m * 16) * D_MODEL + bj * HALF);
#pragma unroll
            for (int ai = 0; ai < 2; ++ai)
#pragma unroll
                for (int m = 0; m < 4; ++m)
#pragma unroll
                    for (int bj = 0; bj < 2; ++bj) { f32x4 b0, b1; unpack8h(bb[ai][m][bj], b0, b1);
                        const f32x4 x0 = b0 + gv[bj][0] * acc[ai][bj][m][0], x1 = b1 + gv[bj][1] * acc[ai][bj][m][1];
                        *(u32x4*)(obase + off0 + (size_t)(ai * HALF + m * 16) * D_MODEL + bj * HALF) = pack8h(x0, x1); }
        }
    }
};
DI void rope8(f32x4& x0, f32x4& x1, const float* rt, int fq) {
    const float* cp = rt + 2 * ((8 * fq) & 15);
    const f32x4 A = *(const f32x4*)cp, B = *(const f32x4*)(cp + 4), C = *(const f32x4*)(cp + 8), D = *(const f32x4*)(cp + 12);
    const f32x4 c0 = {A[0], A[2], B[0], B[2]}, s0 = {A[1], A[3], B[1], B[3]}, c1 = {C[0], C[2], D[0], D[2]}, s1 = {C[1], C[3], D[1], D[3]};
    const bool lo = fq < 2;
    f32x4 p0, p1;
#pragma unroll
    for (int j = 0; j < 4; ++j) {
        const auto r0 = __builtin_amdgcn_permlane32_swap(__float_as_uint(x0[j]), __float_as_uint(x0[j]), false, false);
        const auto r1 = __builtin_amdgcn_permlane32_swap(__float_as_uint(x1[j]), __float_as_uint(x1[j]), false, false);
        p0[j] = __uint_as_float(lo ? r0[1] : r0[0]); p1[j] = __uint_as_float(lo ? r1[1] : r1[0]); }
    const float sg = lo ? -1.f : 1.f;
    x0 = x0 * c0 + (p0 * s0) * sg; x1 = x1 * c1 + (p1 * s1) * sg;
}
struct EpiABIn {
    static constexpr bool PERM = true;
    bf16_t* Q; bf16_t* KV; bf16_t* Y; const float* rope; float qscale;
    DI void operator()(const Acc& acc, const Unit& u, int wr, int wc, int fr, int fq) const {
        asm volatile("" : "+v"(fr), "+v"(fq));
        const int rowt = u.pm * BM + wr * 64 + fr; const bool is_x = u.pm < (MX / BM);
        if (u.pn >= 3) {
            const int col0 = (u.pn - 3) * HALF + wc * 32 + 8 * fq;
#pragma unroll
            for (int ai = 0; ai < 2; ++ai)
#pragma unroll
                for (int m = 0; m < 4; ++m) { f32x4 v0, v1;
#pragma unroll
                    for (int j = 0; j < 4; ++j) { v0[j] = acc[ai][0][m][0][j] * sigmoid_f(acc[ai][1][m][0][j]); v1[j] = acc[ai][0][m][1][j] * sigmoid_f(acc[ai][1][m][1][j]); }
                    *(u32x4*)(Y + (size_t)(rowt + ai * HALF + m * 16) * 512 + col0) = pack8(v0, v1); }
        } else {
            const int a = wc & 1;
#pragma unroll
            for (int ai = 0; ai < 2; ++ai)
#pragma unroll
                for (int m = 0; m < 4; ++m) { const int row = rowt + ai * HALF + m * 16; const float* rt = rope + (size_t)(row & (SEQ - 1)) * 64 + a * 32;
#pragma unroll
                    for (int bj = 0; bj < 2; ++bj) { f32x4 x0 = acc[ai][bj][m][0], x1 = acc[ai][bj][m][1];
                        const bool do_rope = is_x && !(u.pn == 2 && bj == 1);
                        if (do_rope) rope8(x0, x1, rt, fq);
                        bf16_t* p;
                        if (u.pn < 2) { x0 = x0 * qscale; x1 = x1 * qscale; p = Q + (size_t)row * 512 + u.pn * BM + bj * HALF + wc * 32 + 8 * fq; }
                        else p = KV + (size_t)row * 256 + bj * HALF + wc * 32 + 8 * fq;
                        *(u32x4*)p = pack8(x0, x1); } }
        }
    }
};
struct EpiUq {
    static constexpr bool PERM = true;
    bf16_t* Q; const float* rope; float qscale;
    DI void operator()(const Acc& acc, const Unit& u, int wr, int wc, int fr, int fq) const {
        asm volatile("" : "+v"(fr), "+v"(fq));
        const int rowt = u.pm * BM + wr * 64 + fr;
#pragma unroll
        for (int ai = 0; ai < 2; ++ai)
#pragma unroll
            for (int m = 0; m < 4; ++m) { const int row = rowt + ai * HALF + m * 16;
#pragma unroll
                for (int bj = 0; bj < 2; ++bj) { const int blk = u.pn * 8 + bj * 4 + wc, bh = blk % 6;
                    f32x4 x0 = acc[ai][bj][m][0], x1 = acc[ai][bj][m][1];
                    if (bh >= 4) rope8(x0, x1, rope + (size_t)(row & (SEQ - 1)) * 64 + (bh - 4) * 32, fq);
                    x0 = x0 * qscale; x1 = x1 * qscale;
                    *(u32x4*)(Q + (size_t)row * 1536 + blk * 32 + 8 * fq) = pack8(x0, x1); } }
    }
};
}

struct AttnU {
    const bf16_t* Q; int ldq;
    const bf16_t* K1; int ldk1;
    const bf16_t* K2; int ldk2;
    const bf16_t* V; int ldv;
    bf16_t* O; int ldo;
    int nt_lat, lat_row0, kpos0, nt_ctx, ctx_row0, qpos0;
    float m0, l0;
};
#define MFMA32(a, b, c) __builtin_amdgcn_mfma_f32_32x32x16_bf16((a), (b), (c), 0, 0, 0)
typedef short v4i16_t __attribute__((ext_vector_type(4)));
DI s16x4 vtr(const LAS unsigned char* p) { return __builtin_bit_cast(s16x4, __builtin_amdgcn_ds_read_tr16_b64_v4i16((LAS v4i16_t*)p)); }
template <int DQK, int NK1, int DV, bool WINDOW, int DUMMY = 0>
DI void attn_unit(LAS unsigned char* lds, const AttnU& a) {
    constexpr int KSB = (DQK + 8) * 2, VROW = DV * 2 + 64, K_BYTES = 64 * KSB, BUF_BYTES = K_BYTES + 64 * VROW;
    constexpr int C1 = NK1 / 8, C2 = (DQK - NK1) / 8, CV = DV / 8;
    constexpr int L1 = C1 / 8, L2 = C2 / 8, LV = CV / 8, NKK = DQK / 16, NDB = DV / 32;
    int tid = threadIdx.x; asm volatile("" : "+v"(tid));
    const int lane = tid & 63, wid = __builtin_amdgcn_readfirstlane(tid >> 6), r = lane & 31, h = lane >> 5;
    bf16x8 qf[NKK];
    { const bf16_t* qrow = a.Q + (size_t)(wid * 32 + r) * a.ldq + 8 * h;
#pragma unroll
      for (int kk = 0; kk < NKK; ++kk) qf[kk] = *(const bf16x8*)(qrow + 16 * kk); }
    f32x16 o[NDB];
#pragma unroll
    for (int d = 0; d < NDB; ++d)
#pragma unroll
        for (int i = 0; i < 16; ++i) o[d][i] = 0.f;
    float m = a.m0, l = (h == 0) ? a.l0 : 0.f;
    const int nt = a.nt_lat + a.nt_ctx;
    u32x4 k1reg[L1 > 0 ? L1 : 1], k2reg[L2 > 0 ? L2 : 1], vreg[LV];
#define ATT_LOAD(j) do { const int grow_ = ((j) < a.nt_lat ? a.lat_row0 + 64 * (j) : a.ctx_row0 + 64 * ((j) - a.nt_lat)); \
        _Pragma("unroll") for (int i_ = 0; i_ < L1; ++i_) { const int x_ = tid + 512 * i_; k1reg[i_] = *(const u32x4*)(a.K1 + (size_t)(grow_ + x_ / C1) * a.ldk1 + (x_ % C1) * 8); } \
        _Pragma("unroll") for (int i_ = 0; i_ < L2; ++i_) { const int x_ = tid + 512 * i_; k2reg[i_] = *(const u32x4*)(a.K2 + (size_t)(grow_ + x_ / (C2 > 0 ? C2 : 1)) * a.ldk2 + (x_ % (C2 > 0 ? C2 : 1)) * 8); } \
        _Pragma("unroll") for (int i_ = 0; i_ < LV; ++i_) { const int x_ = tid + 512 * i_; vreg[i_] = *(const u32x4*)(a.V + (size_t)(grow_ + x_ / CV) * a.ldv + (x_ % CV) * 8); } } while (0)
#define ATT_STORE(buf) do { LAS unsigned char* Kw_ = lds + (buf) * BUF_BYTES; LAS unsigned char* Vw_ = Kw_ + K_BYTES; \
        _Pragma("unroll") for (int i_ = 0; i_ < L1; ++i_) { const int x_ = tid + 512 * i_; *(LAS u32x4*)(Kw_ + (x_ / C1) * KSB + (x_ % C1) * 16) = k1reg[i_]; } \
        _Pragma("unroll") for (int i_ = 0; i_ < L2; ++i_) { const int x_ = tid + 512 * i_; *(LAS u32x4*)(Kw_ + (x_ / (C2 > 0 ? C2 : 1)) * KSB + (C1 + x_ % (C2 > 0 ? C2 : 1)) * 16) = k2reg[i_]; } \
        _Pragma("unroll") for (int i_ = 0; i_ < LV; ++i_) { const int x_ = tid + 512 * i_; *(LAS u32x4*)(Vw_ + (x_ / CV) * VROW + (x_ % CV) * 16) = vreg[i_]; } } while (0)
    if (wid >= 4) __builtin_amdgcn_s_setprio(1);
    ATT_LOAD(0);
    __syncthreads();
    ATT_STORE(0);
    if (nt > 1) ATT_LOAD(1);
    __syncthreads();
    const int qp = a.qpos0 + wid * 32 + r;
    const int voff = (4 * h + ((lane & 15) >> 2)) * VROW + (16 * ((lane >> 4) & 1) + 4 * (lane & 3)) * 2;
    for (int j = 0; j < nt; ++j) {
        const int cur = j & 1;
        LAS unsigned char* Ks = lds + cur * BUF_BYTES; LAS unsigned char* Vs = Ks + K_BYTES + voff;
        bool active = true;
        const bool lat = j < a.nt_lat;
        if (WINDOW && lat) { const int kt = a.kpos0 + 64 * j, qw = a.qpos0 + wid * 32; active = (kt <= qw + 31 + 128) && (kt + 63 >= qw - 128); }
        if (active && DUMMY != 4) {
            f32x16 p0, p1;
#pragma unroll
            for (int i = 0; i < 16; ++i) { p0[i] = 0.f; p1[i] = 0.f; }
            {
                constexpr int KB = 2, NB = NKK / KB;
                bf16x8 ka[2][KB][2];
#pragma unroll
                for (int q = 0; q < KB; ++q) { ka[0][q][0] = *(const LAS bf16x8*)(Ks + r * KSB + q * 32 + h * 16); ka[0][q][1] = *(const LAS bf16x8*)(Ks + (32 + r) * KSB + q * 32 + h * 16); }
#pragma unroll
                for (int b = 0; b < NB; ++b) {
                    if (b + 1 < NB) {
#pragma unroll
                        for (int q = 0; q < KB; ++q) { const int kk = (b + 1) * KB + q;
                            ka[(b + 1) & 1][q][0] = *(const LAS bf16x8*)(Ks + r * KSB + kk * 32 + h * 16); ka[(b + 1) & 1][q][1] = *(const LAS bf16x8*)(Ks + (32 + r) * KSB + kk * 32 + h * 16); }
                    }
                    __builtin_amdgcn_sched_barrier(0);
#pragma unroll
                    for (int q = 0; q < KB; ++q) { p0 = MFMA32(ka[b & 1][q][0], qf[b * KB + q], p0); p1 = MFMA32(ka[b & 1][q][1], qf[b * KB + q], p1); }
                    __builtin_amdgcn_sched_barrier(0);
                }
            }
            constexpr int NDH = 1;
            s16x4 vlo[NDB][4], vhi[NDB][4];
            if (DUMMY != 2) {
#pragma unroll
            for (int d = 0; d < NDH; ++d)
#pragma unroll
                for (int s2 = 0; s2 < 4; ++s2) { vlo[d][s2] = vtr(Vs + (16 * s2) * VROW + 64 * d); vhi[d][s2] = vtr(Vs + (16 * s2 + 8) * VROW + 64 * d); }
            }
            __builtin_amdgcn_sched_barrier(0);
            if (WINDOW && lat) { const int kb = a.kpos0 + 64 * j + 4 * h;
#pragma unroll
                for (int i = 0; i < 16; ++i) { const int d0 = qp - (kb + (i & 3) + 8 * (i >> 2)); const int d1 = d0 - 32;
                    if (d0 > 128 || d0 < -128) p0[i] = -1e30f; if (d1 > 128 || d1 < -128) p1[i] = -1e30f; } }
            float mxa = max3f(p0[0], p0[1], p1[0]), mxb = max3f(p0[2], p0[3], p1[1]); mxa = max3f(mxa, p1[2], p1[3]);
#pragma unroll
            for (int i = 4; i < 16; i += 4) { mxa = max3f(mxa, p0[i], p0[i + 1]); mxb = max3f(mxb, p0[i + 2], p0[i + 3]); mxa = max3f(mxa, p1[i], p1[i + 1]); mxb = max3f(mxb, p1[i + 2], p1[i + 3]); }
            float mx = fmaxf(mxa, mxb);
            { const auto rr = __builtin_amdgcn_permlane32_swap(__float_as_uint(mx), __float_as_uint(mx), false, false); mx = fmaxf(__uint_as_float(rr[0]), __uint_as_float(rr[1])); }
            if (__any(mx > m + 8.f)) {
                const float mn = fmaxf(m, mx), alpha = fast_exp2(m - mn); m = mn; l *= alpha;
#pragma unroll
                for (int d = 0; d < NDB; ++d)
#pragma unroll
                    for (int i = 0; i < 16; ++i) o[d][i] *= alpha;
            }
            float sum = 0.f;
            if (DUMMY != 3) {
#pragma unroll
            for (int i = 0; i < 16; ++i) { p0[i] = fast_exp2(p0[i] - m); p1[i] = fast_exp2(p1[i] - m); }
            { f32x2 sa = {p0[0], p0[1]}, sb = {p1[0], p1[1]};
#pragma unroll
              for (int i = 2; i < 16; i += 2) { sa += (f32x2){p0[i], p0[i + 1]}; sb += (f32x2){p1[i], p1[i + 1]}; }
              sa += sb; sum = sa[0] + sa[1]; }
            } else sum = 1.f;
            l += sum;
            bf16x8 pb[4];
#pragma unroll
            for (int s = 0; s < 4; ++s) { u32x4 w;
#pragma unroll
                for (int q2 = 0; q2 < 4; ++q2) { const int i = 8 * (s & 1) + 2 * q2; w[q2] = (s < 2) ? cvt_pk_bf16(p0[i], p0[i + 1]) : cvt_pk_bf16(p1[i], p1[i + 1]); }
                pb[s] = __builtin_bit_cast(bf16x8, w); }
            __builtin_amdgcn_sched_barrier(0);
            if (DUMMY == 2) { o[0][0] += __builtin_bit_cast(float, (int)pb[0][0] | ((int)pb[1][1] << 8) | ((int)pb[2][2] << 16) ^ (int)pb[3][3]); }
            else
#pragma unroll
            for (int d = 0; d < NDB; ++d) {
                if (d + 1 < NDB) {
#pragma unroll
                    for (int s2 = 0; s2 < 4; ++s2) { vlo[d + 1][s2] = vtr(Vs + (16 * s2) * VROW + 64 * (d + 1)); vhi[d + 1][s2] = vtr(Vs + (16 * s2 + 8) * VROW + 64 * (d + 1)); }
                }
                __builtin_amdgcn_sched_barrier(0);
#pragma unroll
                for (int s2 = 0; s2 < 4; ++s2) { const bf16x8 av = __builtin_shufflevector(vlo[d][s2], vhi[d][s2], 0, 1, 2, 3, 4, 5, 6, 7); o[d] = MFMA32(av, pb[s2], o[d]); }
                __builtin_amdgcn_sched_barrier(0);
            }
        }
        if (j + 1 < nt) ATT_STORE(cur ^ 1);
        __syncthreads();
        if (j + 2 < nt) ATT_LOAD(j + 2);
    }
#undef ATT_LOAD
#undef ATT_STORE
    __builtin_amdgcn_s_setprio(0);
    { const auto rr = __builtin_amdgcn_permlane32_swap(__float_as_uint(l), __float_as_uint(l), false, false); l = __uint_as_float(rr[0]) + __uint_as_float(rr[1]); }
    const float inv = 1.f / l;
    bf16_t* orow = a.O + (size_t)(wid * 32 + r) * a.ldo;
#pragma unroll
    for (int d = 0; d < NDB; ++d)
#pragma unroll
        for (int g = 0; g < 4; ++g) { f32x4 v = {o[d][4 * g] * inv, o[d][4 * g + 1] * inv, o[d][4 * g + 2] * inv, o[d][4 * g + 3] * inv};
            if (!DUMMY || inv < 0.f) *(u32x2*)(orow + 32 * d + 8 * g + 4 * h) = pack4(v); }
}

DI void conv_unit(LAS unsigned char* lds, const bf16_t* Y, int row_base, int seqlen, int t0, const float* wdw, const float* bdw, const float* lng, const float* lnb, bf16_t* out) {
    int c = threadIdx.x; asm volatile("" : "+v"(c));
    const int lane = c & 63, wid = c >> 6;
    float in[62];
#pragma unroll
    for (int i = 0; i < 62; ++i) { const int t = t0 - 15 + i; in[i] = (t >= 0 && t < seqlen) ? bf2f(Y[(size_t)(row_base + t) * 512 + c]) : 0.f; }
    float w[31];
#pragma unroll
    for (int j = 0; j < 31; ++j) w[j] = wdw[j * 512 + c];
    const float bias = bdw[c];
    LAS float* buf = (LAS float*)lds;
    __syncthreads();
#pragma unroll
    for (int t = 0; t < 32; ++t) { float acc = bias;
#pragma unroll
        for (int j = 0; j < 31; ++j) acc += w[j] * in[t + j];
        buf[t * 516 + c] = acc; }
    __syncthreads();
#pragma unroll
    for (int tt = 0; tt < 4; ++tt) { const int t = wid * 4 + tt;
        const f32x4 v0 = *(const LAS f32x4*)(buf + t * 516 + lane * 8), v1 = *(const LAS f32x4*)(buf + t * 516 + lane * 8 + 4);
        const float mean = wave_sum((v0[0] + v0[1]) + (v0[2] + v0[3]) + (v1[0] + v1[1]) + (v1[2] + v1[3])) * (1.f / 512.f);
        const f32x4 d0 = v0 - mean, d1 = v1 - mean;
        const float var = wave_sum((d0[0] * d0[0] + d0[1] * d0[1]) + (d0[2] * d0[2] + d0[3] * d0[3]) + (d1[0] * d1[0] + d1[1] * d1[1]) + (d1[2] * d1[2] + d1[3] * d1[3])) * (1.f / 512.f);
        const float rstd = 1.f / sqrtf(var + 1e-5f);
        const f32x4 g0 = *(const f32x4*)(lng + lane * 8), g1 = *(const f32x4*)(lng + lane * 8 + 4), b0 = *(const f32x4*)(lnb + lane * 8), b1 = *(const f32x4*)(lnb + lane * 8 + 4);
        f32x4 y0 = d0 * rstd * g0 + b0, y1 = d1 * rstd * g1 + b1;
#pragma unroll
        for (int j = 0; j < 4; ++j) { y0[j] = y0[j] * sigmoid_f(y0[j]); y1[j] = y1[j] * sigmoid_f(y1[j]); }
        u32x4 wv; wv.x = cvt_pk_bf16(y0[0], y0[1]); wv.y = cvt_pk_bf16(y0[2], y0[3]); wv.z = cvt_pk_bf16(y1[0], y1[1]); wv.w = cvt_pk_bf16(y1[2], y1[3]);
        *(u32x4*)(out + (size_t)(row_base + t0 + t) * 1024 + 512 + lane * 8) = wv; }
}


#define XB_TMO      128
#define XB_XCNT(j)  (256  + 64 * (j))
#define XB_XSUB(j)  (1280 + 64 * (j))
#define XB_XGEN(j)  (2304 + 64 * (j))
#define XB_TOP      3328
#define XB_TOPGEN   3392
#define XCD_BAR_WORDS 3456
#define XB_SPIN_CAP (1u << 22)
DI unsigned xb_ld(unsigned* p)              { return __hip_atomic_load(p, __ATOMIC_RELAXED, __HIP_MEMORY_SCOPE_AGENT); }
DI unsigned xb_add(unsigned* p, unsigned v) { return __hip_atomic_fetch_add(p, v, __ATOMIC_RELAXED, __HIP_MEMORY_SCOPE_AGENT); }
DI unsigned xb_xcc_id() { return (unsigned)__builtin_amdgcn_s_getreg((3 << 11) | 20) & 0xFu; }
#define XB_SPIN(cond, bar) do { unsigned _sp = 0; while (cond) { __builtin_amdgcn_s_sleep(1); \
    if ((++_sp & 255u) == 0u) { if (xb_ld(&(bar)[XB_TMO])) break; if (_sp > XB_SPIN_CAP) { atomicAdd(&(bar)[XB_TMO], 1u); break; } } } } while (0)
struct XcdBarrier { unsigned* bar; unsigned x; volatile LAS unsigned* st; };
DI XcdBarrier xcd_barrier_post(unsigned* bar, volatile LAS unsigned* st) {
    XcdBarrier b; b.bar = bar; b.x = xb_xcc_id(); b.st = st;
    if (threadIdx.x == 0) (void)xb_add(&bar[XB_XCNT(b.x)], 1u);
    return b;
}
DI void xcd_barrier_complete(unsigned* bar, unsigned x, unsigned& nloc, unsigned& nx) {
    const unsigned G = gridDim.x * gridDim.y * gridDim.z;
    unsigned sum, cnt, mine, sp = 0u;
    for (;;) {
        sum = 0u; cnt = 0u; mine = 0u;
#pragma unroll
        for (unsigned j = 0; j < 16; ++j) { const unsigned c = xb_ld(&bar[XB_XCNT(j)]); sum += c; cnt += (c > 0u) ? 1u : 0u; mine = (j == x) ? c : mine; }
        if (sum == G) break;
        __builtin_amdgcn_s_sleep(1);
        if ((++sp & 255u) == 0u) { if (xb_ld(&bar[XB_TMO])) break; if (sp > XB_SPIN_CAP) { atomicAdd(&bar[XB_TMO], 1u); break; } }
    }
    nloc = mine > 0u ? mine : 1u; nx = cnt > 0u ? cnt : 1u;
}
DI void xcd_barrier(const XcdBarrier& b) {
    asm volatile("s_waitcnt vmcnt(0)" ::: "memory");
    __syncthreads();
    if (threadIdx.x == 0) {
        unsigned* bar = b.bar;
        __builtin_amdgcn_s_waitcnt(0);
        unsigned nloc = b.st[0], nx = b.st[1];
        if (nloc == 0u) { xcd_barrier_complete(bar, b.x, nloc, nx); b.st[0] = nloc; b.st[1] = nx; }
        const unsigned old = xb_add(&bar[XB_XSUB(b.x)], 1u);
        const unsigned gen = old / nloc;
        if (old + 1u == (gen + 1u) * nloc) {
            __builtin_amdgcn_fence(__ATOMIC_RELEASE, "agent");
            asm volatile("s_waitcnt vmcnt(0)" ::: "memory");
            const unsigned og = xb_add(&bar[XB_TOP], 1u);
            const unsigned tg = og / nx;
            if (og + 1u == (tg + 1u) * nx) xb_add(&bar[XB_TOPGEN], 1u);
            else XB_SPIN(xb_ld(&bar[XB_TOPGEN]) == tg, bar);
            __builtin_amdgcn_fence(__ATOMIC_ACQUIRE, "agent");
            xb_add(&bar[XB_XGEN(b.x)], 1u);
            asm volatile("s_waitcnt vmcnt(0)" ::: "memory");
        } else {
            XB_SPIN(xb_ld(&bar[XB_XGEN(b.x)]) == gen, bar);
            __builtin_amdgcn_fence(__ATOMIC_ACQUIRE, "agent");
            asm volatile("s_waitcnt vmcnt(0)" ::: "memory");
        }
    }
    __syncthreads();
}

struct Job { const float* src; bf16_t* dst; int K, N, ldd, map, row_off, item0; };
constexpr int NJOBS = 16;
struct Args {
    const float* in[25]; float* out; unsigned char* ws;
    Job jobs[NJOBS]; int nitems; int pad;
};

DI int job_rowmap(int map, int row_off, int n0) {
    if (map == 1) return n0 < D_FF ? 256 * (n0 / 128) + (n0 % 128) : 256 * ((n0 - D_FF) / 128) + 128 + ((n0 - D_FF) % 128);
    if (map == 2) return n0 < 768 ? n0 : (n0 < 1280 ? 768 + 256 * ((n0 - 768) / 128) + ((n0 - 768) % 128) : 768 + 256 * ((n0 - 1280) / 128) + 128 + ((n0 - 1280) % 128));
    return row_off + n0;
}
DI void transpose_item(const Job& jb, LAS float* scr, int item, int lane) {
    const int nblk = jb.N / 32, kb = item / nblk, nb = item % nblk, k0 = 64 * kb, n0 = 32 * nb;
    const float* W = jb.src; const int N = jb.N;
    float wv[32];
#pragma unroll
    for (int i = 0; i < 32; ++i) { const int kk = 2 * i + (lane >> 5); wv[i] = W[(size_t)(k0 + kk) * N + n0 + (lane & 31)]; }
#pragma unroll
    for (int i = 0; i < 32; ++i) { const int kk = 2 * i + (lane >> 5); scr[kk * 33 + (lane & 31)] = wv[i]; }
    asm volatile("s_waitcnt lgkmcnt(0)" ::: "memory");
    const int c = lane & 7;
    const int drow0 = job_rowmap(jb.map, jb.row_off, n0);
    const int kd0 = (jb.map == 3) ? (k0 / 128) * 192 + (k0 % 128) : k0;
#pragma unroll
    for (int j = 0; j < 4; ++j) { const int n = (lane >> 3) + 8 * j; const LAS float* s = scr + (8 * c) * 33 + n;
        u32x4 o; o.x = cvt_pk_bf16(s[0 * 33], s[1 * 33]); o.y = cvt_pk_bf16(s[2 * 33], s[3 * 33]); o.z = cvt_pk_bf16(s[4 * 33], s[5 * 33]); o.w = cvt_pk_bf16(s[6 * 33], s[7 * 33]);
        *(u32x4*)(jb.dst + (size_t)(drow0 + n) * jb.ldd + kd0 + 8 * c) = o; }
    asm volatile("s_waitcnt lgkmcnt(0)" ::: "memory");
}

template <bool SRCF32>
DI void norm_mod_row(const void* xrow, const float* g, const float* shift, const float* scale, bf16_t* orow, int lane, const float* addp, bf16_t* wb) {
    f32x4 v[4]; float s = 0.f;
#pragma unroll
    for (int j = 0; j < 2; ++j) { const int c = 8 * (lane + 64 * j);
        if (SRCF32) { v[2 * j] = *(const f32x4*)((const float*)xrow + c); v[2 * j + 1] = *(const f32x4*)((const float*)xrow + c + 4); }
        else unpack8h(*(const u32x4*)((const bf16_t*)xrow + c), v[2 * j], v[2 * j + 1]); }
    if (addp) {
#pragma unroll
        for (int j = 0; j < 2; ++j) { const int c = 8 * (lane + 64 * j); v[2 * j] = v[2 * j] + *(const f32x4*)(addp + c); v[2 * j + 1] = v[2 * j + 1] + *(const f32x4*)(addp + c + 4);
            *(u32x4*)(wb + c) = pack8h(v[2 * j], v[2 * j + 1]); } }
#pragma unroll
    for (int j = 0; j < 4; ++j) s += (v[j][0] * v[j][0] + v[j][1] * v[j][1]) + (v[j][2] * v[j][2] + v[j][3] * v[j][3]);
    const float rstd = 1.f / sqrtf(wave_sum(s) * (1.f / D_MODEL) + 1e-6f);
#pragma unroll
    for (int j = 0; j < 2; ++j) { const int c = 8 * (lane + 64 * j);
        const f32x4 y0 = (v[2 * j] * rstd * *(const f32x4*)(g + c)) * (*(const f32x4*)(scale + c) + 1.f) + *(const f32x4*)(shift + c);
        const f32x4 y1 = (v[2 * j + 1] * rstd * *(const f32x4*)(g + c + 4)) * (*(const f32x4*)(scale + c + 4) + 1.f) + *(const f32x4*)(shift + c + 4);
        *(u32x4*)(orow + c) = pack8(y0, y1); }
}

__global__ void __launch_bounds__(512, 2) fwd_kernel(Args args) {
    extern __shared__ __attribute__((aligned(16))) unsigned char lds_raw[];
    LAS unsigned char* lds = (LAS unsigned char*)lds_raw;
    cg::grid_group grid = cg::this_grid();
    const int G = gridDim.x, bx = blockIdx.x;
    const int vcu = (G % 8 == 0) ? (bx % 8) * (G / 8) + bx / 8 : bx;
    const int NGW = G * 8;
#define FRESH_IDS int tid = threadIdx.x; asm volatile("" : "+v"(tid)); const int lane = tid & 63, wave = __builtin_amdgcn_readfirstlane(tid >> 6); const int gw = vcu * 8 + wave; (void)lane; (void)gw;
    unsigned char* ws = args.ws;
    const float* x_in = args.in[0]; const float* c_in = args.in[1]; const float* ctx_in = args.in[2]; const float* cctx_in = args.in[3];
    const float* w_mod = args.in[4]; const float* b_mod = args.in[5]; const float* g_norm = args.in[6];
    const float* a_sink = args.in[10]; const float* b_w_dw = args.in[11]; const float* b_b_dw = args.in[12]; const float* b_ln_g = args.in[13]; const float* b_ln_b = args.in[14];
    const float* c_g_q = args.in[17]; const float* c_g_kv = args.in[20]; const float* g_final = args.in[24];
    float* rope = (float*)(ws + WS_ROPE); float* mod = (float*)(ws + WS_MOD);
    bf16_t* xs = (bf16_t*)(ws + WS_XS);
    unsigned char* R = ws + WS_R;

    volatile LAS unsigned* bar_st = (volatile LAS unsigned*)(lds + 131072);
    unsigned* bar_words = (unsigned*)(ws + WS_BAR);
    {
        FRESH_IDS
        if (tid < 2) bar_st[tid] = 0u;
        if (bx == 0) for (int i = tid; i < XCD_BAR_WORDS; i += 512) bar_words[i] = 0u;
        LAS float* scr = (LAS float*)(lds + wave * 8704);
        for (int rep = 0; rep < (PROBE == 6 ? 2 : 1); ++rep) {
        __syncthreads();
        for (int it = gw; it < args.nitems; it += NGW) {
            int ji = 0;
#pragma unroll
            for (int q = 1; q < NJOBS; ++q) if (it >= args.jobs[q].item0) ji = q;
            Job jb = args.jobs[0];
#pragma unroll
            for (int q = 1; q < NJOBS; ++q) if (ji == q) jb = args.jobs[q];
            transpose_item(jb, scr, it - jb.item0, lane);
        }
        { bf16_t* wd = (bf16_t*)(ws + WS_WD) + (size_t)576 * 1024; const int n16 = 192 * 1024 / 8;
          for (int i = bx * 512 + tid; i < n16; i += G * 512) ((u32x4*)wd)[i] = (u32x4){0u, 0u, 0u, 0u};
 }
        for (int i = bx * 512 + tid; i < SEQ * 32; i += G * 512) { const int t = i >> 5, ai = i & 31, a = ai >> 4, ii = ai & 15;
            const float inv_freq = powf(10000.0f, -(float)(2 * ii) / 32.0f); const float pos = a == 0 ? (float)(t >> 6) : (float)(t & 63); const float ang = pos * inv_freq;
            rope[2 * i] = cosf(ang); rope[2 * i + 1] = sinf(ang); }
        __syncthreads();
        LAS float* sl = (LAS float*)lds;
        LAS float* red = (LAS float*)(lds + 17 * 1024 * 4);
        for (int i = tid; i < 17 * 1024; i += 512) { const float v = i < 16 * 1024 ? c_in[i] : cctx_in[i - 16 * 1024]; sl[i] = v / (1.f + expf(-v)); }
        __syncthreads();
        const int ks = tid >> 5, col = tid & 31;
        for (int u = vcu; u < 2 * (NMOD / 32); u += G) { const int l = u / (NMOD / 32), c0 = (u % (NMOD / 32)) * 32;
            float acc[17];
#pragma unroll
            for (int r = 0; r < 17; ++r) acc[r] = 0.f;
            const float* wp = w_mod + (size_t)l * D_MODEL * NMOD + (size_t)(ks * 64) * NMOD + c0 + col;
#pragma unroll 4
            for (int k = 0; k < 64; ++k) { const float wv = wp[(size_t)k * NMOD];
#pragma unroll
                for (int r = 0; r < 17; ++r) acc[r] += sl[r * 1024 + ks * 64 + k] * wv; }
#pragma unroll
            for (int r = 0; r < 17; ++r) red[(ks * 17 + r) * 32 + col] = acc[r];
            __syncthreads();
            for (int i = tid; i < 17 * 32; i += 512) { const int r = i >> 5, cc = i & 31; float s = b_mod[l * NMOD + c0 + cc];
#pragma unroll
                for (int q = 0; q < 16; ++q) s += red[(q * 17 + r) * 32 + cc];
                mod[((size_t)l * 17 + r) * NMOD + c0 + cc] = s; }
            __syncthreads();
        }
        }
    }
    grid.sync();
    const XcdBarrier xbar = xcd_barrier_post(bar_words, bar_st);
#define GSYNC() xcd_barrier(xbar)

#define NORM_PHASE(F32, LAYER, WHICH, SRCX, SRCH, DST, MROWS) do { FRESH_IDS \
        const float* g_ = g_norm + ((LAYER) * 3 + (WHICH)) * D_MODEL; const float* modl_ = mod + (size_t)(LAYER) * 17 * NMOD + (size_t)(3 * (WHICH)) * D_MODEL; \
        for (int row_ = gw; row_ < (MROWS); row_ += NGW) { const int mi_ = row_ < MX ? row_ / SEQ : 16; \
            const void* xr_ = row_ < MX ? (const void*)((SRCX) + (size_t)row_ * D_MODEL) : (const void*)((SRCH) + (size_t)(row_ - MX) * D_MODEL); \
            norm_mod_row<F32>(xr_, g_, modl_ + (size_t)mi_ * NMOD, modl_ + (size_t)mi_ * NMOD + D_MODEL, (DST) + (size_t)row_ * D_MODEL, lane, (!((LAYER) == 0 && (WHICH) == 0) && row_ >= MX) ? (const float*)(R + R_PART) + (size_t)(row_ - MX) * D_MODEL : (const float*)nullptr, xs + (size_t)row_ * D_MODEL); } } while (0)

#define FFN_PHASES(F32, LAYER, WHICH, S, SRCX, SRCH, MROWS) do { \
        NORM_PHASE(F32, LAYER, WHICH, SRCX, SRCH, (bf16_t*)(R + R_XN), MROWS); \
        GSYNC(); \
        if (PROBE == 2) { pg8::Gemm g_{(const bf16_t*)(R + R_XN), (const bf16_t*)(ws + WS_WIN + (size_t)((LAYER) * 2 + (S)) * W_IN_BYTES), (MROWS), 2 * D_FF, D_MODEL, D_MODEL, D_MODEL}; \
          pg8::StaticOrder S_; S_.init((MROWS), 2 * D_FF, D_MODEL, G, bx); pg8::EpiSwiglu E_{(bf16_t*)(R + R_ACT), D_FF}; pg8::gemm_phase(lds, g_, S_, E_); GSYNC(); } \
        { pg8::Gemm g_{(const bf16_t*)(R + R_XN), (const bf16_t*)(ws + WS_WIN + (size_t)((LAYER) * 2 + (S)) * W_IN_BYTES), (MROWS), 2 * D_FF, D_MODEL, D_MODEL, D_MODEL}; \
          pg8::StaticOrder S_; S_.init((MROWS), 2 * D_FF, D_MODEL, G, bx); pg8::EpiSwiglu E_{(bf16_t*)(R + R_ACT), D_FF}; pg8::gemm_phase(lds, g_, S_, E_); } \
        GSYNC(); \
        { pg8::Gemm g_{(const bf16_t*)(R + R_ACT), (const bf16_t*)(ws + WS_WOUT + (size_t)((LAYER) * 2 + (S)) * W_OUT_BYTES), (MROWS), D_MODEL, D_FF, D_FF, D_FF}; \
          pg8::EpiResid<F32> E_{(SRCX), (SRCH), xs, mod + (size_t)(LAYER) * 17 * NMOD + (size_t)(3 * (WHICH) + 2) * D_MODEL, (float*)(R + R_PART), 0.5f, 0}; \
          if ((MROWS) == MT) { pg8::SplitOrder S_; S_.init(D_MODEL, D_FF, G, bx); pg8::gemm_phase(lds, g_, S_, E_); } \
          else { pg8::StaticOrder S_; S_.init((MROWS), D_MODEL, D_FF, G, bx); pg8::gemm_phase(lds, g_, S_, E_); } } \
        GSYNC(); if (PROBE == 5) { GSYNC(); GSYNC(); GSYNC(); GSYNC(); GSYNC(); } } while (0)

    const bf16_t* xs_h = xs + (size_t)MX * D_MODEL;
    FFN_PHASES(true, 0, 0, 0, x_in, ctx_in, MT);
    NORM_PHASE(false, 0, 1, xs, xs_h, (bf16_t*)(R + R_XN), MT);
    GSYNC();
    { pg8::Gemm g_{(const bf16_t*)(R + R_XN), (const bf16_t*)(ws + WS_WABIN), MT, 1792, D_MODEL, D_MODEL, D_MODEL};
      pg8::StaticOrder S_; S_.init(MT, 1792, D_MODEL, G, bx);
      pg8::EpiABIn E_{(bf16_t*)(R + R_Q), (bf16_t*)(R + R_KV), (bf16_t*)(R + R_Y), rope, 0.125f * LOG2E}; pg8::gemm_phase(lds, g_, S_, E_); }
    GSYNC();
    {
        const bf16_t* Qb = (const bf16_t*)(R + R_Q); const bf16_t* KVb = (const bf16_t*)(R + R_KV); bf16_t* cat = (bf16_t*)(R + R_CAT);
        for (int rep = 0; rep < (PROBE == 4 ? 2 : 1); ++rep) {
        const int apw = (1152 + G - 1) / G;
        for (int u = vcu * apw; u < vcu * apw + apw; ++u) {
            if (u >= 1152) break;
            AttnU a; int b, hq;
            if (u < 1024) { b = u >> 6; hq = (u >> 3) & 7; const int qb = u & 7; const int q0 = qb * 256;
                const int lo = q0 - 128 < 0 ? 0 : q0 - 128, hi = q0 + 384 > SEQ ? SEQ : q0 + 384;
                a.Q = Qb + (size_t)(b * SEQ + q0) * 512 + hq * 64; a.O = cat + (size_t)(b * SEQ + q0) * 1024 + hq * 64;
                a.nt_lat = (hi - lo) / 64; a.lat_row0 = b * SEQ + lo; a.kpos0 = lo; a.qpos0 = q0;
            } else { const int v = u - 1024; b = v >> 3; hq = v & 7;
                a.Q = Qb + (size_t)(MX + b * CTX) * 512 + hq * 64; a.O = cat + (size_t)(MX + b * CTX) * 1024 + hq * 64;
                a.nt_lat = 0; a.lat_row0 = 0; a.kpos0 = 0; a.qpos0 = 0; }
            a.ldq = 512; a.ldo = 1024; const int hkv = hq >> 2;
            a.K1 = KVb + hkv * 64; a.ldk1 = 256; a.K2 = a.K1; a.ldk2 = 256; a.V = KVb + 128 + hkv * 64; a.ldv = 256;
            a.nt_ctx = 4; a.ctx_row0 = MX + b * CTX; a.m0 = a_sink[hq] * LOG2E; a.l0 = 1.f;
            attn_unit<64, 64, 64, true>(lds, a);
        }
        __syncthreads();
        for (int u = vcu; u < 1152; u += G) { int row_base, seqlen, t0;
            if (u < 1024) { row_base = (u >> 6) * SEQ; seqlen = SEQ; t0 = (u & 63) * 32; } else { const int v = u - 1024; row_base = MX + (v >> 3) * CTX; seqlen = CTX; t0 = (v & 7) * 32; }
            conv_unit(lds, (const bf16_t*)(R + R_Y), row_base, seqlen, t0, b_w_dw, b_b_dw, b_ln_g, b_ln_b, cat); }
        }
    }
    GSYNC();
    { pg8::Gemm g_{(const bf16_t*)(R + R_CAT), (const bf16_t*)(ws + WS_WABOUT), MT, D_MODEL, D_MODEL, D_MODEL, D_MODEL};
      pg8::SplitOrder S_; S_.init(D_MODEL, D_MODEL, G, bx);
      pg8::EpiResid<false> E_{xs, xs_h, xs, mod + (size_t)5 * D_MODEL, (float*)(R + R_PART), 1.0f, 0}; pg8::gemm_phase(lds, g_, S_, E_); }
    GSYNC();
    FFN_PHASES(false, 0, 2, 1, xs, xs_h, MT);

    FFN_PHASES(false, 1, 0, 0, xs, xs_h, MT);
    NORM_PHASE(false, 1, 1, xs, xs_h, (bf16_t*)(R + R_XN), MT);
    GSYNC();
    { pg8::Gemm g_{(const bf16_t*)(R + R_XN), (const bf16_t*)(ws + WS_WD), MT, 768, D_MODEL, D_MODEL, D_MODEL};
      pg8::StaticOrder S_; S_.init(MT, 768, D_MODEL, G, bx);
      pg8::EpiPlain E_{(bf16_t*)(R + R_D), (bf16_t*)(R + R_D), 1000, LDD, LDD}; pg8::gemm_phase(lds, g_, S_, E_); }
    GSYNC();
    {
        FRESH_IDS
        bf16_t* Db = (bf16_t*)(R + R_D);
        for (int row = gw; row < MT; row += NGW) { bf16_t* dr = Db + (size_t)row * LDD;
            const u32x2 qa = ((const u32x2*)dr)[lane], ka = ((const u32x2*)(dr + 256))[lane]; const float kr = bf2f(dr[512 + lane]);
            f32x4 q = {__uint_as_float(qa.x << 16), __uint_as_float(qa.x & 0xffff0000u), __uint_as_float(qa.y << 16), __uint_as_float(qa.y & 0xffff0000u)};
            f32x4 k = {__uint_as_float(ka.x << 16), __uint_as_float(ka.x & 0xffff0000u), __uint_as_float(ka.y << 16), __uint_as_float(ka.y & 0xffff0000u)};
            const float rq = 1.f / sqrtf(wave_sum((q[0] * q[0] + q[1] * q[1]) + (q[2] * q[2] + q[3] * q[3])) * (1.f / 256.f) + 1e-6f);
            const float rk = 1.f / sqrtf(wave_sum((k[0] * k[0] + k[1] * k[1]) + (k[2] * k[2] + k[3] * k[3])) * (1.f / 256.f) + 1e-6f);
            q = q * rq * ((const f32x4*)c_g_q)[lane]; k = k * rk * ((const f32x4*)c_g_kv)[lane];
            float kro = kr;
            const float partner = __shfl_xor(kr, 16);
            if (row < MX) { const int t = row & (SEQ - 1); const float cs = rope[(size_t)t * 64 + ((lane >> 5) * 16 + (lane & 15)) * 2], sn = rope[(size_t)t * 64 + ((lane >> 5) * 16 + (lane & 15)) * 2 + 1];
                const float rot = (lane & 16) ? partner : -partner; kro = kr * cs + rot * sn; }
            ((u32x2*)dr)[lane] = pack4(q); ((u32x2*)(dr + 256))[lane] = pack4(k); dr[512 + lane] = (bf16_t)(cvt_pk_bf16(kro, 0.f) & 0xffffu); }
    }
    GSYNC();
    { pg8::Gemm g_{(const bf16_t*)(R + R_D), (const bf16_t*)(ws + WS_WUQ), MX, 1536, 256, LDD, 256};
      pg8::StaticOrder S_; S_.init(MX, 1536, 256, G, bx);
      pg8::EpiUq E_{(bf16_t*)(R + R_Q2), rope, 0.07216878364870322f * LOG2E}; pg8::gemm_phase(lds, g_, S_, E_); }
    { pg8::Gemm g_{(const bf16_t*)(R + R_D) + 256, (const bf16_t*)(ws + WS_WUKV), MT, 2048, 256, LDD, 256};
      pg8::StaticOrder S_; S_.init(MT, 2048, 256, G, bx);
      pg8::EpiPlain E_{(bf16_t*)(R + R_KN), (bf16_t*)(R + R_V), 4, D_MODEL, 1 << 30}; pg8::gemm_phase(lds, g_, S_, E_); }
    GSYNC();
    {
        bf16_t* Q2 = (bf16_t*)(R + R_Q2); const bf16_t* Kn = (const bf16_t*)(R + R_KN); const bf16_t* Db = (const bf16_t*)(R + R_D); const bf16_t* Vb = (const bf16_t*)(R + R_V);
        const int mpw = (1024 + G - 1) / G;
        for (int u = vcu * mpw; u < vcu * mpw + mpw; ++u) { if (u >= 1024) break; const int b = u >> 6, hh = (u >> 3) & 7, qb = u & 7;
            AttnU a; a.Q = Q2 + (size_t)(b * SEQ + qb * 256) * 1536 + hh * 192; a.ldq = 1536; a.O = Q2 + (size_t)(b * SEQ + qb * 256) * 1536 + hh * 192; a.ldo = 1536;
            a.K1 = Kn + hh * 128; a.ldk1 = D_MODEL; a.K2 = Db + 512; a.ldk2 = LDD; a.V = Vb + hh * 128; a.ldv = D_MODEL;
            a.nt_lat = SEQ / 64; a.lat_row0 = b * SEQ; a.kpos0 = 0; a.nt_ctx = 4; a.ctx_row0 = MX + b * CTX; a.qpos0 = 0; a.m0 = -1e30f; a.l0 = 0.f;
            if (PROBE == 1) attn_unit<192, 128, 128, false, 1>(lds, a);
            if (PROBE == 7) attn_unit<192, 128, 128, false, 4>(lds, a);
            if (PROBE == 8) attn_unit<192, 128, 128, false, 3>(lds, a);
            if (PROBE == 9) attn_unit<192, 128, 128, false, 2>(lds, a);
            attn_unit<192, 128, 128, false>(lds, a); }
        __syncthreads();
    }
    GSYNC();
    { pg8::Gemm g_{(const bf16_t*)(R + R_Q2), (const bf16_t*)(ws + WS_WO), MX, D_MODEL, D_MODEL, 1536, D_MODEL, 1};
      pg8::StaticOrder S_; S_.init(MX, D_MODEL, D_MODEL, G, bx);
      pg8::EpiResid<false> E_{xs, xs_h, xs, mod + (size_t)17 * NMOD + (size_t)5 * D_MODEL, (float*)(R + R_PART), 1.0f, 0}; pg8::gemm_phase(lds, g_, S_, E_); }
    GSYNC();
    FFN_PHASES(false, 1, 2, 1, xs, xs_h, MX);
    FRESH_IDS
    for (int row = gw; row < MX; row += NGW) { const bf16_t* xr = xs + (size_t)row * D_MODEL;
        f32x4 v[4]; float sq = 0.f;
#pragma unroll
        for (int j = 0; j < 2; ++j) unpack8h(*(const u32x4*)(xr + 8 * (lane + 64 * j)), v[2 * j], v[2 * j + 1]);
#pragma unroll
        for (int j = 0; j < 4; ++j) sq += (v[j][0] * v[j][0] + v[j][1] * v[j][1]) + (v[j][2] * v[j][2] + v[j][3] * v[j][3]);
        const float rstd = 1.f / sqrtf(wave_sum(sq) * (1.f / D_MODEL) + 1e-6f);
        float* orow = args.out + (size_t)row * D_MODEL;
#pragma unroll
        for (int j = 0; j < 2; ++j) { const int c = 8 * (lane + 64 * j);
            *(f32x4*)(orow + c) = v[2 * j] * rstd * *(const f32x4*)(g_final + c); *(f32x4*)(orow + c + 4) = v[2 * j + 1] * rstd * *(const f32x4*)(g_final + c + 4); } }
}

extern "C" void kernel_launch(void* const* d_in, const int* in_sizes, int n_in, void* d_out, int out_size, void* d_ws, size_t ws_size, hipStream_t stream) {
    static int grid = 0;
    if (grid == 0) {
        if (n_in != 25 || ws_size < WS_END || out_size != MX * D_MODEL) { fprintf(stderr, "kernel_launch: unexpected shapes: n_in %d ws %zu out %d\n", n_in, ws_size, out_size); grid = -1; return; }
        int dev = 0, cus = 0, per_cu = 0;
        if (hipGetDevice(&dev) != hipSuccess || hipDeviceGetAttribute(&cus, hipDeviceAttributeMultiprocessorCount, dev) != hipSuccess) { grid = -1; return; }
        if (hipFuncSetAttribute((const void*)fwd_kernel, hipFuncAttributeMaxDynamicSharedMemorySize, LDS_BYTES) != hipSuccess) { fprintf(stderr, "kernel_launch: hipFuncSetAttribute failed\n"); grid = -1; return; }
        if (hipOccupancyMaxActiveBlocksPerMultiprocessor(&per_cu, (const void*)fwd_kernel, 512, LDS_BYTES) != hipSuccess || per_cu < 1) { fprintf(stderr, "kernel_launch: occupancy query says %d\n", per_cu); per_cu = 1; }
        (void)hipGetLastError();
        grid = cus;
    }
    if (grid < 0) return;
    Args a{};
    for (int i = 0; i < 25; ++i) a.in[i] = (const float*)d_in[i];
    a.out = (float*)d_out; a.ws = (unsigned char*)d_ws;
    unsigned char* ws = (unsigned char*)d_ws;
    int nj = 0, items = 0;
    auto add = [&](const float* src, size_t dst_off, int K, int N, int ldd, int map, int row_off) {
        Job& j = a.jobs[nj++]; j.src = src; j.dst = (bf16_t*)(ws + dst_off); j.K = K; j.N = N; j.ldd = ldd; j.map = map; j.row_off = row_off; j.item0 = items; items += (K / 64) * (N / 32); };
    const float* ffn_w_in = (const float*)d_in[7]; const float* ffn_w_out = (const float*)d_in[8];
    for (int i = 0; i < 4; ++i) add(ffn_w_in + (size_t)i * D_MODEL * 2 * D_FF, WS_WIN + i * W_IN_BYTES, D_MODEL, 2 * D_FF, D_MODEL, 1, 0);
    for (int i = 0; i < 4; ++i) add(ffn_w_out + (size_t)i * D_FF * D_MODEL, WS_WOUT + i * W_OUT_BYTES, D_FF, D_MODEL, D_FF, 0, 0);
    add((const float*)d_in[9], WS_WABIN, D_MODEL, 1792, D_MODEL, 2, 0);
    add((const float*)d_in[15], WS_WABOUT, D_MODEL, D_MODEL, D_MODEL, 0, 0);
    add((const float*)d_in[16], WS_WD, D_MODEL, 256, D_MODEL, 0, 0);
    add((const float*)d_in[19], WS_WD, D_MODEL, 320, D_MODEL, 0, 256);
    add((const float*)d_in[18], WS_WUQ, 256, 1536, 256, 0, 0);
    add((const float*)d_in[21], WS_WUKV, 256, 1024, 256, 0, 0);
    add((const float*)d_in[22], WS_WUKV, 256, 1024, 256, 0, 1024);
    add((const float*)d_in[23], WS_WO, D_MODEL, D_MODEL, D_MODEL, 0, 0);
    a.nitems = items;
    void* kargs[] = {&a};
    hipError_t e = hipLaunchCooperativeKernel((const void*)fwd_kernel, dim3(grid), dim3(512), kargs, LDS_BYTES, stream);
    if (e != hipSuccess) fprintf(stderr, "kernel_launch: cooperative launch failed: %s (grid %d)\n", hipGetErrorString(e), grid);
}
```

```cpp
#include <hip/hip_runtime.h>
#include <hip/hip_cooperative_groups.h>
#include <cstdio>
#include <cstdint>
namespace cg = cooperative_groups;

#define LAS __attribute__((address_space(3)))
#define DI __device__ __forceinline__
typedef unsigned short bf16_t;
typedef short bf16x8 __attribute__((ext_vector_type(8)));
typedef short s16x4 __attribute__((ext_vector_type(4)));
typedef float f32x4 __attribute__((ext_vector_type(4)));
typedef float f32x16 __attribute__((ext_vector_type(16)));
typedef unsigned u32x4 __attribute__((ext_vector_type(4)));
typedef unsigned u32x2 __attribute__((ext_vector_type(2)));

constexpr int D_MODEL = 1024, BATCH = 16, SEQ = 2048, CTX = 256, D_FF = 2816;
constexpr int MX = BATCH * SEQ;
constexpr int MH = BATCH * CTX;
constexpr int MT = MX + MH;
constexpr int NMOD = 9 * D_MODEL;
constexpr float LOG2E = 1.4426950408889634f;

constexpr size_t MiB = 1u << 20;
constexpr size_t WS_ROPE = 0;
constexpr size_t WS_MOD = 512 * 1024;
constexpr size_t WS_BAR = 1792 * 1024;
constexpr size_t WS_W = 2 * MiB;
constexpr size_t W_IN_BYTES = (size_t)2 * D_FF * D_MODEL * 2;
constexpr size_t W_OUT_BYTES = (size_t)D_MODEL * D_FF * 2;
constexpr size_t WS_WIN = WS_W;
constexpr size_t WS_WOUT = WS_WIN + 4 * W_IN_BYTES;
constexpr size_t WS_WABIN = WS_WOUT + 4 * W_OUT_BYTES;
constexpr size_t WS_WABOUT = WS_WABIN + (size_t)1792 * 1024 * 2;
constexpr size_t WS_WD = WS_WABOUT + (size_t)1024 * 1024 * 2;
constexpr size_t WS_WUQ = WS_WD + (size_t)768 * 1024 * 2;
constexpr size_t WS_WUKV = WS_WUQ + (size_t)1536 * 256 * 2;
constexpr size_t WS_WO = WS_WUKV + (size_t)2048 * 256 * 2;
constexpr size_t WS_WEND = WS_WO + (size_t)1024 * 1536 * 2;
static_assert(WS_WEND <= 80 * MiB, "weights");
constexpr size_t WS_XS = 80 * MiB;
constexpr size_t WS_PART = 152 * MiB;
constexpr size_t WS_R = 224 * MiB;
constexpr size_t WS_END = 512 * MiB;
constexpr size_t R_XN = 0;
constexpr size_t R_ACT = 72 * MiB;
constexpr size_t R_PART = 270 * MiB;
constexpr size_t R_CAT = 0;
constexpr size_t R_Q = 72 * MiB;
constexpr size_t R_KV = 108 * MiB;
constexpr size_t R_Y = 126 * MiB;
constexpr size_t R_KN = 0;
constexpr int LDD = 576;
constexpr size_t R_D = 72 * MiB;
constexpr size_t R_Q2 = 113 * MiB;
constexpr size_t R_V = 209 * MiB;
static_assert(R_V + 72 * MiB <= 288 * MiB && R_ACT + 198 * MiB <= 288 * MiB, "R map");

#ifndef PROBE
#define PROBE 0
#endif
constexpr int LDS_BYTES = 135168;

typedef float f32x2c __attribute__((ext_vector_type(2))); typedef __bf16 bf16x2c __attribute__((ext_vector_type(2)));
DI unsigned cvt_pk_bf16(float lo, float hi) { const f32x2c v = {lo, hi}; const bf16x2c b = __builtin_convertvector(v, bf16x2c); return __builtin_bit_cast(unsigned, b); }
DI float bf2f(bf16_t v) { return __uint_as_float((unsigned)v << 16); }
DI float fast_exp2(float x) { return __builtin_amdgcn_exp2f(x); }
DI float fast_rcp(float x) { return __builtin_amdgcn_rcpf(x); }
DI float sigmoid_f(float x) { return fast_rcp(1.f + fast_exp2(-x * LOG2E)); }
DI float wave_sum(float v) {
#pragma unroll
    for (int o = 1; o < 64; o <<= 1) v += __shfl_xor(v, o);
    return v;
}
typedef _Float16 h16x2 __attribute__((ext_vector_type(2)));
DI unsigned cvt_pk_f16(float lo, float hi) { const h16x2 v = {(_Float16)lo, (_Float16)hi}; return __builtin_bit_cast(unsigned, v); }
DI void unpack8h(const u32x4 w, f32x4& a, f32x4& b) {
    const unsigned w0 = w[0], w1 = w[1], w2 = w[2], w3 = w[3];
    const h16x2 p0 = __builtin_bit_cast(h16x2, w0), p1 = __builtin_bit_cast(h16x2, w1), p2 = __builtin_bit_cast(h16x2, w2), p3 = __builtin_bit_cast(h16x2, w3);
    a = (f32x4){(float)p0[0], (float)p0[1], (float)p1[0], (float)p1[1]}; b = (f32x4){(float)p2[0], (float)p2[1], (float)p3[0], (float)p3[1]};
}
DI u32x4 pack8h(const f32x4 a, const f32x4 b) { u32x4 o; o.x = cvt_pk_f16(a[0], a[1]); o.y = cvt_pk_f16(a[2], a[3]); o.z = cvt_pk_f16(b[0], b[1]); o.w = cvt_pk_f16(b[2], b[3]); return o; }
typedef float f32x2 __attribute__((ext_vector_type(2)));
DI float max3f(float a, float b, float c) { return __builtin_fmaxf(__builtin_fmaxf(a, b), c); }
DI void unpack8(const u32x4 w, f32x4& a, f32x4& b) {
    a = (f32x4){__uint_as_float(w.x << 16), __uint_as_float(w.x & 0xffff0000u), __uint_as_float(w.y << 16), __uint_as_float(w.y & 0xffff0000u)};
    b = (f32x4){__uint_as_float(w.z << 16), __uint_as_float(w.z & 0xffff0000u), __uint_as_float(w.w << 16), __uint_as_float(w.w & 0xffff0000u)};
}
DI u32x4 pack8(const f32x4 a, const f32x4 b) { u32x4 o; o.x = cvt_pk_bf16(a[0], a[1]); o.y = cvt_pk_bf16(a[2], a[3]); o.z = cvt_pk_bf16(b[0], b[1]); o.w = cvt_pk_bf16(b[2], b[3]); return o; }
DI u32x2 pack4(f32x4 v) { u32x2 w; w.x = cvt_pk_bf16(v[0], v[1]); w.y = cvt_pk_bf16(v[2], v[3]); return w; }

namespace pg8 {
constexpr int BM = 256, BK = 64, HALF = 128, HTB = HALF * BK * 2, STAGE_BYTES = 8 * HTB, NXCD = 8, WGM = 8;
DI int lds_byte(int r, int c) { const int st = (r >> 4) * 2 + (c >> 5), rr = r & 15, cc = c & 31, ob = rr * 64 + cc * 2; return st * 1024 + (ob ^ (((ob >> 9) & 1) << 5)); }
DI void stage_rc(int b, int& R, int& C) { const int st = b / 1024, sb = b % 1024, swz = sb ^ (((sb >> 9) & 1) << 5); R = (st >> 1) * 16 + swz / 64; C = (st & 1) * 32 + (swz % 64) / 2; }
DI int perm32(int rho) { const int n = rho >> 4, i = rho & 15; return 8 * (i >> 2) + 4 * n + (i & 3); }

struct Unit { int pm, pn, k0, nk, part; };
struct Gemm { const bf16_t* A; const bf16_t* Bt; int M, N, K, lda, ldb; int amode = 0; };

struct StaticOrder {
    int nM, nN, nwg, G, c;
    int ntk;
    DI void init(int M, int N, int K, int G_, int c_) { nM = M / BM; nN = N / BM; nwg = nM * nN; G = G_; c = c_; ntk = K / BK; }
    DI Unit get(int i, bool& ok) const { return at((long)i * G + c, ok); }
    DI Unit at(long L, bool& ok) const {
        Unit u; u.pm = 0; u.pn = 0; u.k0 = 0; u.nk = ntk; u.part = 0; ok = L < nwg; if (!ok) return u;
        int wgid = (int)L; { const int q = nwg / NXCD, r = nwg % NXCD, xcd = wgid % NXCD, off = wgid / NXCD; wgid = (xcd < r ? xcd * (q + 1) : r * (q + 1) + (xcd - r) * q) + off; }
        const int nig = WGM * nN, gid = wgid / nig, fm = gid * WGM, gsz = (nM - fm) < WGM ? (nM - fm) : WGM;
        u.pm = fm + ((wgid % nig) % gsz); u.pn = (wgid % nig) / gsz; return u;
    }
};
struct SplitOrder {
    StaticOrder full; int G, c, ntk;
    DI void init(int N, int K, int G_, int c_) { full.init(MX, N, K, G_, c_); G = G_; c = c_; ntk = K / BK; }
    DI Unit get(int i, bool& ok) const {
        const long L = (long)i * G + c;
        if (L < full.nwg) return full.at(L, ok);
        const int q = (int)(L - full.nwg); ok = q < 256;
        Unit u; u.pm = MX / BM + (q >> 4); u.pn = (q >> 2) & 3; const int part = q & 3; u.part = part;
        if (ntk == 44) { u.k0 = part * 11 + (part & 1); u.nk = 12 - 2 * (part & 1); }
        else { u.nk = ntk / 4; u.k0 = part * u.nk; }
        return u;
    }
};

template <class Epi, class Sched>
DI void gemm_phase(LAS unsigned char* lds, const Gemm g, const Sched& S, const Epi& E) {
    int tid = threadIdx.x; asm volatile("" : "+v"(tid));
    const int wid = __builtin_amdgcn_readfirstlane(tid >> 6), lane = tid & 63, wr = wid >> 2, wc = wid & 3, fr = lane & 15, fq = lane >> 4;
    unsigned voffA[2], voffB[2];
#pragma unroll
    for (int i = 0; i < 2; ++i) { int R, C; stage_rc(tid * 16 + i * 8192, R, C); const int Rb = Epi::PERM ? ((R & ~31) + perm32(R & 31)) : R;
        voffA[i] = (unsigned)(R * g.lda + C) * 2u; voffB[i] = (unsigned)(Rb * g.ldb + C) * 2u; }
    const size_t kstep = (size_t)(BK * 2);
    const size_t hstepA = (size_t)HALF * g.lda * 2, hstepB = (size_t)HALF * g.ldb * 2;
    const size_t tstepA = 2 * hstepA, tstepB = 2 * hstepB;
    const unsigned ldsw = (unsigned)wid * 1024u;
    const int aoff = lds_byte(wr * 64 + fr, fq * 8), boff = lds_byte(wc * 32 + fr, fq * 8);
#define PG8_SA(b, h) (((b) * 2 + (h)) * HTB)
#define PG8_SB(b, h) ((4 + (b) * 2 + (h)) * HTB)
#define PG8_STAGE(bufoff, gbase, voff) do { _Pragma("unroll") for (int _i = 0; _i < 2; ++_i) \
        __builtin_amdgcn_global_load_lds((const unsigned*)((const char*)(gbase) + (voff)[_i]), (LAS unsigned*)(lds + (bufoff) + ldsw + _i * 8192), 16, 0, 0); } while (0)
#define PG8_LDA(dst, b, h) do { _Pragma("unroll") for (int m = 0; m < 4; ++m) _Pragma("unroll") for (int k = 0; k < 2; ++k) dst[m][k] = *(const LAS bf16x8*)(lds + PG8_SA(b, h) + aoff + m * 2048 + k * 1024); } while (0)
#define PG8_LDB(dst, b, h) do { _Pragma("unroll") for (int n = 0; n < 2; ++n) _Pragma("unroll") for (int k = 0; k < 2; ++k) dst[n][k] = *(const LAS bf16x8*)(lds + PG8_SB(b, h) + boff + n * 2048 + k * 1024); } while (0)
#define PG8_MMA(ai, bj, At, Bt) do { __builtin_amdgcn_s_setprio(1); _Pragma("unroll") for (int m = 0; m < 4; ++m) _Pragma("unroll") for (int n = 0; n < 2; ++n) _Pragma("unroll") for (int k = 0; k < 2; ++k) \
        acc[ai][bj][m][n] = __builtin_amdgcn_mfma_f32_16x16x32_bf16(Bt[n][k], At[m][k], acc[ai][bj][m][n], 0, 0, 0); __builtin_amdgcn_s_setprio(0); } while (0)
#define PG8_WAIT_V(n) asm volatile("s_waitcnt vmcnt(" #n ")" ::: "memory")
#define PG8_WAIT_L(n) asm volatile("s_waitcnt lgkmcnt(" #n ")" ::: "memory")
#define PG8_BAR __builtin_amdgcn_s_barrier()
#define PG8_SCHED __builtin_amdgcn_sched_barrier(0)
    int ui = 0; bool ok0;
    Unit cur = S.get(0, ok0), nxt = cur;
    if (!ok0) return;
    f32x4 acc[2][2][4][2];
#pragma unroll
    for (int a = 0; a < 2; ++a)
#pragma unroll
        for (int b = 0; b < 2; ++b)
#pragma unroll
            for (int m = 0; m < 4; ++m)
#pragma unroll
                for (int n = 0; n < 2; ++n) acc[a][b][m][n] = (f32x4){0.f, 0.f, 0.f, 0.f};
    bf16x8 At[4][2], B0[2][2], B1[2][2];
    const char* cA = (const char*)g.A + (size_t)cur.pm * tstepA + (size_t)cur.k0 * kstep; const char* cB = (const char*)g.Bt + (size_t)cur.pn * tstepB + (size_t)cur.k0 * kstep;
    PG8_STAGE(PG8_SB(0, 0), cB, voffB); PG8_STAGE(PG8_SB(0, 1), cB + hstepB, voffB); PG8_STAGE(PG8_SA(0, 0), cA, voffA); PG8_STAGE(PG8_SA(0, 1), cA + hstepA, voffA);
    if (wr == 1) PG8_BAR;
    PG8_WAIT_V(2); PG8_BAR;
    PG8_STAGE(PG8_SB(1, 0), cB + kstep, voffB); PG8_STAGE(PG8_SA(1, 0), cA + kstep, voffA); PG8_STAGE(PG8_SB(1, 1), cB + hstepB + kstep, voffB);
    PG8_WAIT_V(6); PG8_BAR;
    for (;;) {
        bool has_next; nxt = S.get(ui + 1, has_next);
        const char* nA = has_next ? (const char*)g.A + (size_t)nxt.pm * tstepA + (size_t)nxt.k0 * kstep : cA; const char* nB = has_next ? (const char*)g.Bt + (size_t)nxt.pn * tstepB + (size_t)nxt.k0 * kstep : cB;
        const int nt = cur.nk;
        for (int t = 0; t < nt; t += 2) {
            const bool last = (t == nt - 2);
            const char* a1 = cA + (g.amode ? (size_t)(t + 1 + (t >> 1)) * kstep : (size_t)(t + 1) * kstep);
            const char* a2 = last ? nA : cA + (g.amode ? (size_t)(t + 2 + ((t + 2) >> 1)) * kstep : (size_t)(t + 2) * kstep); const char* b2 = last ? nB : cB + (size_t)(t + 2) * kstep;
            const char* a3 = a2 + kstep; const char* b3 = b2 + kstep;
            PG8_LDB(B0, 0, 0); PG8_LDB(B1, 0, 1); PG8_SCHED; PG8_LDA(At, 0, 0); PG8_STAGE(PG8_SA(1, 1), a1 + hstepA, voffA);
            PG8_WAIT_V(8); PG8_WAIT_L(0); PG8_BAR; PG8_MMA(0, 0, At, B0); PG8_MMA(0, 1, At, B1); PG8_BAR; PG8_SCHED;
            PG8_LDA(At, 0, 1); PG8_STAGE(PG8_SB(0, 0), b2, voffB); PG8_STAGE(PG8_SB(0, 1), b2 + hstepB, voffB); PG8_STAGE(PG8_SA(0, 0), a2, voffA);
            PG8_WAIT_V(8); PG8_WAIT_L(0); PG8_BAR; PG8_MMA(1, 0, At, B0); PG8_MMA(1, 1, At, B1); PG8_BAR; PG8_SCHED;
            PG8_LDB(B0, 1, 0); PG8_LDB(B1, 1, 1); PG8_SCHED; PG8_LDA(At, 1, 0); PG8_STAGE(PG8_SA(0, 1), a2 + hstepA, voffA);
            PG8_WAIT_V(8); PG8_WAIT_L(0); PG8_BAR; PG8_MMA(0, 0, At, B0); PG8_MMA(0, 1, At, B1); PG8_BAR; PG8_SCHED;
            PG8_LDA(At, 1, 1); PG8_STAGE(PG8_SB(1, 0), b3, voffB); PG8_STAGE(PG8_SB(1, 1), b3 + hstepB, voffB); PG8_STAGE(PG8_SA(1, 0), a3, voffA);
            PG8_WAIT_V(8); PG8_WAIT_L(0); PG8_BAR; PG8_MMA(1, 0, At, B0); PG8_MMA(1, 1, At, B1); PG8_BAR; PG8_SCHED;
        }
        if (wr == 0) PG8_BAR;
        E(acc, cur, wr, wc, fr, fq);
        if (!has_next) break;
#pragma unroll
        for (int a = 0; a < 2; ++a)
#pragma unroll
            for (int b = 0; b < 2; ++b)
#pragma unroll
                for (int m = 0; m < 4; ++m)
#pragma unroll
                    for (int n = 0; n < 2; ++n) acc[a][b][m][n] = (f32x4){0.f, 0.f, 0.f, 0.f};
        cur = nxt; cA = nA; cB = nB; ++ui;
        if (wr == 1) PG8_BAR;
    }
    PG8_WAIT_V(0);
    PG8_BAR;
#undef PG8_SA
#undef PG8_SB
#undef PG8_STAGE
#undef PG8_LDA
#undef PG8_LDB
#undef PG8_MMA
#undef PG8_WAIT_V
#undef PG8_WAIT_L
#undef PG8_BAR
#undef PG8_SCHED
}

typedef f32x4 Acc[2][2][4][2];

struct EpiPlain {
    static constexpr bool PERM = true;
    bf16_t* O0; bf16_t* O1; int split_tile; int ldc; int ncols_valid;
    DI void operator()(const Acc& acc, const Unit& u, int wr, int wc, int fr, int fq) const {
        asm volatile("" : "+v"(fr), "+v"(fq));
        const int row0 = u.pm * BM + wr * 64 + fr;
        bf16_t* base = O0; int colt = u.pn * BM; if (u.pn >= split_tile) { base = O1; colt -= split_tile * BM; }
        const int col0 = colt + wc * 32 + 8 * fq;
#pragma unroll
        for (int ai = 0; ai < 2; ++ai)
#pragma unroll
            for (int m = 0; m < 4; ++m) { bf16_t* rowp = base + (size_t)(row0 + ai * HALF + m * 16) * ldc + col0;
#pragma unroll
                for (int bj = 0; bj < 2; ++bj) { if (col0 + bj * HALF < ncols_valid) { const f32x4 v0 = acc[ai][bj][m][0], v1 = acc[ai][bj][m][1]; u32x4 w;
                    w.x = cvt_pk_bf16(v0[0], v0[1]); w.y = cvt_pk_bf16(v0[2], v0[3]); w.z = cvt_pk_bf16(v1[0], v1[1]); w.w = cvt_pk_bf16(v1[2], v1[3]);
                    *(u32x4*)(rowp + bj * HALF) = w; } } }
    }
};
struct EpiSwiglu {
    static constexpr bool PERM = true;
    bf16_t* O; int ldc;
    DI void operator()(const Acc& acc, const Unit& u, int wr, int wc, int fr, int fq) const {
        asm volatile("" : "+v"(fr), "+v"(fq));
        const int row0 = u.pm * BM + wr * 64 + fr; const int col0 = u.pn * HALF + wc * 32 + 8 * fq;
#pragma unroll
        for (int ai = 0; ai < 2; ++ai)
#pragma unroll
            for (int m = 0; m < 4; ++m) { bf16_t* rowp = O + (size_t)(row0 + ai * HALF + m * 16) * ldc + col0; float v[8];
#pragma unroll
                for (int n = 0; n < 2; ++n)
#pragma unroll
                    for (int j = 0; j < 4; ++j) { const float gg = acc[ai][0][m][n][j], uu = acc[ai][1][m][n][j]; v[n * 4 + j] = gg * sigmoid_f(gg) * uu; }
                u32x4 w; w.x = cvt_pk_bf16(v[0], v[1]); w.y = cvt_pk_bf16(v[2], v[3]); w.z = cvt_pk_bf16(v[4], v[5]); w.w = cvt_pk_bf16(v[6], v[7]);
                *(u32x4*)rowp = w; }
    }
};
template <bool BASEF32>
struct EpiResid {
    static constexpr bool PERM = true;
    const void* base_x; const void* base_h;
    bf16_t* out; const float* gate;
    bf16_t* part; float coef; int pad_;
    DI void operator()(const Acc& acc, const Unit& u, int wr, int wc, int fr, int fq) const {
        asm volatile("" : "+v"(fr), "+v"(fq));
        const int col0 = u.pn * BM + wc * 32 + 8 * fq;
        const int midx = u.pm < (MX / BM) ? (u.pm >> 3) : 16;
        const float* gp = gate + (size_t)midx * NMOD + col0;
        f32x4 gv[2][2];
#pragma unroll
        for (int bj = 0; bj < 2; ++bj)
#pragma unroll
            for (int n = 0; n < 2; ++n) gv[bj][n] = *(const f32x4*)(gp + bj * HALF + n * 4) * coef;
        if (u.part != 0) {
            bf16_t* pbase = part + (size_t)(u.part - 1) * MH * D_MODEL + (size_t)(u.pm - MX / BM) * BM * D_MODEL;
#pragma unroll
            for (int ai = 0; ai < 2; ++ai)
#pragma unroll
                for (int m = 0; m < 4; ++m) { const size_t off = (size_t)(ai * HALF + wr * 64 + m * 16 + fr) * D_MODEL + col0;
#pragma unroll
                    for (int bj = 0; bj < 2; ++bj) *(u32x4*)(pbase + off + bj * HALF) = pack8(gv[bj][0] * acc[ai][bj][m][0], gv[bj][1] * acc[ai][bj][m][1]); }
            return;
        }
        const size_t tile_off = u.pm < (MX / BM) ? (size_t)u.pm * BM * D_MODEL : (size_t)(u.pm - MX / BM) * BM * D_MODEL;
        const void* bsel = u.pm < (MX / BM) ? base_x : base_h;
        bf16_t* obase = out + (size_t)u.pm * BM * D_MODEL;
        const size_t off0 = (size_t)(wr * 64 + fr) * D_MODEL + col0;
        if (BASEF32) {
#pragma unroll
            for (int ai = 0; ai < 2; ++ai) { f32x4 bb[4][2][2];
#pragma unroll
                for (int m = 0; m < 4; ++m)
#pragma unroll
                    for (int bj = 0; bj < 2; ++bj) { const float* bp = (const float*)bsel + tile_off + off0 + (size_t)(ai * HALF + m * 16) * D_MODEL + bj * HALF; bb[m][bj][0] = *(const f32x4*)bp; bb[m][bj][1] = *(const f32x4*)(bp + 4); }
#pragma unroll
                for (int m = 0; m < 4; ++m)
#pragma unroll
                    for (int bj = 0; bj < 2; ++bj) { const f32x4 x0 = bb[m][bj][0] + gv[bj][0] * acc[ai][bj][m][0], x1 = bb[m][bj][1] + gv[bj][1] * acc[ai][bj][m][1];
                        *(u32x4*)(obase + off0 + (size_t)(ai * HALF + m * 16) * D_MODEL + bj * HALF) = pack8h(x0, x1); } }
        } else {
            u32x4 bb[2][4][2];
#pragma unroll
            for (int ai = 0; ai < 2; ++ai)
#pragma unroll
                for (int m = 0; m < 4; ++m)
#pragma unroll
                    for (int bj = 0; bj < 2; ++bj) bb[ai][m][bj] = *(const u32x4*)((const bf16_t*)bsel + tile_off + off0 + (size_t)(ai * HALF + m * 16) * D_MODEL + bj * HALF);
#pragma unroll
            for (int ai = 0; ai < 2; ++ai)
#pragma unroll
                for (int m = 0; m < 4; ++m)
#pragma unroll
                    for (int bj = 0; bj < 2; ++bj) { f32x4 b0, b1; unpack8h(bb[ai][m][bj], b0, b1);
                        const f32x4 x0 = b0 + gv[bj][0] * acc[ai][bj][m][0], x1 = b1 + gv[bj][1] * acc[ai][bj][m][1];
                        *(u32x4*)(obase + off0 + (size_t)(ai * HALF + m * 16) * D_MODEL + bj * HALF) = pack8h(x0, x1); }
        }
    }
};
DI void rope8(f32x4& x0, f32x4& x1, const float* rt, int fq) {
    const float* cp = rt + 2 * ((8 * fq) & 15);
    const f32x4 A = *(const f32x4*)cp, B = *(const f32x4*)(cp + 4), C = *(const f32x4*)(cp + 8), D = *(const f32x4*)(cp + 12);
    const f32x4 c0 = {A[0], A[2], B[0], B[2]}, s0 = {A[1], A[3], B[1], B[3]}, c1 = {C[0], C[2], D[0], D[2]}, s1 = {C[1], C[3], D[1], D[3]};
    const bool lo = fq < 2;
    f32x4 p0, p1;
#pragma unroll
    for (int j = 0; j < 4; ++j) {
        const auto r0 = __builtin_amdgcn_permlane32_swap(__float_as_uint(x0[j]), __float_as_uint(x0[j]), false, false);
        const auto r1 = __builtin_amdgcn_permlane32_swap(__float_as_uint(x1[j]), __float_as_uint(x1[j]), false, false);
        p0[j] = __uint_as_float(lo ? r0[1] : r0[0]); p1[j] = __uint_as_float(lo ? r1[1] : r1[0]); }
    const float sg = lo ? -1.f : 1.f;
    x0 = x0 * c0 + (p0 * s0) * sg; x1 = x1 * c1 + (p1 * s1) * sg;
}
struct EpiABIn {
    static constexpr bool PERM = true;
    bf16_t* Q; bf16_t* KV; bf16_t* Y; const float* rope; float qscale;
    DI void operator()(const Acc& acc, const Unit& u, int wr, int wc, int fr, int fq) const {
        asm volatile("" : "+v"(fr), "+v"(fq));
        const int rowt = u.pm * BM + wr * 64 + fr; const bool is_x = u.pm < (MX / BM);
        if (u.pn >= 3) {
            const int col0 = (u.pn - 3) * HALF + wc * 32 + 8 * fq;
#pragma unroll
            for (int ai = 0; ai < 2; ++ai)
#pragma unroll
                for (int m = 0; m < 4; ++m) { f32x4 v0, v1;
#pragma unroll
                    for (int j = 0; j < 4; ++j) { v0[j] = acc[ai][0][m][0][j] * sigmoid_f(acc[ai][1][m][0][j]); v1[j] = acc[ai][0][m][1][j] * sigmoid_f(acc[ai][1][m][1][j]); }
                    *(u32x4*)(Y + (size_t)(rowt + ai * HALF + m * 16) * 512 + col0) = pack8(v0, v1); }
        } else {
            const int a = wc & 1;
#pragma unroll
            for (int ai = 0; ai < 2; ++ai)
#pragma unroll
                for (int m = 0; m < 4; ++m) { const int row = rowt + ai * HALF + m * 16; const float* rt = rope + (size_t)(row & (SEQ - 1)) * 64 + a * 32;
#pragma unroll
                    for (int bj = 0; bj < 2; ++bj) { f32x4 x0 = acc[ai][bj][m][0], x1 = acc[ai][bj][m][1];
                        const bool do_rope = is_x && !(u.pn == 2 && bj == 1);
                        if (do_rope) rope8(x0, x1, rt, fq);
                        bf16_t* p;
                        if (u.pn < 2) { x0 = x0 * qscale; x1 = x1 * qscale; p = Q + (size_t)row * 512 + u.pn * BM + bj * HALF + wc * 32 + 8 * fq; }
                        else p = KV + (size_t)row * 256 + bj * HALF + wc * 32 + 8 * fq;
                        *(u32x4*)p = pack8(x0, x1); } }
        }
    }
};
struct EpiUq {
    static constexpr bool PERM = true;
    bf16_t* Q; const float* rope; float qscale;
    DI void operator()(const Acc& acc, const Unit& u, int wr, int wc, int fr, int fq) const {
        asm volatile("" : "+v"(fr), "+v"(fq));
        const int rowt = u.pm * BM + wr * 64 + fr;
#pragma unroll
        for (int ai = 0; ai < 2; ++ai)
#pragma unroll
            for (int m = 0; m < 4; ++m) { const int row = rowt + ai * HALF + m * 16;
#pragma unroll
                for (int bj = 0; bj < 2; ++bj) { const int blk = u.pn * 8 + bj * 4 + wc, bh = blk % 6;
                    f32x4 x0 = acc[ai][bj][m][0], x1 = acc[ai][bj][m][1];
                    if (bh >= 4) rope8(x0, x1, rope + (size_t)(row & (SEQ - 1)) * 64 + (bh - 4) * 32, fq);
                    x0 = x0 * qscale; x1 = x1 * qscale;
                    *(u32x4*)(Q + (size_t)row * 1536 + blk * 32 + 8 * fq) = pack8(x0, x1); } }
    }
};
}

struct AttnU {
    const bf16_t* Q; int ldq;
    const bf16_t* K1; int ldk1;
    const bf16_t* K2; int ldk2;
    const bf16_t* V; int ldv;
    bf16_t* O; int ldo;
    int nt_lat, lat_row0, kpos0, nt_ctx, ctx_row0, qpos0;
    float m0, l0;
};
#define MFMA32(a, b, c) __builtin_amdgcn_mfma_f32_32x32x16_bf16((a), (b), (c), 0, 0, 0)
typedef short v4i16_t __attribute__((ext_vector_type(4)));
DI s16x4 vtr(const LAS unsigned char* p) { return __builtin_bit_cast(s16x4, __builtin_amdgcn_ds_read_tr16_b64_v4i16((LAS v4i16_t*)p)); }
template <int DQK, int NK1, int DV, bool WINDOW, int DUMMY = 0>
DI void attn_unit(LAS unsigned char* lds, const AttnU& a) {
    constexpr int KSB = (DQK + 8) * 2, VROW = DV * 2 + 64, K_BYTES = 64 * KSB, BUF_BYTES = K_BYTES + 64 * VROW;
    constexpr int C1 = NK1 / 8, C2 = (DQK - NK1) / 8, CV = DV / 8;
    constexpr int L1 = C1 / 8, L2 = C2 / 8, LV = CV / 8, NKK = DQK / 16, NDB = DV / 32;
    int tid = threadIdx.x; asm volatile("" : "+v"(tid));
    const int lane = tid & 63, wid = __builtin_amdgcn_readfirstlane(tid >> 6), r = lane & 31, h = lane >> 5;
    bf16x8 qf[NKK];
    { const bf16_t* qrow = a.Q + (size_t)(wid * 32 + r) * a.ldq + 8 * h;
#pragma unroll
      for (int kk = 0; kk < NKK; ++kk) qf[kk] = *(const bf16x8*)(qrow + 16 * kk); }
    f32x16 o[NDB];
#pragma unroll
    for (int d = 0; d < NDB; ++d)
#pragma unroll
        for (int i = 0; i < 16; ++i) o[d][i] = 0.f;
    float m = a.m0, l = (h == 0) ? a.l0 : 0.f;
    const int nt = a.nt_lat + a.nt_ctx;
    u32x4 k1reg[L1 > 0 ? L1 : 1], k2reg[L2 > 0 ? L2 : 1], vreg[LV];
#define ATT_LOAD(j) do { const int grow_ = ((j) < a.nt_lat ? a.lat_row0 + 64 * (j) : a.ctx_row0 + 64 * ((j) - a.nt_lat)); \
        _Pragma("unroll") for (int i_ = 0; i_ < L1; ++i_) { const int x_ = tid + 512 * i_; k1reg[i_] = *(const u32x4*)(a.K1 + (size_t)(grow_ + x_ / C1) * a.ldk1 + (x_ % C1) * 8); } \
        _Pragma("unroll") for (int i_ = 0; i_ < L2; ++i_) { const int x_ = tid + 512 * i_; k2reg[i_] = *(const u32x4*)(a.K2 + (size_t)(grow_ + x_ / (C2 > 0 ? C2 : 1)) * a.ldk2 + (x_ % (C2 > 0 ? C2 : 1)) * 8); } \
        _Pragma("unroll") for (int i_ = 0; i_ < LV; ++i_) { const int x_ = tid + 512 * i_; vreg[i_] = *(const u32x4*)(a.V + (size_t)(grow_ + x_ / CV) * a.ldv + (x_ % CV) * 8); } } while (0)
#define ATT_STORE(buf) do { LAS unsigned char* Kw_ = lds + (buf) * BUF_BYTES; LAS unsigned char* Vw_ = Kw_ + K_BYTES; \
        _Pragma("unroll") for (int i_ = 0; i_ < L1; ++i_) { const int x_ = tid + 512 * i_; *(LAS u32x4*)(Kw_ + (x_ / C1) * KSB + (x_ % C1) * 16) = k1reg[i_]; } \
        _Pragma("unroll") for (int i_ = 0; i_ < L2; ++i_) { const int x_ = tid + 512 * i_; *(LAS u32x4*)(Kw_ + (x_ / (C2 > 0 ? C2 : 1)) * KSB + (C1 + x_ % (C2 > 0 ? C2 : 1)) * 16) = k2reg[i_]; } \
        _Pragma("unroll") for (int i_ = 0; i_ < LV; ++i_) { const int x_ = tid + 512 * i_; *(LAS u32x4*)(Vw_ + (x_ / CV) * VROW + (x_ % CV) * 16) = vreg[i_]; } } while (0)
    if (wid >= 4) __builtin_amdgcn_s_setprio(1);
    ATT_LOAD(0);
    __syncthreads();
    ATT_STORE(0);
    if (nt > 1) ATT_LOAD(1);
    __syncthreads();
    const int qp = a.qpos0 + wid * 32 + r;
    const int voff = (4 * h + ((lane & 15) >> 2)) * VROW + (16 * ((lane >> 4) & 1) + 4 * (lane & 3)) * 2;
    for (int j = 0; j < nt; ++j) {
        const int cur = j & 1;
        LAS unsigned char* Ks = lds + cur * BUF_BYTES; LAS unsigned char* Vs = Ks + K_BYTES + voff;
        bool active = true;
        const bool lat = j < a.nt_lat;
        if (WINDOW && lat) { const int kt = a.kpos0 + 64 * j, qw = a.qpos0 + wid * 32; active = (kt <= qw + 31 + 128) && (kt + 63 >= qw - 128); }
        if (active && DUMMY != 4) {
            f32x16 p0, p1;
#pragma unroll
            for (int i = 0; i < 16; ++i) { p0[i] = 0.f; p1[i] = 0.f; }
            {
                constexpr int KB = 2, NB = NKK / KB;
                bf16x8 ka[2][KB][2];
#pragma unroll
                for (int q = 0; q < KB; ++q) { ka[0][q][0] = *(const LAS bf16x8*)(Ks + r * KSB + q * 32 + h * 16); ka[0][q][1] = *(const LAS bf16x8*)(Ks + (32 + r) * KSB + q * 32 + h * 16); }
#pragma unroll
                for (int b = 0; b < NB; ++b) {
                    if (b + 1 < NB) {
#pragma unroll
                        for (int q = 0; q < KB; ++q) { const int kk = (b + 1) * KB + q;
                            ka[(b + 1) & 1][q][0] = *(const LAS bf16x8*)(Ks + r * KSB + kk * 32 + h * 16); ka[(b + 1) & 1][q][1] = *(const LAS bf16x8*)(Ks + (32 + r) * KSB + kk * 32 + h * 16); }
                    }
                    __builtin_amdgcn_sched_barrier(0);
#pragma unroll
                    for (int q = 0; q < KB; ++q) { p0 = MFMA32(ka[b & 1][q][0], qf[b * KB + q], p0); p1 = MFMA32(ka[b & 1][q][1], qf[b * KB + q], p1); }
                    __builtin_amdgcn_sched_barrier(0);
                }
            }
            constexpr int NDH = 1;
            s16x4 vlo[NDB][4], vhi[NDB][4];
            if (DUMMY != 2) {
#pragma unroll
            for (int d = 0; d < NDH; ++d)
#pragma unroll
                for (int s2 = 0; s2 < 4; ++s2) { vlo[d][s2] = vtr(Vs + (16 * s2) * VROW + 64 * d); vhi[d][s2] = vtr(Vs + (16 * s2 + 8) * VROW + 64 * d); }
            }
            __builtin_amdgcn_sched_barrier(0);
            if (WINDOW && lat) { const int kb = a.kpos0 + 64 * j + 4 * h;
#pragma unroll
                for (int i = 0; i < 16; ++i) { const int d0 = qp - (kb + (i & 3) + 8 * (i >> 2)); const int d1 = d0 - 32;
                    if (d0 > 128 || d0 < -128) p0[i] = -1e30f; if (d1 > 128 || d1 < -128) p1[i] = -1e30f; } }
            float mxa = max3f(p0[0], p0[1], p1[0]), mxb = max3f(p0[2], p0[3], p1[1]); mxa = max3f(mxa, p1[2], p1[3]);
#pragma unroll
            for (int i = 4; i < 16; i += 4) { mxa = max3f(mxa, p0[i], p0[i + 1]); mxb = max3f(mxb, p0[i + 2], p0[i + 3]); mxa = max3f(mxa, p1[i], p1[i + 1]); mxb = max3f(mxb, p1[i + 2], p1[i + 3]); }
            float mx = fmaxf(mxa, mxb);
            { const auto rr = __builtin_amdgcn_permlane32_swap(__float_as_uint(mx), __float_as_uint(mx), false, false); mx = fmaxf(__uint_as_float(rr[0]), __uint_as_float(rr[1])); }
            if (__any(mx > m + 8.f)) {
                const float mn = fmaxf(m, mx), alpha = fast_exp2(m - mn); m = mn; l *= alpha;
#pragma unroll
                for (int d = 0; d < NDB; ++d)
#pragma unroll
                    for (int i = 0; i < 16; ++i) o[d][i] *= alpha;
            }
            float sum = 0.f;
            if (DUMMY != 3) {
#pragma unroll
            for (int i = 0; i < 16; ++i) { p0[i] = fast_exp2(p0[i] - m); p1[i] = fast_exp2(p1[i] - m); }
            { f32x2 sa = {p0[0], p0[1]}, sb = {p1[0], p1[1]};
#pragma unroll
              for (int i = 2; i < 16; i += 2) { sa += (f32x2){p0[i], p0[i + 1]}; sb += (f32x2){p1[i], p1[i + 1]}; }
              sa += sb; sum = sa[0] + sa[1]; }
            } else sum = 1.f;
            l += sum;
            bf16x8 pb[4];
#pragma unroll
            for (int s = 0; s < 4; ++s) { u32x4 w;
#pragma unroll
                for (int q2 = 0; q2 < 4; ++q2) { const int i = 8 * (s & 1) + 2 * q2; w[q2] = (s < 2) ? cvt_pk_bf16(p0[i], p0[i + 1]) : cvt_pk_bf16(p1[i], p1[i + 1]); }
                pb[s] = __builtin_bit_cast(bf16x8, w); }
            __builtin_amdgcn_sched_barrier(0);
            if (DUMMY == 2) { o[0][0] += __builtin_bit_cast(float, (int)pb[0][0] | ((int)pb[1][1] << 8) | ((int)pb[2][2] << 16) ^ (int)pb[3][3]); }
            else
#pragma unroll
            for (int d = 0; d < NDB; ++d) {
                if (d + 1 < NDB) {
#pragma unroll
                    for (int s2 = 0; s2 < 4; ++s2) { vlo[d + 1][s2] = vtr(Vs + (16 * s2) * VROW + 64 * (d + 1)); vhi[d + 1][s2] = vtr(Vs + (16 * s2 + 8) * VROW + 64 * (d + 1)); }
                }
                __builtin_amdgcn_sched_barrier(0);
#pragma unroll
                for (int s2 = 0; s2 < 4; ++s2) { const bf16x8 av = __builtin_shufflevector(vlo[d][s2], vhi[d][s2], 0, 1, 2, 3, 4, 5, 6, 7); o[d] = MFMA32(av, pb[s2], o[d]); }
                __builtin_amdgcn_sched_barrier(0);
            }
        }
        if (j + 1 < nt) ATT_STORE(cur ^ 1);
        __syncthreads();
        if (j + 2 < nt) ATT_LOAD(j + 2);
    }
#undef ATT_LOAD
#undef ATT_STORE
    __builtin_amdgcn_s_setprio(0);
    { const auto rr = __builtin_amdgcn_permlane32_swap(__float_as_uint(l), __float_as_uint(l), false, false); l = __uint_as_float(rr[0]) + __uint_as_float(rr[1]); }
    const float inv = 1.f / l;
    bf16_t* orow = a.O + (size_t)(wid * 32 + r) * a.ldo;
#pragma unroll
    for (int d = 0; d < NDB; ++d)
#pragma unroll
        for (int g = 0; g < 4; ++g) { f32x4 v = {o[d][4 * g] * inv, o[d][4 * g + 1] * inv, o[d][4 * g + 2] * inv, o[d][4 * g + 3] * inv};
            if (!DUMMY || inv < 0.f) *(u32x2*)(orow + 32 * d + 8 * g + 4 * h) = pack4(v); }
}

DI void conv_unit(LAS unsigned char* lds, const bf16_t* Y, int row_base, int seqlen, int t0, const float* wdw, const float* bdw, const float* lng, const float* lnb, bf16_t* out) {
    int c = threadIdx.x; asm volatile("" : "+v"(c));
    const int lane = c & 63, wid = c >> 6;
    float in[62];
#pragma unroll
    for (int i = 0; i < 62; ++i) { const int t = t0 - 15 + i; in[i] = (t >= 0 && t < seqlen) ? bf2f(Y[(size_t)(row_base + t) * 512 + c]) : 0.f; }
    float w[31];
#pragma unroll
    for (int j = 0; j < 31; ++j) w[j] = wdw[j * 512 + c];
    const float bias = bdw[c];
    LAS float* buf = (LAS float*)lds;
    __syncthreads();
#pragma unroll
    for (int t = 0; t < 32; ++t) { float acc = bias;
#pragma unroll
        for (int j = 0; j < 31; ++j) acc += w[j] * in[t + j];
        buf[t * 516 + c] = acc; }
    __syncthreads();
#pragma unroll
    for (int tt = 0; tt < 4; ++tt) { const int t = wid * 4 + tt;
        const f32x4 v0 = *(const LAS f32x4*)(buf + t * 516 + lane * 8), v1 = *(const LAS f32x4*)(buf + t * 516 + lane * 8 + 4);
        const float mean = wave_sum((v0[0] + v0[1]) + (v0[2] + v0[3]) + (v1[0] + v1[1]) + (v1[2] + v1[3])) * (1.f / 512.f);
        const f32x4 d0 = v0 - mean, d1 = v1 - mean;
        const float var = wave_sum((d0[0] * d0[0] + d0[1] * d0[1]) + (d0[2] * d0[2] + d0[3] * d0[3]) + (d1[0] * d1[0] + d1[1] * d1[1]) + (d1[2] * d1[2] + d1[3] * d1[3])) * (1.f / 512.f);
        const float rstd = 1.f / sqrtf(var + 1e-5f);
        const f32x4 g0 = *(const f32x4*)(lng + lane * 8), g1 = *(const f32x4*)(lng + lane * 8 + 4), b0 = *(const f32x4*)(lnb + lane * 8), b1 = *(const f32x4*)(lnb + lane * 8 + 4);
        f32x4 y0 = d0 * rstd * g0 + b0, y1 = d1 * rstd * g1 + b1;
#pragma unroll
        for (int j = 0; j < 4; ++j) { y0[j] = y0[j] * sigmoid_f(y0[j]); y1[j] = y1[j] * sigmoid_f(y1[j]); }
        u32x4 wv; wv.x = cvt_pk_bf16(y0[0], y0[1]); wv.y = cvt_pk_bf16(y0[2], y0[3]); wv.z = cvt_pk_bf16(y1[0], y1[1]); wv.w = cvt_pk_bf16(y1[2], y1[3]);
        *(u32x4*)(out + (size_t)(row_base + t0 + t) * 1024 + 512 + lane * 8) = wv; }
}


#define XB_TMO      128
#define XB_XCNT(j)  (256  + 64 * (j))
#define XB_XSUB(j)  (1280 + 64 * (j))
#define XB_XGEN(j)  (2304 + 64 * (j))
#define XB_TOP      3328
#define XB_TOPGEN   3392
#define XCD_BAR_WORDS 3456
#define XB_SPIN_CAP (1u << 22)
DI unsigned xb_ld(unsigned* p)              { return __hip_atomic_load(p, __ATOMIC_RELAXED, __HIP_MEMORY_SCOPE_AGENT); }
DI unsigned xb_add(unsigned* p, unsigned v) { return __hip_atomic_fetch_add(p, v, __ATOMIC_RELAXED, __HIP_MEMORY_SCOPE_AGENT); }
DI unsigned xb_xcc_id() { return (unsigned)__builtin_amdgcn_s_getreg((3 << 11) | 20) & 0xFu; }
#define XB_SPIN(cond, bar) do { unsigned _sp = 0; while (cond) { __builtin_amdgcn_s_sleep(1); \
    if ((++_sp & 255u) == 0u) { if (xb_ld(&(bar)[XB_TMO])) break; if (_sp > XB_SPIN_CAP) { atomicAdd(&(bar)[XB_TMO], 1u); break; } } } } while (0)
struct XcdBarrier { unsigned* bar; unsigned x; volatile LAS unsigned* st; };
DI XcdBarrier xcd_barrier_post(unsigned* bar, volatile LAS unsigned* st) {
    XcdBarrier b; b.bar = bar; b.x = xb_xcc_id(); b.st = st;
    if (threadIdx.x == 0) (void)xb_add(&bar[XB_XCNT(b.x)], 1u);
    return b;
}
DI void xcd_barrier_complete(unsigned* bar, unsigned x, unsigned& nloc, unsigned& nx) {
    const unsigned G = gridDim.x * gridDim.y * gridDim.z;
    unsigned sum, cnt, mine, sp = 0u;
    for (;;) {
        sum = 0u; cnt = 0u; mine = 0u;
#pragma unroll
        for (unsigned j = 0; j < 16; ++j) { const unsigned c = xb_ld(&bar[XB_XCNT(j)]); sum += c; cnt += (c > 0u) ? 1u : 0u; mine = (j == x) ? c : mine; }
        if (sum == G) break;
        __builtin_amdgcn_s_sleep(1);
        if ((++sp & 255u) == 0u) { if (xb_ld(&bar[XB_TMO])) break; if (sp > XB_SPIN_CAP) { atomicAdd(&bar[XB_TMO], 1u); break; } }
    }
    nloc = mine > 0u ? mine : 1u; nx = cnt > 0u ? cnt : 1u;
}
DI void xcd_barrier(const XcdBarrier& b) {
    asm volatile("s_waitcnt vmcnt(0)" ::: "memory");
    __syncthreads();
    if (threadIdx.x == 0) {
        unsigned* bar = b.bar;
        __builtin_amdgcn_s_waitcnt(0);
        unsigned nloc = b.st[0], nx = b.st[1];
        if (nloc == 0u) { xcd_barrier_complete(bar, b.x, nloc, nx); b.st[0] = nloc; b.st[1] = nx; }
        const unsigned old = xb_add(&bar[XB_XSUB(b.x)], 1u);
        const unsigned gen = old / nloc;
        if (old + 1u == (gen + 1u) * nloc) {
            __builtin_amdgcn_fence(__ATOMIC_RELEASE, "agent");
            asm volatile("s_waitcnt vmcnt(0)" ::: "memory");
            const unsigned og = xb_add(&bar[XB_TOP], 1u);
            const unsigned tg = og / nx;
            if (og + 1u == (tg + 1u) * nx) xb_add(&bar[XB_TOPGEN], 1u);
            else XB_SPIN(xb_ld(&bar[XB_TOPGEN]) == tg, bar);
            __builtin_amdgcn_fence(__ATOMIC_ACQUIRE, "agent");
            xb_add(&bar[XB_XGEN(b.x)], 1u);
            asm volatile("s_waitcnt vmcnt(0)" ::: "memory");
        } else {
            XB_SPIN(xb_ld(&bar[XB_XGEN(b.x)]) == gen, bar);
            __builtin_amdgcn_fence(__ATOMIC_ACQUIRE, "agent");
            asm volatile("s_waitcnt vmcnt(0)" ::: "memory");
        }
    }
    __syncthreads();
}

struct Job { const float* src; bf16_t* dst; int K, N, ldd, map, row_off, item0; };
constexpr int NJOBS = 16;
struct Args {
    const float* in[25]; float* out; unsigned char* ws;
    Job jobs[NJOBS]; int nitems; int pad;
};

DI int job_rowmap(int map, int row_off, int n0) {
    if (map == 1) return n0 < D_FF ? 256 * (n0 / 128) + (n0 % 128) : 256 * ((n0 - D_FF) / 128) + 128 + ((n0 - D_FF) % 128);
    if (map == 2) return n0 < 768 ? n0 : (n0 < 1280 ? 768 + 256 * ((n0 - 768) / 128) + ((n0 - 768) % 128) : 768 + 256 * ((n0 - 1280) / 128) + 128 + ((n0 - 1280) % 128));
    return row_off + n0;
}
DI void transpose_item(const Job& jb, LAS float* scr, int item, int lane) {
    const int nblk = jb.N / 32, kb = item / nblk, nb = item % nblk, k0 = 64 * kb, n0 = 32 * nb;
    const float* W = jb.src; const int N = jb.N;
    float wv[32];
#pragma unroll
    for (int i = 0; i < 32; ++i) { const int kk = 2 * i + (lane >> 5); wv[i] = W[(size_t)(k0 + kk) * N + n0 + (lane & 31)]; }
#pragma unroll
    for (int i = 0; i < 32; ++i) { const int kk = 2 * i + (lane >> 5); scr[kk * 33 + (lane & 31)] = wv[i]; }
    asm volatile("s_waitcnt lgkmcnt(0)" ::: "memory");
    const int c = lane & 7;
    const int drow0 = job_rowmap(jb.map, jb.row_off, n0);
    const int kd0 = (jb.map == 3) ? (k0 / 128) * 192 + (k0 % 128) : k0;
#pragma unroll
    for (int j = 0; j < 4; ++j) { const int n = (lane >> 3) + 8 * j; const LAS float* s = scr + (8 * c) * 33 + n;
        u32x4 o; o.x = cvt_pk_bf16(s[0 * 33], s[1 * 33]); o.y = cvt_pk_bf16(s[2 * 33], s[3 * 33]); o.z = cvt_pk_bf16(s[4 * 33], s[5 * 33]); o.w = cvt_pk_bf16(s[6 * 33], s[7 * 33]);
        *(u32x4*)(jb.dst + (size_t)(drow0 + n) * jb.ldd + kd0 + 8 * c) = o; }
    asm volatile("s_waitcnt lgkmcnt(0)" ::: "memory");
}

template <bool SRCF32>
DI void norm_mod_row(const void* xrow, const float* g, const float* shift, const float* scale, bf16_t* orow, int lane, const bf16_t* addp, bf16_t* wb) {
    f32x4 v[4]; float s = 0.f;
#pragma unroll
    for (int j = 0; j < 2; ++j) { const int c = 8 * (lane + 64 * j);
        if (SRCF32) { v[2 * j] = *(const f32x4*)((const float*)xrow + c); v[2 * j + 1] = *(const f32x4*)((const float*)xrow + c + 4); }
        else unpack8h(*(const u32x4*)((const bf16_t*)xrow + c), v[2 * j], v[2 * j + 1]); }
    if (addp) {
#pragma unroll
        for (int j = 0; j < 2; ++j) { const int c = 8 * (lane + 64 * j);
#pragma unroll
            for (int q = 0; q < 3; ++q) { f32x4 a0, a1; unpack8(*(const u32x4*)(addp + (size_t)q * MH * D_MODEL + c), a0, a1); v[2 * j] = v[2 * j] + a0; v[2 * j + 1] = v[2 * j + 1] + a1; }
            *(u32x4*)(wb + c) = pack8h(v[2 * j], v[2 * j + 1]); } }
#pragma unroll
    for (int j = 0; j < 4; ++j) s += (v[j][0] * v[j][0] + v[j][1] * v[j][1]) + (v[j][2] * v[j][2] + v[j][3] * v[j][3]);
    const float rstd = 1.f / sqrtf(wave_sum(s) * (1.f / D_MODEL) + 1e-6f);
#pragma unroll
    for (int j = 0; j < 2; ++j) { const int c = 8 * (lane + 64 * j);
        const f32x4 y0 = (v[2 * j] * rstd * *(const f32x4*)(g + c)) * (*(const f32x4*)(scale + c) + 1.f) + *(const f32x4*)(shift + c);
        const f32x4 y1 = (v[2 * j + 1] * rstd * *(const f32x4*)(g + c + 4)) * (*(const f32x4*)(scale + c + 4) + 1.f) + *(const f32x4*)(shift + c + 4);
        *(u32x4*)(orow + c) = pack8(y0, y1); }
}

__global__ void __launch_bounds__(512, 2) fwd_kernel(Args args) {
    extern __shared__ __attribute__((aligned(16))) unsigned char lds_raw[];
    LAS unsigned char* lds = (LAS unsigned char*)lds_raw;
    cg::grid_group grid = cg::this_grid();
    const int G = gridDim.x, bx = blockIdx.x;
    const int vcu = (G % 8 == 0) ? (bx % 8) * (G / 8) + bx / 8 : bx;
    const int NGW = G * 8;
#define FRESH_IDS int tid = threadIdx.x; asm volatile("" : "+v"(tid)); const int lane = tid & 63, wave = __builtin_amdgcn_readfirstlane(tid >> 6); const int gw = vcu * 8 + wave; (void)lane; (void)gw;
    unsigned char* ws = args.ws;
    const float* x_in = args.in[0]; const float* c_in = args.in[1]; const float* ctx_in = args.in[2]; const float* cctx_in = args.in[3];
    const float* w_mod = args.in[4]; const float* b_mod = args.in[5]; const float* g_norm = args.in[6];
    const float* a_sink = args.in[10]; const float* b_w_dw = args.in[11]; const float* b_b_dw = args.in[12]; const float* b_ln_g = args.in[13]; const float* b_ln_b = args.in[14];
    const float* c_g_q = args.in[17]; const float* c_g_kv = args.in[20]; const float* g_final = args.in[24];
    float* rope = (float*)(ws + WS_ROPE); float* mod = (float*)(ws + WS_MOD);
    bf16_t* xs = (bf16_t*)(ws + WS_XS);
    unsigned char* R = ws + WS_R;

    volatile LAS unsigned* bar_st = (volatile LAS unsigned*)(lds + 131072);
    unsigned* bar_words = (unsigned*)(ws + WS_BAR);
    {
        FRESH_IDS
        if (tid < 2) bar_st[tid] = 0u;
        if (bx == 0) for (int i = tid; i < XCD_BAR_WORDS; i += 512) bar_words[i] = 0u;
        LAS float* scr = (LAS float*)(lds + wave * 8704);
        for (int rep = 0; rep < (PROBE == 6 ? 2 : 1); ++rep) {
        __syncthreads();
        for (int it = gw; it < args.nitems; it += NGW) {
            int ji = 0;
#pragma unroll
            for (int q = 1; q < NJOBS; ++q) if (it >= args.jobs[q].item0) ji = q;
            Job jb = args.jobs[0];
#pragma unroll
            for (int q = 1; q < NJOBS; ++q) if (ji == q) jb = args.jobs[q];
            transpose_item(jb, scr, it - jb.item0, lane);
        }
        { bf16_t* wd = (bf16_t*)(ws + WS_WD) + (size_t)576 * 1024; const int n16 = 192 * 1024 / 8;
          for (int i = bx * 512 + tid; i < n16; i += G * 512) ((u32x4*)wd)[i] = (u32x4){0u, 0u, 0u, 0u};
 }
        for (int i = bx * 512 + tid; i < SEQ * 32; i += G * 512) { const int t = i >> 5, ai = i & 31, a = ai >> 4, ii = ai & 15;
            const float inv_freq = powf(10000.0f, -(float)(2 * ii) / 32.0f); const float pos = a == 0 ? (float)(t >> 6) : (float)(t & 63); const float ang = pos * inv_freq;
            rope[2 * i] = cosf(ang); rope[2 * i + 1] = sinf(ang); }
        __syncthreads();
        LAS float* sl = (LAS float*)lds;
        LAS float* red = (LAS float*)(lds + 17 * 1024 * 4);
        for (int i = tid; i < 17 * 1024; i += 512) { const float v = i < 16 * 1024 ? c_in[i] : cctx_in[i - 16 * 1024]; sl[i] = v / (1.f + expf(-v)); }
        __syncthreads();
        const int ks = tid >> 5, col = tid & 31;
        for (int u = vcu; u < 2 * (NMOD / 32); u += G) { const int l = u / (NMOD / 32), c0 = (u % (NMOD / 32)) * 32;
            float acc[17];
#pragma unroll
            for (int r = 0; r < 17; ++r) acc[r] = 0.f;
            const float* wp = w_mod + (size_t)l * D_MODEL * NMOD + (size_t)(ks * 64) * NMOD + c0 + col;
#pragma unroll 4
            for (int k = 0; k < 64; ++k) { const float wv = wp[(size_t)k * NMOD];
#pragma unroll
                for (int r = 0; r < 17; ++r) acc[r] += sl[r * 1024 + ks * 64 + k] * wv; }
#pragma unroll
            for (int r = 0; r < 17; ++r) red[(ks * 17 + r) * 32 + col] = acc[r];
            __syncthreads();
            for (int i = tid; i < 17 * 32; i += 512) { const int r = i >> 5, cc = i & 31; float s = b_mod[l * NMOD + c0 + cc];
#pragma unroll
                for (int q = 0; q < 16; ++q) s += red[(q * 17 + r) * 32 + cc];
                mod[((size_t)l * 17 + r) * NMOD + c0 + cc] = s; }
            __syncthreads();
        }
        }
    }
    grid.sync();
    const XcdBarrier xbar = xcd_barrier_post(bar_words, bar_st);
#define GSYNC() xcd_barrier(xbar)

#define NORM_PHASE(F32, LAYER, WHICH, SRCX, SRCH, DST, MROWS) do { FRESH_IDS \
        const float* g_ = g_norm + ((LAYER) * 3 + (WHICH)) * D_MODEL; const float* modl_ = mod + (size_t)(LAYER) * 17 * NMOD + (size_t)(3 * (WHICH)) * D_MODEL; \
        for (int row_ = gw; row_ < (MROWS); row_ += NGW) { const int mi_ = row_ < MX ? row_ / SEQ : 16; \
            const void* xr_ = row_ < MX ? (const void*)((SRCX) + (size_t)row_ * D_MODEL) : (const void*)((SRCH) + (size_t)(row_ - MX) * D_MODEL); \
            norm_mod_row<F32>(xr_, g_, modl_ + (size_t)mi_ * NMOD, modl_ + (size_t)mi_ * NMOD + D_MODEL, (DST) + (size_t)row_ * D_MODEL, lane, (!((LAYER) == 0 && (WHICH) == 0) && row_ >= MX) ? (const bf16_t*)(ws + WS_PART) + (size_t)(row_ - MX) * D_MODEL : (const bf16_t*)nullptr, xs + (size_t)row_ * D_MODEL); } } while (0)

#define FFN_PHASES(F32, LAYER, WHICH, S, SRCX, SRCH, MROWS) do { \
        NORM_PHASE(F32, LAYER, WHICH, SRCX, SRCH, (bf16_t*)(R + R_XN), MROWS); \
        GSYNC(); \
        if (PROBE == 2) { pg8::Gemm g_{(const bf16_t*)(R + R_XN), (const bf16_t*)(ws + WS_WIN + (size_t)((LAYER) * 2 + (S)) * W_IN_BYTES), (MROWS), 2 * D_FF, D_MODEL, D_MODEL, D_MODEL}; \
          pg8::StaticOrder S_; S_.init((MROWS), 2 * D_FF, D_MODEL, G, bx); pg8::EpiSwiglu E_{(bf16_t*)(R + R_ACT), D_FF}; pg8::gemm_phase(lds, g_, S_, E_); GSYNC(); } \
        { pg8::Gemm g_{(const bf16_t*)(R + R_XN), (const bf16_t*)(ws + WS_WIN + (size_t)((LAYER) * 2 + (S)) * W_IN_BYTES), (MROWS), 2 * D_FF, D_MODEL, D_MODEL, D_MODEL}; \
          pg8::StaticOrder S_; S_.init((MROWS), 2 * D_FF, D_MODEL, G, bx); pg8::EpiSwiglu E_{(bf16_t*)(R + R_ACT), D_FF}; pg8::gemm_phase(lds, g_, S_, E_); } \
        GSYNC(); \
        { pg8::Gemm g_{(const bf16_t*)(R + R_ACT), (const bf16_t*)(ws + WS_WOUT + (size_t)((LAYER) * 2 + (S)) * W_OUT_BYTES), (MROWS), D_MODEL, D_FF, D_FF, D_FF}; \
          pg8::EpiResid<F32> E_{(SRCX), (SRCH), xs, mod + (size_t)(LAYER) * 17 * NMOD + (size_t)(3 * (WHICH) + 2) * D_MODEL, (bf16_t*)(ws + WS_PART), 0.5f, 0}; \
          if ((MROWS) == MT) { pg8::SplitOrder S_; S_.init(D_MODEL, D_FF, G, bx); pg8::gemm_phase(lds, g_, S_, E_); } \
          else { pg8::StaticOrder S_; S_.init((MROWS), D_MODEL, D_FF, G, bx); pg8::gemm_phase(lds, g_, S_, E_); } } \
        GSYNC(); if (PROBE == 5) { GSYNC(); GSYNC(); GSYNC(); GSYNC(); GSYNC(); } } while (0)

    const bf16_t* xs_h = xs + (size_t)MX * D_MODEL;
    FFN_PHASES(true, 0, 0, 0, x_in, ctx_in, MT);
    NORM_PHASE(false, 0, 1, xs, xs_h, (bf16_t*)(R + R_XN), MT);
    GSYNC();
    { pg8::Gemm g_{(const bf16_t*)(R + R_XN), (const bf16_t*)(ws + WS_WABIN), MT, 1792, D_MODEL, D_MODEL, D_MODEL};
      pg8::StaticOrder S_; S_.init(MT, 1792, D_MODEL, G, bx);
      pg8::EpiABIn E_{(bf16_t*)(R + R_Q), (bf16_t*)(R + R_KV), (bf16_t*)(R + R_Y), rope, 0.125f * LOG2E}; pg8::gemm_phase(lds, g_, S_, E_); }
    GSYNC();
    {
        const bf16_t* Qb = (const bf16_t*)(R + R_Q); const bf16_t* KVb = (const bf16_t*)(R + R_KV); bf16_t* cat = (bf16_t*)(R + R_CAT);
        for (int rep = 0; rep < (PROBE == 4 ? 2 : 1); ++rep) {
        const int apw = (1152 + G - 1) / G;
        for (int u = vcu * apw; u < vcu * apw + apw; ++u) {
            if (u >= 1152) break;
            AttnU a; int b, hq;
            if (u < 1024) { b = u >> 6; hq = (u >> 3) & 7; const int qb = u & 7; const int q0 = qb * 256;
                const int lo = q0 - 128 < 0 ? 0 : q0 - 128, hi = q0 + 384 > SEQ ? SEQ : q0 + 384;
                a.Q = Qb + (size_t)(b * SEQ + q0) * 512 + hq * 64; a.O = cat + (size_t)(b * SEQ + q0) * 1024 + hq * 64;
                a.nt_lat = (hi - lo) / 64; a.lat_row0 = b * SEQ + lo; a.kpos0 = lo; a.qpos0 = q0;
            } else { const int v = u - 1024; b = v >> 3; hq = v & 7;
                a.Q = Qb + (size_t)(MX + b * CTX) * 512 + hq * 64; a.O = cat + (size_t)(MX + b * CTX) * 1024 + hq * 64;
                a.nt_lat = 0; a.lat_row0 = 0; a.kpos0 = 0; a.qpos0 = 0; }
            a.ldq = 512; a.ldo = 1024; const int hkv = hq >> 2;
            a.K1 = KVb + hkv * 64; a.ldk1 = 256; a.K2 = a.K1; a.ldk2 = 256; a.V = KVb + 128 + hkv * 64; a.ldv = 256;
            a.nt_ctx = 4; a.ctx_row0 = MX + b * CTX; a.m0 = a_sink[hq] * LOG2E; a.l0 = 1.f;
            attn_unit<64, 64, 64, true>(lds, a);
        }
        __syncthreads();
        for (int u = vcu; u < 1152; u += G) { int row_base, seqlen, t0;
            if (u < 1024) { row_base = (u >> 6) * SEQ; seqlen = SEQ; t0 = (u & 63) * 32; } else { const int v = u - 1024; row_base = MX + (v >> 3) * CTX; seqlen = CTX; t0 = (v & 7) * 32; }
            conv_unit(lds, (const bf16_t*)(R + R_Y), row_base, seqlen, t0, b_w_dw, b_b_dw, b_ln_g, b_ln_b, cat); }
        }
    }
    GSYNC();
    { pg8::Gemm g_{(const bf16_t*)(R + R_CAT), (const bf16_t*)(ws + WS_WABOUT), MT, D_MODEL, D_MODEL, D_MODEL, D_MODEL};
      pg8::SplitOrder S_; S_.init(D_MODEL, D_MODEL, G, bx);
      pg8::EpiResid<false> E_{xs, xs_h, xs, mod + (size_t)5 * D_MODEL, (bf16_t*)(ws + WS_PART), 1.0f, 0}; pg8::gemm_phase(lds, g_, S_, E_); }
    GSYNC();
    FFN_PHASES(false, 0, 2, 1, xs, xs_h, MT);

    FFN_PHASES(false, 1, 0, 0, xs, xs_h, MT);
    NORM_PHASE(false, 1, 1, xs, xs_h, (bf16_t*)(R + R_XN), MT);
    GSYNC();
    { pg8::Gemm g_{(const bf16_t*)(R + R_XN), (const bf16_t*)(ws + WS_WD), MT, 768, D_MODEL, D_MODEL, D_MODEL};
      pg8::StaticOrder S_; S_.init(MT, 768, D_MODEL, G, bx);
      pg8::EpiPlain E_{(bf16_t*)(R + R_D), (bf16_t*)(R + R_D), 1000, LDD, LDD}; pg8::gemm_phase(lds, g_, S_, E_); }
    GSYNC();
    {
        FRESH_IDS
        bf16_t* Db = (bf16_t*)(R + R_D);
        for (int row = gw; row < MT; row += NGW) { bf16_t* dr = Db + (size_t)row * LDD;
            const u32x2 qa = ((const u32x2*)dr)[lane], ka = ((const u32x2*)(dr + 256))[lane]; const float kr = bf2f(dr[512 + lane]);
            f32x4 q = {__uint_as_float(qa.x << 16), __uint_as_float(qa.x & 0xffff0000u), __uint_as_float(qa.y << 16), __uint_as_float(qa.y & 0xffff0000u)};
            f32x4 k = {__uint_as_float(ka.x << 16), __uint_as_float(ka.x & 0xffff0000u), __uint_as_float(ka.y << 16), __uint_as_float(ka.y & 0xffff0000u)};
            const float rq = 1.f / sqrtf(wave_sum((q[0] * q[0] + q[1] * q[1]) + (q[2] * q[2] + q[3] * q[3])) * (1.f / 256.f) + 1e-6f);
            const float rk = 1.f / sqrtf(wave_sum((k[0] * k[0] + k[1] * k[1]) + (k[2] * k[2] + k[3] * k[3])) * (1.f / 256.f) + 1e-6f);
            q = q * rq * ((const f32x4*)c_g_q)[lane]; k = k * rk * ((const f32x4*)c_g_kv)[lane];
            float kro = kr;
            const float partner = __shfl_xor(kr, 16);
            if (row < MX) { const int t = row & (SEQ - 1); const float cs = rope[(size_t)t * 64 + ((lane >> 5) * 16 + (lane & 15)) * 2], sn = rope[(size_t)t * 64 + ((lane >> 5) * 16 + (lane & 15)) * 2 + 1];
                const float rot = (lane & 16) ? partner : -partner; kro = kr * cs + rot * sn; }
            ((u32x2*)dr)[lane] = pack4(q); ((u32x2*)(dr + 256))[lane] = pack4(k); dr[512 + lane] = (bf16_t)(cvt_pk_bf16(kro, 0.f) & 0xffffu); }
    }
    GSYNC();
    { pg8::Gemm g_{(const bf16_t*)(R + R_D), (const bf16_t*)(ws + WS_WUQ), MX, 1536, 256, LDD, 256};
      pg8::StaticOrder S_; S_.init(MX, 1536, 256, G, bx);
      pg8::EpiUq E_{(bf16_t*)(R + R_Q2), rope, 0.07216878364870322f * LOG2E}; pg8::gemm_phase(lds, g_, S_, E_); }
    { pg8::Gemm g_{(const bf16_t*)(R + R_D) + 256, (const bf16_t*)(ws + WS_WUKV), MT, 2048, 256, LDD, 256};
      pg8::StaticOrder S_; S_.init(MT, 2048, 256, G, bx);
      pg8::EpiPlain E_{(bf16_t*)(R + R_KN), (bf16_t*)(R + R_V), 4, D_MODEL, 1 << 30}; pg8::gemm_phase(lds, g_, S_, E_); }
    GSYNC();
    {
        bf16_t* Q2 = (bf16_t*)(R + R_Q2); const bf16_t* Kn = (const bf16_t*)(R + R_KN); const bf16_t* Db = (const bf16_t*)(R + R_D); const bf16_t* Vb = (const bf16_t*)(R + R_V);
        const int mpw = (1024 + G - 1) / G;
        for (int u = vcu * mpw; u < vcu * mpw + mpw; ++u) { if (u >= 1024) break; const int b = u >> 6, hh = (u >> 3) & 7, qb = u & 7;
            AttnU a; a.Q = Q2 + (size_t)(b * SEQ + qb * 256) * 1536 + hh * 192; a.ldq = 1536; a.O = Q2 + (size_t)(b * SEQ + qb * 256) * 1536 + hh * 192; a.ldo = 1536;
            a.K1 = Kn + hh * 128; a.ldk1 = D_MODEL; a.K2 = Db + 512; a.ldk2 = LDD; a.V = Vb + hh * 128; a.ldv = D_MODEL;
            a.nt_lat = SEQ / 64; a.lat_row0 = b * SEQ; a.kpos0 = 0; a.nt_ctx = 4; a.ctx_row0 = MX + b * CTX; a.qpos0 = 0; a.m0 = -1e30f; a.l0 = 0.f;
            if (PROBE == 1) attn_unit<192, 128, 128, false, 1>(lds, a);
            if (PROBE == 7) attn_unit<192, 128, 128, false, 4>(lds, a);
            if (PROBE == 8) attn_unit<192, 128, 128, false, 3>(lds, a);
            if (PROBE == 9) attn_unit<192, 128, 128, false, 2>(lds, a);
            attn_unit<192, 128, 128, false>(lds, a); }
        __syncthreads();
    }
    GSYNC();
    { pg8::Gemm g_{(const bf16_t*)(R + R_Q2), (const bf16_t*)(ws + WS_WO), MX, D_MODEL, D_MODEL, 1536, D_MODEL, 1};
      pg8::StaticOrder S_; S_.init(MX, D_MODEL, D_MODEL, G, bx);
      pg8::EpiResid<false> E_{xs, xs_h, xs, mod + (size_t)17 * NMOD + (size_t)5 * D_MODEL, (bf16_t*)(ws + WS_PART), 1.0f, 0}; pg8::gemm_phase(lds, g_, S_, E_); }
    GSYNC();
    FFN_PHASES(false, 1, 2, 1, xs, xs_h, MX);
    FRESH_IDS
    for (int row = gw; row < MX; row += NGW) { const bf16_t* xr = xs + (size_t)row * D_MODEL;
        f32x4 v[4]; float sq = 0.f;
#pragma unroll
        for (int j = 0; j < 2; ++j) unpack8h(*(const u32x4*)(xr + 8 * (lane + 64 * j)), v[2 * j], v[2 * j + 1]);
#pragma unroll
        for (int j = 0; j < 4; ++j) sq += (v[j][0] * v[j][0] + v[j][1] * v[j][1]) + (v[j][2] * v[j][2] + v[j][3] * v[j][3]);
        const float rstd = 1.f / sqrtf(wave_sum(sq) * (1.f / D_MODEL) + 1e-6f);
        float* orow = args.out + (size_t)row * D_MODEL;
#pragma unroll
        for (int j = 0; j < 2; ++j) { const int c = 8 * (lane + 64 * j);
            *(f32x4*)(orow + c) = v[2 * j] * rstd * *(const f32x4*)(g_final + c); *(f32x4*)(orow + c + 4) = v[2 * j + 1] * rstd * *(const f32x4*)(g_final + c + 4); } }
}

extern "C" void kernel_launch(void* const* d_in, const int* in_sizes, int n_in, void* d_out, int out_size, void* d_ws, size_t ws_size, hipStream_t stream) {
    static int grid = 0;
    if (grid == 0) {
        if (n_in != 25 || ws_size < WS_END || out_size != MX * D_MODEL) { fprintf(stderr, "kernel_launch: unexpected shapes: n_in %d ws %zu out %d\n", n_in, ws_size, out_size); grid = -1; return; }
        int dev = 0, cus = 0, per_cu = 0;
        if (hipGetDevice(&dev) != hipSuccess || hipDeviceGetAttribute(&cus, hipDeviceAttributeMultiprocessorCount, dev) != hipSuccess) { grid = -1; return; }
        if (hipFuncSetAttribute((const void*)fwd_kernel, hipFuncAttributeMaxDynamicSharedMemorySize, LDS_BYTES) != hipSuccess) { fprintf(stderr, "kernel_launch: hipFuncSetAttribute failed\n"); grid = -1; return; }
        if (hipOccupancyMaxActiveBlocksPerMultiprocessor(&per_cu, (const void*)fwd_kernel, 512, LDS_BYTES) != hipSuccess || per_cu < 1) { fprintf(stderr, "kernel_launch: occupancy query says %d\n", per_cu); per_cu = 1; }
        (void)hipGetLastError();
        grid = cus;
    }
    if (grid < 0) return;
    Args a{};
    for (int i = 0; i < 25; ++i) a.in[i] = (const float*)d_in[i];
    a.out = (float*)d_out; a.ws = (unsigned char*)d_ws;
    unsigned char* ws = (unsigned char*)d_ws;
    int nj = 0, items = 0;
    auto add = [&](const float* src, size_t dst_off, int K, int N, int ldd, int map, int row_off) {
        Job& j = a.jobs[nj++]; j.src = src; j.dst = (bf16_t*)(ws + dst_off); j.K = K; j.N = N; j.ldd = ldd; j.map = map; j.row_off = row_off; j.item0 = items; items += (K / 64) * (N / 32); };
    const float* ffn_w_in = (const float*)d_in[7]; const float* ffn_w_out = (const float*)d_in[8];
    for (int i = 0; i < 4; ++i) add(ffn_w_in + (size_t)i * D_MODEL * 2 * D_FF, WS_WIN + i * W_IN_BYTES, D_MODEL, 2 * D_FF, D_MODEL, 1, 0);
    for (int i = 0; i < 4; ++i) add(ffn_w_out + (size_t)i * D_FF * D_MODEL, WS_WOUT + i * W_OUT_BYTES, D_FF, D_MODEL, D_FF, 0, 0);
    add((const float*)d_in[9], WS_WABIN, D_MODEL, 1792, D_MODEL, 2, 0);
    add((const float*)d_in[15], WS_WABOUT, D_MODEL, D_MODEL, D_MODEL, 0, 0);
    add((const float*)d_in[16], WS_WD, D_MODEL, 256, D_MODEL, 0, 0);
    add((const float*)d_in[19], WS_WD, D_MODEL, 320, D_MODEL, 0, 256);
    add((const float*)d_in[18], WS_WUQ, 256, 1536, 256, 0, 0);
    add((const float*)d_in[21], WS_WUKV, 256, 1024, 256, 0, 0);
    add((const float*)d_in[22], WS_WUKV, 256, 1024, 256, 0, 1024);
    add((const float*)d_in[23], WS_WO, D_MODEL, D_MODEL, D_MODEL, 0, 0);
    a.nitems = items;
    void* kargs[] = {&a};
    hipError_t e = hipLaunchCooperativeKernel((const void*)fwd_kernel, dim3(grid), dim3(512), kargs, LDS_BYTES, stream);
    if (e != hipSuccess) fprintf(stderr, "kernel_launch: cooperative launch failed: %s (grid %d)\n", hipGetErrorString(e), grid);
}
```

```cpp
#include <hip/hip_runtime.h>
#include <hip/hip_cooperative_groups.h>
#include <cstdio>
#include <cstdint>
namespace cg = cooperative_groups;

#define LAS __attribute__((address_space(3)))
#define DI __device__ __forceinline__
typedef unsigned short bf16_t;
typedef short bf16x8 __attribute__((ext_vector_type(8)));
typedef short s16x4 __attribute__((ext_vector_type(4)));
typedef float f32x4 __attribute__((ext_vector_type(4)));
typedef float f32x16 __attribute__((ext_vector_type(16)));
typedef unsigned u32x4 __attribute__((ext_vector_type(4)));
typedef unsigned u32x2 __attribute__((ext_vector_type(2)));

constexpr int D_MODEL = 1024, BATCH = 16, SEQ = 2048, CTX = 256, D_FF = 2816;
constexpr int MX = BATCH * SEQ;
constexpr int MH = BATCH * CTX;
constexpr int MT = MX + MH;
constexpr int NMOD = 9 * D_MODEL;
constexpr float LOG2E = 1.4426950408889634f;

constexpr size_t MiB = 1u << 20;
constexpr size_t WS_ROPE = 0;
constexpr size_t WS_MOD = 512 * 1024;
constexpr size_t WS_BAR = 1792 * 1024;
constexpr size_t WS_W = 2 * MiB;
constexpr size_t W_IN_BYTES = (size_t)2 * D_FF * D_MODEL * 2;
constexpr size_t W_OUT_BYTES = (size_t)D_MODEL * D_FF * 2;
constexpr size_t WS_WIN = WS_W;
constexpr size_t WS_WOUT = WS_WIN + 4 * W_IN_BYTES;
constexpr size_t WS_WABIN = WS_WOUT + 4 * W_OUT_BYTES;
constexpr size_t WS_WABOUT = WS_WABIN + (size_t)1792 * 1024 * 2;
constexpr size_t WS_WD = WS_WABOUT + (size_t)1024 * 1024 * 2;
constexpr size_t WS_WUQ = WS_WD + (size_t)768 * 1024 * 2;
constexpr size_t WS_WUKV = WS_WUQ + (size_t)1536 * 256 * 2;
constexpr size_t WS_WO = WS_WUKV + (size_t)2048 * 256 * 2;
constexpr size_t WS_WEND = WS_WO + (size_t)1024 * 1536 * 2;
static_assert(WS_WEND <= 80 * MiB, "weights");
constexpr size_t WS_XS = 80 * MiB;
constexpr size_t WS_PART = 152 * MiB;
constexpr size_t WS_R = 224 * MiB;
constexpr size_t WS_END = 512 * MiB;
constexpr size_t R_XN = 0;
constexpr size_t R_ACT = 72 * MiB;
constexpr size_t R_PART = 270 * MiB;
constexpr size_t R_CAT = 0;
constexpr size_t R_Q = 72 * MiB;
constexpr size_t R_KV = 108 * MiB;
constexpr size_t R_Y = 126 * MiB;
constexpr size_t R_KN = 0;
constexpr int LDD = 576;
constexpr size_t R_D = 72 * MiB;
constexpr size_t R_Q2 = 113 * MiB;
constexpr size_t R_V = 209 * MiB;
static_assert(R_V + 72 * MiB <= 288 * MiB && R_ACT + 198 * MiB <= 288 * MiB, "R map");

#ifndef PROBE
#define PROBE 0
#endif
constexpr int LDS_BYTES = 135168;

typedef float f32x2c __attribute__((ext_vector_type(2))); typedef __bf16 bf16x2c __attribute__((ext_vector_type(2)));
DI unsigned cvt_pk_bf16(float lo, float hi) { const f32x2c v = {lo, hi}; const bf16x2c b = __builtin_convertvector(v, bf16x2c); return __builtin_bit_cast(unsigned, b); }
DI float bf2f(bf16_t v) { return __uint_as_float((unsigned)v << 16); }
DI float fast_exp2(float x) { return __builtin_amdgcn_exp2f(x); }
DI float fast_rcp(float x) { return __builtin_amdgcn_rcpf(x); }
DI float sigmoid_f(float x) { return fast_rcp(1.f + fast_exp2(-x * LOG2E)); }
DI float wave_sum(float v) {
#pragma unroll
    for (int o = 1; o < 64; o <<= 1) v += __shfl_xor(v, o);
    return v;
}
typedef _Float16 h16x2 __attribute__((ext_vector_type(2)));
DI unsigned cvt_pk_f16(float lo, float hi) { const h16x2 v = {(_Float16)lo, (_Float16)hi}; return __builtin_bit_cast(unsigned, v); }
DI void unpack8h(const u32x4 w, f32x4& a, f32x4& b) {
    const unsigned w0 = w[0], w1 = w[1], w2 = w[2], w3 = w[3];
    const h16x2 p0 = __builtin_bit_cast(h16x2, w0), p1 = __builtin_bit_cast(h16x2, w1), p2 = __builtin_bit_cast(h16x2, w2), p3 = __builtin_bit_cast(h16x2, w3);
    a = (f32x4){(float)p0[0], (float)p0[1], (float)p1[0], (float)p1[1]}; b = (f32x4){(float)p2[0], (float)p2[1], (float)p3[0], (float)p3[1]};
}
DI u32x4 pack8h(const f32x4 a, const f32x4 b) { u32x4 o; o.x = cvt_pk_f16(a[0], a[1]); o.y = cvt_pk_f16(a[2], a[3]); o.z = cvt_pk_f16(b[0], b[1]); o.w = cvt_pk_f16(b[2], b[3]); return o; }
typedef float f32x2 __attribute__((ext_vector_type(2)));
DI float max3f(float a, float b, float c) { return __builtin_fmaxf(__builtin_fmaxf(a, b), c); }
DI void unpack8(const u32x4 w, f32x4& a, f32x4& b) {
    a = (f32x4){__uint_as_float(w.x << 16), __uint_as_float(w.x & 0xffff0000u), __uint_as_float(w.y << 16), __uint_as_float(w.y & 0xffff0000u)};
    b = (f32x4){__uint_as_float(w.z << 16), __uint_as_float(w.z & 0xffff0000u), __uint_as_float(w.w << 16), __uint_as_float(w.w & 0xffff0000u)};
}
DI u32x4 pack8(const f32x4 a, const f32x4 b) { u32x4 o; o.x = cvt_pk_bf16(a[0], a[1]); o.y = cvt_pk_bf16(a[2], a[3]); o.z = cvt_pk_bf16(b[0], b[1]); o.w = cvt_pk_bf16(b[2], b[3]); return o; }
DI u32x2 pack4(f32x4 v) { u32x2 w; w.x = cvt_pk_bf16(v[0], v[1]); w.y = cvt_pk_bf16(v[2], v[3]); return w; }

namespace pg8 {
constexpr int BM = 256, BK = 64, HALF = 128, HTB = HALF * BK * 2, STAGE_BYTES = 8 * HTB, NXCD = 8, WGM = 8;
DI int lds_byte(int r, int c) { const int st = (r >> 4) * 2 + (c >> 5), rr = r & 15, cc = c & 31, ob = rr * 64 + cc * 2; return st * 1024 + (ob ^ (((ob >> 9) & 1) << 5)); }
DI void stage_rc(int b, int& R, int& C) { const int st = b / 1024, sb = b % 1024, swz = sb ^ (((sb >> 9) & 1) << 5); R = (st >> 1) * 16 + swz / 64; C = (st & 1) * 32 + (swz % 64) / 2; }
DI int perm32(int rho) { const int n = rho >> 4, i = rho & 15; return 8 * (i >> 2) + 4 * n + (i & 3); }

struct Unit { int pm, pn, k0, nk, part; };
struct Gemm { const bf16_t* A; const bf16_t* Bt; int M, N, K, lda, ldb; int amode = 0; };

struct StaticOrder {
    int nM, nN, nwg, G, c;
    int ntk;
    DI void init(int M, int N, int K, int G_, int c_) { nM = M / BM; nN = N / BM; nwg = nM * nN; G = G_; c = c_; ntk = K / BK; }
    DI Unit get(int i, bool& ok) const { return at((long)i * G + c, ok); }
    DI Unit at(long L, bool& ok) const {
        Unit u; u.pm = 0; u.pn = 0; u.k0 = 0; u.nk = ntk; u.part = 0; ok = L < nwg; if (!ok) return u;
        int wgid = (int)L; { const int q = nwg / NXCD, r = nwg % NXCD, xcd = wgid % NXCD, off = wgid / NXCD; wgid = (xcd < r ? xcd * (q + 1) : r * (q + 1) + (xcd - r) * q) + off; }
        const int nig = WGM * nN, gid = wgid / nig, fm = gid * WGM, gsz = (nM - fm) < WGM ? (nM - fm) : WGM;
        u.pm = fm + ((wgid % nig) % gsz); u.pn = (wgid % nig) / gsz; return u;
    }
};
struct SplitOrder {
    StaticOrder full; int G, c, ntk;
    DI void init(int N, int K, int G_, int c_) { full.init(MX, N, K, G_, c_); G = G_; c = c_; ntk = K / BK; }
    DI Unit get(int i, bool& ok) const {
        const long L = (long)i * G + c;
        if (L < full.nwg) return full.at(L, ok);
        const int q = (int)(L - full.nwg); ok = q < 256;
        Unit u; u.pm = MX / BM + (q >> 4); u.pn = (q >> 2) & 3; const int part = q & 3; u.part = part;
        if (ntk == 44) { u.k0 = part * 11 + (part & 1); u.nk = 12 - 2 * (part & 1); }
        else { u.nk = ntk / 4; u.k0 = part * u.nk; }
        return u;
    }
};

template <class Epi, class Sched>
DI void gemm_phase(LAS unsigned char* lds, const Gemm g, const Sched& S, const Epi& E) {
    int tid = threadIdx.x; asm volatile("" : "+v"(tid));
    const int wid = __builtin_amdgcn_readfirstlane(tid >> 6), lane = tid & 63, wr = wid >> 2, wc = wid & 3, fr = lane & 15, fq = lane >> 4;
    unsigned voffA[2], voffB[2];
#pragma unroll
    for (int i = 0; i < 2; ++i) { int R, C; stage_rc(tid * 16 + i * 8192, R, C); const int Rb = Epi::PERM ? ((R & ~31) + perm32(R & 31)) : R;
        voffA[i] = (unsigned)(R * g.lda + C) * 2u; voffB[i] = (unsigned)(Rb * g.ldb + C) * 2u; }
    const size_t kstep = (size_t)(BK * 2);
    const size_t hstepA = (size_t)HALF * g.lda * 2, hstepB = (size_t)HALF * g.ldb * 2;
    const size_t tstepA = 2 * hstepA, tstepB = 2 * hstepB;
    const unsigned ldsw = (unsigned)wid * 1024u;
    const int aoff = lds_byte(wr * 64 + fr, fq * 8), boff = lds_byte(wc * 32 + fr, fq * 8);
#define PG8_SA(b, h) (((b) * 2 + (h)) * HTB)
#define PG8_SB(b, h) ((4 + (b) * 2 + (h)) * HTB)
#define PG8_STAGE(bufoff, gbase, voff) do { _Pragma("unroll") for (int _i = 0; _i < 2; ++_i) \
        __builtin_amdgcn_global_load_lds((const unsigned*)((const char*)(gbase) + (voff)[_i]), (LAS unsigned*)(lds + (bufoff) + ldsw + _i * 8192), 16, 0, 0); } while (0)
#define PG8_LDA(dst, b, h) do { _Pragma("unroll") for (int m = 0; m < 4; ++m) _Pragma("unroll") for (int k = 0; k < 2; ++k) dst[m][k] = *(const LAS bf16x8*)(lds + PG8_SA(b, h) + aoff + m * 2048 + k * 1024); } while (0)
#define PG8_LDB(dst, b, h) do { _Pragma("unroll") for (int n = 0; n < 2; ++n) _Pragma("unroll") for (int k = 0; k < 2; ++k) dst[n][k] = *(const LAS bf16x8*)(lds + PG8_SB(b, h) + boff + n * 2048 + k * 1024); } while (0)
#define PG8_MMA(ai, bj, At, Bt) do { __builtin_amdgcn_s_setprio(1); _Pragma("unroll") for (int m = 0; m < 4; ++m) _Pragma("unroll") for (int n = 0; n < 2; ++n) _Pragma("unroll") for (int k = 0; k < 2; ++k) \
        acc[ai][bj][m][n] = __builtin_amdgcn_mfma_f32_16x16x32_bf16(Bt[n][k], At[m][k], acc[ai][bj][m][n], 0, 0, 0); __builtin_amdgcn_s_setprio(0); } while (0)
#define PG8_WAIT_V(n) asm volatile("s_waitcnt vmcnt(" #n ")" ::: "memory")
#define PG8_WAIT_L(n) asm volatile("s_waitcnt lgkmcnt(" #n ")" ::: "memory")
#define PG8_BAR __builtin_amdgcn_s_barrier()
#define PG8_SCHED __builtin_amdgcn_sched_barrier(0)
    int ui = 0; bool ok0;
    Unit cur = S.get(0, ok0), nxt = cur;
    if (!ok0) return;
    f32x4 acc[2][2][4][2];
#pragma unroll
    for (int a = 0; a < 2; ++a)
#pragma unroll
        for (int b = 0; b < 2; ++b)
#pragma unroll
            for (int m = 0; m < 4; ++m)
#pragma unroll
                for (int n = 0; n < 2; ++n) acc[a][b][m][n] = (f32x4){0.f, 0.f, 0.f, 0.f};
    bf16x8 At[4][2], B0[2][2], B1[2][2];
    const char* cA = (const char*)g.A + (size_t)cur.pm * tstepA + (size_t)cur.k0 * kstep; const char* cB = (const char*)g.Bt + (size_t)cur.pn * tstepB + (size_t)cur.k0 * kstep;
    PG8_STAGE(PG8_SB(0, 0), cB, voffB); PG8_STAGE(PG8_SB(0, 1), cB + hstepB, voffB); PG8_STAGE(PG8_SA(0, 0), cA, voffA); PG8_STAGE(PG8_SA(0, 1), cA + hstepA, voffA);
    if (wr == 1) PG8_BAR;
    PG8_WAIT_V(2); PG8_BAR;
    PG8_STAGE(PG8_SB(1, 0), cB + kstep, voffB); PG8_STAGE(PG8_SA(1, 0), cA + kstep, voffA); PG8_STAGE(PG8_SB(1, 1), cB + hstepB + kstep, voffB);
    PG8_WAIT_V(6); PG8_BAR;
    for (;;) {
        bool has_next; nxt = S.get(ui + 1, has_next);
        const char* nA = has_next ? (const char*)g.A + (size_t)nxt.pm * tstepA + (size_t)nxt.k0 * kstep : cA; const char* nB = has_next ? (const char*)g.Bt + (size_t)nxt.pn * tstepB + (size_t)nxt.k0 * kstep : cB;
        const int nt = cur.nk;
        for (int t = 0; t < nt; t += 2) {
            const bool last = (t == nt - 2);
            const char* a1 = cA + (g.amode ? (size_t)(t + 1 + (t >> 1)) * kstep : (size_t)(t + 1) * kstep);
            const char* a2 = last ? nA : cA + (g.amode ? (size_t)(t + 2 + ((t + 2) >> 1)) * kstep : (size_t)(t + 2) * kstep); const char* b2 = last ? nB : cB + (size_t)(t + 2) * kstep;
            const char* a3 = a2 + kstep; const char* b3 = b2 + kstep;
            PG8_LDB(B0, 0, 0); PG8_LDB(B1, 0, 1); PG8_SCHED; PG8_LDA(At, 0, 0); PG8_STAGE(PG8_SA(1, 1), a1 + hstepA, voffA);
            PG8_WAIT_V(8); PG8_WAIT_L(0); PG8_BAR; PG8_MMA(0, 0, At, B0); PG8_MMA(0, 1, At, B1); PG8_BAR; PG8_SCHED;
            PG8_LDA(At, 0, 1); PG8_STAGE(PG8_SB(0, 0), b2, voffB); PG8_STAGE(PG8_SB(0, 1), b2 + hstepB, voffB); PG8_STAGE(PG8_SA(0, 0), a2, voffA);
            PG8_WAIT_V(8); PG8_WAIT_L(0); PG8_BAR; PG8_MMA(1, 0, At, B0); PG8_MMA(1, 1, At, B1); PG8_BAR; PG8_SCHED;
            PG8_LDB(B0, 1, 0); PG8_LDB(B1, 1, 1); PG8_SCHED; PG8_LDA(At, 1, 0); PG8_STAGE(PG8_SA(0, 1), a2 + hstepA, voffA);
            PG8_WAIT_V(8); PG8_WAIT_L(0); PG8_BAR; PG8_MMA(0, 0, At, B0); PG8_MMA(0, 1, At, B1); PG8_BAR; PG8_SCHED;
            PG8_LDA(At, 1, 1); PG8_STAGE(PG8_SB(1, 0), b3, voffB); PG8_STAGE(PG8_SB(1, 1), b3 + hstepB, voffB); PG8_STAGE(PG8_SA(1, 0), a3, voffA);
            PG8_WAIT_V(8); PG8_WAIT_L(0); PG8_BAR; PG8_MMA(1, 0, At, B0); PG8_MMA(1, 1, At, B1); PG8_BAR; PG8_SCHED;
        }
        if (wr == 0) PG8_BAR;
        E(acc, cur, wr, wc, fr, fq);
        if (!has_next) break;
#pragma unroll
        for (int a = 0; a < 2; ++a)
#pragma unroll
            for (int b = 0; b < 2; ++b)
#pragma unroll
                for (int m = 0; m < 4; ++m)
#pragma unroll
                    for (int n = 0; n < 2; ++n) acc[a][b][m][n] = (f32x4){0.f, 0.f, 0.f, 0.f};
        cur = nxt; cA = nA; cB = nB; ++ui;
        if (wr == 1) PG8_BAR;
    }
    PG8_WAIT_V(0);
    PG8_BAR;
#undef PG8_SA
#undef PG8_SB
#undef PG8_STAGE
#undef PG8_LDA
#undef PG8_LDB
#undef PG8_MMA
#undef PG8_WAIT_V
#undef PG8_WAIT_L
#undef PG8_BAR
#undef PG8_SCHED
}

typedef f32x4 Acc[2][2][4][2];

struct EpiPlain {
    static constexpr bool PERM = true;
    bf16_t* O0; bf16_t* O1; int split_tile; int ldc; int ncols_valid;
    DI void operator()(const Acc& acc, const Unit& u, int wr, int wc, int fr, int fq) const {
        asm volatile("" : "+v"(fr), "+v"(fq));
        const int row0 = u.pm * BM + wr * 64 + fr;
        bf16_t* base = O0; int colt = u.pn * BM; if (u.pn >= split_tile) { base = O1; colt -= split_tile * BM; }
        const int col0 = colt + wc * 32 + 8 * fq;
#pragma unroll
        for (int ai = 0; ai < 2; ++ai)
#pragma unroll
            for (int m = 0; m < 4; ++m) { bf16_t* rowp = base + (size_t)(row0 + ai * HALF + m * 16) * ldc + col0;
#pragma unroll
                for (int bj = 0; bj < 2; ++bj) { if (col0 + bj * HALF < ncols_valid) { const f32x4 v0 = acc[ai][bj][m][0], v1 = acc[ai][bj][m][1]; u32x4 w;
                    w.x = cvt_pk_bf16(v0[0], v0[1]); w.y = cvt_pk_bf16(v0[2], v0[3]); w.z = cvt_pk_bf16(v1[0], v1[1]); w.w = cvt_pk_bf16(v1[2], v1[3]);
                    *(u32x4*)(rowp + bj * HALF) = w; } } }
    }
};
struct EpiSwiglu {
    static constexpr bool PERM = true;
    bf16_t* O; int ldc;
    DI void operator()(const Acc& acc, const Unit& u, int wr, int wc, int fr, int fq) const {
        asm volatile("" : "+v"(fr), "+v"(fq));
        const int row0 = u.pm * BM + wr * 64 + fr; const int col0 = u.pn * HALF + wc * 32 + 8 * fq;
#pragma unroll
        for (int ai = 0; ai < 2; ++ai)
#pragma unroll
            for (int m = 0; m < 4; ++m) { bf16_t* rowp = O + (size_t)(row0 + ai * HALF + m * 16) * ldc + col0; float v[8];
#pragma unroll
                for (int n = 0; n < 2; ++n)
#pragma unroll
                    for (int j = 0; j < 4; ++j) { const float gg = acc[ai][0][m][n][j], uu = acc[ai][1][m][n][j]; v[n * 4 + j] = gg * sigmoid_f(gg) * uu; }
                u32x4 w; w.x = cvt_pk_bf16(v[0], v[1]); w.y = cvt_pk_bf16(v[2], v[3]); w.z = cvt_pk_bf16(v[4], v[5]); w.w = cvt_pk_bf16(v[6], v[7]);
                *(u32x4*)rowp = w; }
    }
};
template <bool BASEF32>
struct EpiResid {
    static constexpr bool PERM = true;
    const void* base_x; const void* base_h;
    bf16_t* out; const float* gate;
    bf16_t* part; float coef; int pad_;
    DI void operator()(const Acc& acc, const Unit& u, int wr, int wc, int fr, int fq) const {
        asm volatile("" : "+v"(fr), "+v"(fq));
        const int col0 = u.pn * BM + wc * 32 + 8 * fq;
        const int midx = u.pm < (MX / BM) ? (u.pm >> 3) : 16;
        const float* gp = gate + (size_t)midx * NMOD + col0;
        f32x4 gv[2][2];
#pragma unroll
        for (int bj = 0; bj < 2; ++bj)
#pragma unroll
            for (int n = 0; n < 2; ++n) gv[bj][n] = *(const f32x4*)(gp + bj * HALF + n * 4) * coef;
        if (u.part != 0) {
            bf16_t* pbase = part + (size_t)(u.part - 1) * MH * D_MODEL + (size_t)(u.pm - MX / BM) * BM * D_MODEL;
#pragma unroll
            for (int ai = 0; ai < 2; ++ai)
#pragma unroll
                for (int m = 0; m < 4; ++m) { const size_t off = (size_t)(ai * HALF + wr * 64 + m * 16 + fr) * D_MODEL + col0;
#pragma unroll
                    for (int bj = 0; bj < 2; ++bj) *(u32x4*)(pbase + off + bj * HALF) = pack8(gv[bj][0] * acc[ai][bj][m][0], gv[bj][1] * acc[ai][bj][m][1]); }
            return;
        }
        const size_t tile_off = u.pm < (MX / BM) ? (size_t)u.pm * BM * D_MODEL : (size_t)(u.pm - MX / BM) * BM * D_MODEL;
        const void* bsel = u.pm < (MX / BM) ? base_x : base_h;
        bf16_t* obase = out + (size_t)u.pm * BM * D_MODEL;
        const size_t off0 = (size_t)(wr * 64 + fr) * D_MODEL + col0;
        if (BASEF32) {
#pragma unroll
            for (int ai = 0; ai < 2; ++ai) { f32x4 bb[4][2][2];
#pragma unroll
                for (int m = 0; m < 4; ++m)
#pragma unroll
                    for (int bj = 0; bj < 2; ++bj) { const float* bp = (const float*)bsel + tile_off + off0 + (size_t)(ai * HALF + m * 16) * D_MODEL + bj * HALF; bb[m][bj][0] = *(const f32x4*)bp; bb[m][bj][1] = *(const f32x4*)(bp + 4); }
#pragma unroll
                for (int m = 0; m < 4; ++m)
#pragma unroll
                    for (int bj = 0; bj < 2; ++bj) { const f32x4 x0 = bb[m][bj][0] + gv[bj][0] * acc[ai][bj][m][0], x1 = bb[m][bj][1] + gv[bj][1] * acc[ai][bj][m][1];
                        *(u32x4*)(obase + off0 + (size_t)(ai * HALF + m * 16) * D_MODEL + bj * HALF) = pack8h(x0, x1); } }
        } else {
            u32x4 bb[2][4][2];
#pragma unroll
            for (int ai = 0; ai < 2; ++ai)
#pragma unroll
                for (int m = 0; m < 4; ++m)
#pragma unroll
                    for (int bj = 0; bj < 2; ++bj) bb[ai][m][bj] = *(const u32x4*)((const bf16_t*)bsel + tile_off + off0 + (size_t)(ai * HALF + m * 16) * D_MODEL + bj * HALF);
#pragma unroll
            for (int ai = 0; ai < 2; ++ai)
#pragma unroll
                for (int m = 0; m < 4; ++m)
#pragma unroll
                    for (int bj = 0; bj < 2; ++bj) { f32x4 b0, b1; unpack8h(bb[ai][m][bj], b0, b1);
                        const f32x4 x0 = b0 + gv[bj][0] * acc[ai][bj][m][0], x1 = b1 + gv[bj][1] * acc[ai][bj][m][1];
                        *(u32x4*)(obase + off0 + (size_t)(ai * HALF + m * 16) * D_MODEL + bj * HALF) = pack8h(x0, x1); }
        }
    }
};
DI void rope8(f32x4& x0, f32x4& x1, const float* rt, int fq) {
    const float* cp = rt + 2 * ((8 * fq) & 15);
    const f32x4 A = *(const f32x4*)cp, B = *(const f32x4*)(cp + 4), C = *(const f32x4*)(cp + 8), D = *(const f32x4*)(cp + 12);
    const f32x4 c0 = {A[0], A[2], B[0], B[2]}, s0 = {A[1], A[3], B[1], B[3]}, c1 = {C[0], C[2], D[0], D[2]}, s1 = {C[1], C[3], D[1], D[3]};
    const bool lo = fq < 2;
    f32x4 p0, p1;
#pragma unroll
    for (int j = 0; j < 4; ++j) {
        const auto r0 = __builtin_amdgcn_permlane32_swap(__float_as_uint(x0[j]), __float_as_uint(x0[j]), false, false);
        const auto r1 = __builtin_amdgcn_permlane32_swap(__float_as_uint(x1[j]), __float_as_uint(x1[j]), false, false);
        p0[j] = __uint_as_float(lo ? r0[1] : r0[0]); p1[j] = __uint_as_float(lo ? r1[1] : r1[0]); }
    const float sg = lo ? -1.f : 1.f;
    x0 = x0 * c0 + (p0 * s0) * sg; x1 = x1 * c1 + (p1 * s1) * sg;
}
struct EpiABIn {
    static constexpr bool PERM = true;
    bf16_t* Q; bf16_t* KV; bf16_t* Y; const float* rope; float qscale;
    DI void operator()(const Acc& acc, const Unit& u, int wr, int wc, int fr, int fq) const {
        asm volatile("" : "+v"(fr), "+v"(fq));
        const int rowt = u.pm * BM + wr * 64 + fr; const bool is_x = u.pm < (MX / BM);
        if (u.pn >= 3) {
            const int col0 = (u.pn - 3) * HALF + wc * 32 + 8 * fq;
#pragma unroll
            for (int ai = 0; ai < 2; ++ai)
#pragma unroll
                for (int m = 0; m < 4; ++m) { f32x4 v0, v1;
#pragma unroll
                    for (int j = 0; j < 4; ++j) { v0[j] = acc[ai][0][m][0][j] * sigmoid_f(acc[ai][1][m][0][j]); v1[j] = acc[ai][0][m][1][j] * sigmoid_f(acc[ai][1][m][1][j]); }
                    *(u32x4*)(Y + (size_t)(rowt + ai * HALF + m * 16) * 512 + col0) = pack8(v0, v1); }
        } else {
            const int a = wc & 1;
#pragma unroll
            for (int ai = 0; ai < 2; ++ai)
#pragma unroll
                for (int m = 0; m < 4; ++m) { const int row = rowt + ai * HALF + m * 16; const float* rt = rope + (size_t)(row & (SEQ - 1)) * 64 + a * 32;
#pragma unroll
                    for (int bj = 0; bj < 2; ++bj) { f32x4 x0 = acc[ai][bj][m][0], x1 = acc[ai][bj][m][1];
                        const bool do_rope = is_x && !(u.pn == 2 && bj == 1);
                        if (do_rope) rope8(x0, x1, rt, fq);
                        bf16_t* p;
                        if (u.pn < 2) { x0 = x0 * qscale; x1 = x1 * qscale; p = Q + (size_t)row * 512 + u.pn * BM + bj * HALF + wc * 32 + 8 * fq; }
                        else p = KV + (size_t)row * 256 + bj * HALF + wc * 32 + 8 * fq;
                        *(u32x4*)p = pack8(x0, x1); } }
        }
    }
};
struct EpiUq {
    static constexpr bool PERM = true;
    bf16_t* Q; const float* rope; float qscale;
    DI void operator()(const Acc& acc, const Unit& u, int wr, int wc, int fr, int fq) const {
        asm volatile("" : "+v"(fr), "+v"(fq));
        const int rowt = u.pm * BM + wr * 64 + fr;
#pragma unroll
        for (int ai = 0; ai < 2; ++ai)
#pragma unroll
            for (int m = 0; m < 4; ++m) { const int row = rowt + ai * HALF + m * 16;
#pragma unroll
                for (int bj = 0; bj < 2; ++bj) { const int blk = u.pn * 8 + bj * 4 + wc, bh = blk % 6;
                    f32x4 x0 = acc[ai][bj][m][0], x1 = acc[ai][bj][m][1];
                    if (bh >= 4) rope8(x0, x1, rope + (size_t)(row & (SEQ - 1)) * 64 + (bh - 4) * 32, fq);
                    x0 = x0 * qscale; x1 = x1 * qscale;
                    *(u32x4*)(Q + (size_t)row * 1536 + blk * 32 + 8 * fq) = pack8(x0, x1); } }
    }
};
}

struct AttnU {
    const bf16_t* Q; int ldq;
    const bf16_t* K1; int ldk1;
    const bf16_t* K2; int ldk2;
    const bf16_t* V; int ldv;
    bf16_t* O; int ldo;
    int nt_lat, lat_row0, kpos0, nt_ctx, ctx_row0, qpos0;
    float m0, l0;
};
#define MFMA32(a, b, c) __builtin_amdgcn_mfma_f32_32x32x16_bf16((a), (b), (c), 0, 0, 0)
typedef short v4i16_t __attribute__((ext_vector_type(4)));
DI s16x4 vtr(const LAS unsigned char* p) { return __builtin_bit_cast(s16x4, __builtin_amdgcn_ds_read_tr16_b64_v4i16((LAS v4i16_t*)p)); }
template <int DQK, int NK1, int DV, bool WINDOW, int DUMMY = 0>
DI void attn_unit(LAS unsigned char* lds, const AttnU& a) {
    constexpr int KSB = (DQK + 8) * 2, VROW = DV * 2 + 64, K_BYTES = 64 * KSB, BUF_BYTES = K_BYTES + 64 * VROW;
    constexpr int C1 = NK1 / 8, C2 = (DQK - NK1) / 8, CV = DV / 8;
    constexpr int L1 = C1 / 8, L2 = C2 / 8, LV = CV / 8, NKK = DQK / 16, NDB = DV / 32;
    int tid = threadIdx.x; asm volatile("" : "+v"(tid));
    const int lane = tid & 63, wid = __builtin_amdgcn_readfirstlane(tid >> 6), r = lane & 31, h = lane >> 5;
    bf16x8 qf[NKK];
    { const bf16_t* qrow = a.Q + (size_t)(wid * 32 + r) * a.ldq + 8 * h;
#pragma unroll
      for (int kk = 0; kk < NKK; ++kk) qf[kk] = *(const bf16x8*)(qrow + 16 * kk); }
    f32x16 o[NDB];
#pragma unroll
    for (int d = 0; d < NDB; ++d)
#pragma unroll
        for (int i = 0; i < 16; ++i) o[d][i] = 0.f;
    float m = a.m0, l = (h == 0) ? a.l0 : 0.f;
    const int nt = a.nt_lat + a.nt_ctx;
    u32x4 k1reg[L1 > 0 ? L1 : 1], k2reg[L2 > 0 ? L2 : 1], vreg[LV];
#define ATT_LOAD(j) do { const int grow_ = ((j) < a.nt_lat ? a.lat_row0 + 64 * (j) : a.ctx_row0 + 64 * ((j) - a.nt_lat)); \
        _Pragma("unroll") for (int i_ = 0; i_ < L1; ++i_) { const int x_ = tid + 512 * i_; k1reg[i_] = *(const u32x4*)(a.K1 + (size_t)(grow_ + x_ / C1) * a.ldk1 + (x_ % C1) * 8); } \
        _Pragma("unroll") for (int i_ = 0; i_ < L2; ++i_) { const int x_ = tid + 512 * i_; k2reg[i_] = *(const u32x4*)(a.K2 + (size_t)(grow_ + x_ / (C2 > 0 ? C2 : 1)) * a.ldk2 + (x_ % (C2 > 0 ? C2 : 1)) * 8); } \
        _Pragma("unroll") for (int i_ = 0; i_ < LV; ++i_) { const int x_ = tid + 512 * i_; vreg[i_] = *(const u32x4*)(a.V + (size_t)(grow_ + x_ / CV) * a.ldv + (x_ % CV) * 8); } } while (0)
#define ATT_STORE(buf) do { LAS unsigned char* Kw_ = lds + (buf) * BUF_BYTES; LAS unsigned char* Vw_ = Kw_ + K_BYTES; \
        _Pragma("unroll") for (int i_ = 0; i_ < L1; ++i_) { const int x_ = tid + 512 * i_; *(LAS u32x4*)(Kw_ + (x_ / C1) * KSB + (x_ % C1) * 16) = k1reg[i_]; } \
        _Pragma("unroll") for (int i_ = 0; i_ < L2; ++i_) { const int x_ = tid + 512 * i_; *(LAS u32x4*)(Kw_ + (x_ / (C2 > 0 ? C2 : 1)) * KSB + (C1 + x_ % (C2 > 0 ? C2 : 1)) * 16) = k2reg[i_]; } \
        _Pragma("unroll") for (int i_ = 0; i_ < LV; ++i_) { const int x_ = tid + 512 * i_; *(LAS u32x4*)(Vw_ + (x_ / CV) * VROW + (x_ % CV) * 16) = vreg[i_]; } } while (0)
    if (wid >= 4) __builtin_amdgcn_s_setprio(1);
    ATT_LOAD(0);
    __syncthreads();
    ATT_STORE(0);
    if (nt > 1) ATT_LOAD(1);
    __syncthreads();
    const int qp = a.qpos0 + wid * 32 + r;
    const int voff = (4 * h + ((lane & 15) >> 2)) * VROW + (16 * ((lane >> 4) & 1) + 4 * (lane & 3)) * 2;
    for (int j = 0; j < nt; ++j) {
        const int cur = j & 1;
        LAS unsigned char* Ks = lds + cur * BUF_BYTES; LAS unsigned char* Vs = Ks + K_BYTES + voff;
        bool active = true;
        const bool lat = j < a.nt_lat;
        if (WINDOW && lat) { const int kt = a.kpos0 + 64 * j, qw = a.qpos0 + wid * 32; active = (kt <= qw + 31 + 128) && (kt + 63 >= qw - 128); }
        if (active && DUMMY != 4) {
            f32x16 p0, p1;
#pragma unroll
            for (int i = 0; i < 16; ++i) { p0[i] = 0.f; p1[i] = 0.f; }
            {
                constexpr int KB = 2, NB = NKK / KB;
                bf16x8 ka[2][KB][2];
#pragma unroll
                for (int q = 0; q < KB; ++q) { ka[0][q][0] = *(const LAS bf16x8*)(Ks + r * KSB + q * 32 + h * 16); ka[0][q][1] = *(const LAS bf16x8*)(Ks + (32 + r) * KSB + q * 32 + h * 16); }
#pragma unroll
                for (int b = 0; b < NB; ++b) {
                    if (b + 1 < NB) {
#pragma unroll
                        for (int q = 0; q < KB; ++q) { const int kk = (b + 1) * KB + q;
                            ka[(b + 1) & 1][q][0] = *(const LAS bf16x8*)(Ks + r * KSB + kk * 32 + h * 16); ka[(b + 1) & 1][q][1] = *(const LAS bf16x8*)(Ks + (32 + r) * KSB + kk * 32 + h * 16); }
                    }
                    __builtin_amdgcn_sched_barrier(0);
#pragma unroll
                    for (int q = 0; q < KB; ++q) { p0 = MFMA32(ka[b & 1][q][0], qf[b * KB + q], p0); p1 = MFMA32(ka[b & 1][q][1], qf[b * KB + q], p1); }
                    __builtin_amdgcn_sched_barrier(0);
                }
            }
            constexpr int NDH = 1;
            s16x4 vlo[NDB][4], vhi[NDB][4];
            if (DUMMY != 2) {
#pragma unroll
            for (int d = 0; d < NDH; ++d)
#pragma unroll
                for (int s2 = 0; s2 < 4; ++s2) { vlo[d][s2] = vtr(Vs + (16 * s2) * VROW + 64 * d); vhi[d][s2] = vtr(Vs + (16 * s2 + 8) * VROW + 64 * d); }
            }
            __builtin_amdgcn_sched_barrier(0);
            if (WINDOW && lat) { const int kb = a.kpos0 + 64 * j + 4 * h;
#pragma unroll
                for (int i = 0; i < 16; ++i) { const int d0 = qp - (kb + (i & 3) + 8 * (i >> 2)); const int d1 = d0 - 32;
                    if (d0 > 128 || d0 < -128) p0[i] = -1e30f; if (d1 > 128 || d1 < -128) p1[i] = -1e30f; } }
            float mxa = max3f(p0[0], p0[1], p1[0]), mxb = max3f(p0[2], p0[3], p1[1]); mxa = max3f(mxa, p1[2], p1[3]);
#pragma unroll
            for (int i = 4; i < 16; i += 4) { mxa = max3f(mxa, p0[i], p0[i + 1]); mxb = max3f(mxb, p0[i + 2], p0[i + 3]); mxa = max3f(mxa, p1[i], p1[i + 1]); mxb = max3f(mxb, p1[i + 2], p1[i + 3]); }
            float mx = fmaxf(mxa, mxb);
            { const auto rr = __builtin_amdgcn_permlane32_swap(__float_as_uint(mx), __float_as_uint(mx), false, false); mx = fmaxf(__uint_as_float(rr[0]), __uint_as_float(rr[1])); }
            if (__any(mx > m + 8.f)) {
                const float mn = fmaxf(m, mx), alpha = fast_exp2(m - mn); m = mn; l *= alpha;
#pragma unroll
                for (int d = 0; d < NDB; ++d)
#pragma unroll
                    for (int i = 0; i < 16; ++i) o[d][i] *= alpha;
            }
            float sum = 0.f;
            if (DUMMY != 3) {
#pragma unroll
            for (int i = 0; i < 16; ++i) { p0[i] = fast_exp2(p0[i] - m); p1[i] = fast_exp2(p1[i] - m); }
            { f32x2 sa = {p0[0], p0[1]}, sb = {p1[0], p1[1]};
#pragma unroll
              for (int i = 2; i < 16; i += 2) { sa += (f32x2){p0[i], p0[i + 1]}; sb += (f32x2){p1[i], p1[i + 1]}; }
              sa += sb; sum = sa[0] + sa[1]; }
            } else sum = 1.f;
            l += sum;
            bf16x8 pb[4];
#pragma unroll
            for (int s = 0; s < 4; ++s) { u32x4 w;
#pragma unroll
                for (int q2 = 0; q2 < 4; ++q2) { const int i = 8 * (s & 1) + 2 * q2; w[q2] = (s < 2) ? cvt_pk_bf16(p0[i], p0[i + 1]) : cvt_pk_bf16(p1[i], p1[i + 1]); }
                pb[s] = __builtin_bit_cast(bf16x8, w); }
            __builtin_amdgcn_sched_barrier(0);
            if (DUMMY == 2) { o[0][0] += __builtin_bit_cast(float, (int)pb[0][0] | ((int)pb[1][1] << 8) | ((int)pb[2][2] << 16) ^ (int)pb[3][3]); }
            else
#pragma unroll
            for (int d = 0; d < NDB; ++d) {
                if (d + 1 < NDB) {
#pragma unroll
                    for (int s2 = 0; s2 < 4; ++s2) { vlo[d + 1][s2] = vtr(Vs + (16 * s2) * VROW + 64 * (d + 1)); vhi[d + 1][s2] = vtr(Vs + (16 * s2 + 8) * VROW + 64 * (d + 1)); }
                }
                __builtin_amdgcn_sched_barrier(0);
#pragma unroll
                for (int s2 = 0; s2 < 4; ++s2) { const bf16x8 av = __builtin_shufflevector(vlo[d][s2], vhi[d][s2], 0, 1, 2, 3, 4, 5, 6, 7); o[d] = MFMA32(av, pb[s2], o[d]); }
                __builtin_amdgcn_sched_barrier(0);
            }
        }
        if (j + 1 < nt) ATT_STORE(cur ^ 1);
        __syncthreads();
        if (j + 2 < nt) ATT_LOAD(j + 2);
    }
#undef ATT_LOAD
#undef ATT_STORE
    __builtin_amdgcn_s_setprio(0);
    { const auto rr = __builtin_amdgcn_permlane32_swap(__float_as_uint(l), __float_as_uint(l), false, false); l = __uint_as_float(rr[0]) + __uint_as_float(rr[1]); }
    const float inv = 1.f / l;
    bf16_t* orow = a.O + (size_t)(wid * 32 + r) * a.ldo;
#pragma unroll
    for (int d = 0; d < NDB; ++d)
#pragma unroll
        for (int g = 0; g < 4; ++g) { f32x4 v = {o[d][4 * g] * inv, o[d][4 * g + 1] * inv, o[d][4 * g + 2] * inv, o[d][4 * g + 3] * inv};
            if (!DUMMY || inv < 0.f) *(u32x2*)(orow + 32 * d + 8 * g + 4 * h) = pack4(v); }
}

DI void conv_unit(LAS unsigned char* lds, const bf16_t* Y, int row_base, int seqlen, int t0, const float* wdw, const float* bdw, const float* lng, const float* lnb, bf16_t* out) {
    int c = threadIdx.x; asm volatile("" : "+v"(c));
    const int lane = c & 63, wid = c >> 6;
    float in[62];
#pragma unroll
    for (int i = 0; i < 62; ++i) { const int t = t0 - 15 + i; in[i] = (t >= 0 && t < seqlen) ? bf2f(Y[(size_t)(row_base + t) * 512 + c]) : 0.f; }
    float w[31];
#pragma unroll
    for (int j = 0; j < 31; ++j) w[j] = wdw[j * 512 + c];
    const float bias = bdw[c];
    LAS float* buf = (LAS float*)lds;
    __syncthreads();
#pragma unroll
    for (int t = 0; t < 32; ++t) { float acc = bias;
#pragma unroll
        for (int j = 0; j < 31; ++j) acc += w[j] * in[t + j];
        buf[t * 516 + c] = acc; }
    __syncthreads();
#pragma unroll
    for (int tt = 0; tt < 4; ++tt) { const int t = wid * 4 + tt;
        const f32x4 v0 = *(const LAS f32x4*)(buf + t * 516 + lane * 8), v1 = *(const LAS f32x4*)(buf + t * 516 + lane * 8 + 4);
        const float mean = wave_sum((v0[0] + v0[1]) + (v0[2] + v0[3]) + (v1[0] + v1[1]) + (v1[2] + v1[3])) * (1.f / 512.f);
        const f32x4 d0 = v0 - mean, d1 = v1 - mean;
        const float var = wave_sum((d0[0] * d0[0] + d0[1] * d0[1]) + (d0[2] * d0[2] + d0[3] * d0[3]) + (d1[0] * d1[0] + d1[1] * d1[1]) + (d1[2] * d1[2] + d1[3] * d1[3])) * (1.f / 512.f);
        const float rstd = 1.f / sqrtf(var + 1e-5f);
        const f32x4 g0 = *(const f32x4*)(lng + lane * 8), g1 = *(const f32x4*)(lng + lane * 8 + 4), b0 = *(const f32x4*)(lnb + lane * 8), b1 = *(const f32x4*)(lnb + lane * 8 + 4);
        f32x4 y0 = d0 * rstd * g0 + b0, y1 = d1 * rstd * g1 + b1;
#pragma unroll
        for (int j = 0; j < 4; ++j) { y0[j] = y0[j] * sigmoid_f(y0[j]); y1[j] = y1[j] * sigmoid_f(y1[j]); }
        u32x4 wv; wv.x = cvt_pk_bf16(y0[0], y0[1]); wv.y = cvt_pk_bf16(y0[2], y0[3]); wv.z = cvt_pk_bf16(y1[0], y1[1]); wv.w = cvt_pk_bf16(y1[2], y1[3]);
        *(u32x4*)(out + (size_t)(row_base + t0 + t) * 1024 + 512 + lane * 8) = wv; }
}


#define XB_TMO      128
#define XB_XCNT(j)  (256  + 64 * (j))
#define XB_XSUB(j)  (1280 + 64 * (j))
#define XB_XGEN(j)  (2304 + 64 * (j))
#define XB_TOP      3328
#define XB_TOPGEN   3392
#define XCD_BAR_WORDS 3456
#define XB_SPIN_CAP (1u << 22)
DI unsigned xb_ld(unsigned* p)              { return __hip_atomic_load(p, __ATOMIC_RELAXED, __HIP_MEMORY_SCOPE_AGENT); }
DI unsigned xb_add(unsigned* p, unsigned v) { return __hip_atomic_fetch_add(p, v, __ATOMIC_RELAXED, __HIP_MEMORY_SCOPE_AGENT); }
DI unsigned xb_xcc_id() { return (unsigned)__builtin_amdgcn_s_getreg((3 << 11) | 20) & 0xFu; }
#define XB_SPIN(cond, bar) do { unsigned _sp = 0; while (cond) { __builtin_amdgcn_s_sleep(1); \
    if ((++_sp & 255u) == 0u) { if (xb_ld(&(bar)[XB_TMO])) break; if (_sp > XB_SPIN_CAP) { atomicAdd(&(bar)[XB_TMO], 1u); break; } } } } while (0)
struct XcdBarrier { unsigned* bar; unsigned x; volatile LAS unsigned* st; };
DI XcdBarrier xcd_barrier_post(unsigned* bar, volatile LAS unsigned* st) {
    XcdBarrier b; b.bar = bar; b.x = xb_xcc_id(); b.st = st;
    if (threadIdx.x == 0) (void)xb_add(&bar[XB_XCNT(b.x)], 1u);
    return b;
}
DI void xcd_barrier_complete(unsigned* bar, unsigned x, unsigned& nloc, unsigned& nx) {
    const unsigned G = gridDim.x * gridDim.y * gridDim.z;
    unsigned sum, cnt, mine, sp = 0u;
    for (;;) {
        sum = 0u; cnt = 0u; mine = 0u;
#pragma unroll
        for (unsigned j = 0; j < 16; ++j) { const unsigned c = xb_ld(&bar[XB_XCNT(j)]); sum += c; cnt += (c > 0u) ? 1u : 0u; mine = (j == x) ? c : mine; }
        if (sum == G) break;
        __builtin_amdgcn_s_sleep(1);
        if ((++sp & 255u) == 0u) { if (xb_ld(&bar[XB_TMO])) break; if (sp > XB_SPIN_CAP) { atomicAdd(&bar[XB_TMO], 1u); break; } }
    }
    nloc = mine > 0u ? mine : 1u; nx = cnt > 0u ? cnt : 1u;
}
DI void xcd_barrier(const XcdBarrier& b) {
    asm volatile("s_waitcnt vmcnt(0)" ::: "memory");
    __syncthreads();
    if (threadIdx.x == 0) {
        unsigned* bar = b.bar;
        __builtin_amdgcn_s_waitcnt(0);
        unsigned nloc = b.st[0], nx = b.st[1];
        if (nloc == 0u) { xcd_barrier_complete(bar, b.x, nloc, nx); b.st[0] = nloc; b.st[1] = nx; }
        const unsigned old = xb_add(&bar[XB_XSUB(b.x)], 1u);
        const unsigned gen = old / nloc;
        if (old + 1u == (gen + 1u) * nloc) {
            __builtin_amdgcn_fence(__ATOMIC_RELEASE, "agent");
            asm volatile("s_waitcnt vmcnt(0)" ::: "memory");
            const unsigned og = xb_add(&bar[XB_TOP], 1u);
            const unsigned tg = og / nx;
            if (og + 1u == (tg + 1u) * nx) xb_add(&bar[XB_TOPGEN], 1u);
            else XB_SPIN(xb_ld(&bar[XB_TOPGEN]) == tg, bar);
            __builtin_amdgcn_fence(__ATOMIC_ACQUIRE, "agent");
            xb_add(&bar[XB_XGEN(b.x)], 1u);
            asm volatile("s_waitcnt vmcnt(0)" ::: "memory");
        } else {
            XB_SPIN(xb_ld(&bar[XB_XGEN(b.x)]) == gen, bar);
            __builtin_amdgcn_fence(__ATOMIC_ACQUIRE, "agent");
            asm volatile("s_waitcnt vmcnt(0)" ::: "memory");
        }
    }
    __syncthreads();
}

struct Job { const float* src; bf16_t* dst; int K, N, ldd, map, row_off, item0; };
constexpr int NJOBS = 16;
struct Args {
    const float* in[25]; float* out; unsigned char* ws;
    Job jobs[NJOBS]; int nitems; int pad;
};

DI int job_rowmap(int map, int row_off, int n0) {
    if (map == 1) return n0 < D_FF ? 256 * (n0 / 128) + (n0 % 128) : 256 * ((n0 - D_FF) / 128) + 128 + ((n0 - D_FF) % 128);
    if (map == 2) return n0 < 768 ? n0 : (n0 < 1280 ? 768 + 256 * ((n0 - 768) / 128) + ((n0 - 768) % 128) : 768 + 256 * ((n0 - 1280) / 128) + 128 + ((n0 - 1280) % 128));
    return row_off + n0;
}
DI void transpose_item(const Job& jb, LAS float* scr, int item, int lane) {
    const int nblk = jb.N / 32, kb = item / nblk, nb = item % nblk, k0 = 64 * kb, n0 = 32 * nb;
    const float* W = jb.src; const int N = jb.N;
    float wv[32];
#pragma unroll
    for (int i = 0; i < 32; ++i) { const int kk = 2 * i + (lane >> 5); wv[i] = W[(size_t)(k0 + kk) * N + n0 + (lane & 31)]; }
#pragma unroll
    for (int i = 0; i < 32; ++i) { const int kk = 2 * i + (lane >> 5); scr[kk * 33 + (lane & 31)] = wv[i]; }
    asm volatile("s_waitcnt lgkmcnt(0)" ::: "memory");
    const int c = lane & 7;
    const int drow0 = job_rowmap(jb.map, jb.row_off, n0);
    const int kd0 = (jb.map == 3) ? (k0 / 128) * 192 + (k0 % 128) : k0;
#pragma unroll
    for (int j = 0; j < 4; ++j) { const int n = (lane >> 3) + 8 * j; const LAS float* s = scr + (8 * c) * 33 + n;
        u32x4 o; o.x = cvt_pk_bf16(s[0 * 33], s[1 * 33]); o.y = cvt_pk_bf16(s[2 * 33], s[3 * 33]); o.z = cvt_pk_bf16(s[4 * 33], s[5 * 33]); o.w = cvt_pk_bf16(s[6 * 33], s[7 * 33]);
        *(u32x4*)(jb.dst + (size_t)(drow0 + n) * jb.ldd + kd0 + 8 * c) = o; }
    asm volatile("s_waitcnt lgkmcnt(0)" ::: "memory");
}

template <bool SRCF32>
DI void norm_mod_row(const void* xrow, const float* g, const float* shift, const float* scale, bf16_t* orow, int lane, const bf16_t* addp, bf16_t* wb) {
    f32x4 v[4]; float s = 0.f;
#pragma unroll
    for (int j = 0; j < 2; ++j) { const int c = 8 * (lane + 64 * j);
        if (SRCF32) { v[2 * j] = *(const f32x4*)((const float*)xrow + c); v[2 * j + 1] = *(const f32x4*)((const float*)xrow + c + 4); }
        else unpack8h(*(const u32x4*)((const bf16_t*)xrow + c), v[2 * j], v[2 * j + 1]); }
    if (addp) {
#pragma unroll
        for (int j = 0; j < 2; ++j) { const int c = 8 * (lane + 64 * j);
#pragma unroll
            for (int q = 0; q < 3; ++q) { f32x4 a0, a1; unpack8(*(const u32x4*)(addp + (size_t)q * MH * D_MODEL + c), a0, a1); v[2 * j] = v[2 * j] + a0; v[2 * j + 1] = v[2 * j + 1] + a1; }
            *(u32x4*)(wb + c) = pack8h(v[2 * j], v[2 * j + 1]); } }
#pragma unroll
    for (int j = 0; j < 4; ++j) s += (v[j][0] * v[j][0] + v[j][1] * v[j][1]) + (v[j][2] * v[j][2] + v[j][3] * v[j][3]);
    const float rstd = 1.f / sqrtf(wave_sum(s) * (1.f / D_MODEL) + 1e-6f);
#pragma unroll
    for (int j = 0; j < 2; ++j) { const int c = 8 * (lane + 64 * j);
        const f32x4 y0 = (v[2 * j] * rstd * *(const f32x4*)(g + c)) * (*(const f32x4*)(scale + c) + 1.f) + *(const f32x4*)(shift + c);
        const f32x4 y1 = (v[2 * j + 1] * rstd * *(const f32x4*)(g + c + 4)) * (*(const f32x4*)(scale + c + 4) + 1.f) + *(const f32x4*)(shift + c + 4);
        *(u32x4*)(orow + c) = pack8(y0, y1); }
}

__global__ void __launch_bounds__(512, 2) fwd_kernel(Args args) {
    extern __shared__ __attribute__((aligned(16))) unsigned char lds_raw[];
    LAS unsigned char* lds = (LAS unsigned char*)lds_raw;
    cg::grid_group grid = cg::this_grid();
    const int G = gridDim.x, bx = blockIdx.x;
    const int vcu = (G % 8 == 0) ? (bx % 8) * (G / 8) + bx / 8 : bx;
    const int NGW = G * 8;
#define FRESH_IDS int tid = threadIdx.x; asm volatile("" : "+v"(tid)); const int lane = tid & 63, wave = __builtin_amdgcn_readfirstlane(tid >> 6); const int gw = vcu * 8 + wave; (void)lane; (void)gw;
    unsigned char* ws = args.ws;
    const float* x_in = args.in[0]; const float* c_in = args.in[1]; const float* ctx_in = args.in[2]; const float* cctx_in = args.in[3];
    const float* w_mod = args.in[4]; const float* b_mod = args.in[5]; const float* g_norm = args.in[6];
    const float* a_sink = args.in[10]; const float* b_w_dw = args.in[11]; const float* b_b_dw = args.in[12]; const float* b_ln_g = args.in[13]; const float* b_ln_b = args.in[14];
    const float* c_g_q = args.in[17]; const float* c_g_kv = args.in[20]; const float* g_final = args.in[24];
    float* rope = (float*)(ws + WS_ROPE); float* mod = (float*)(ws + WS_MOD);
    bf16_t* xs = (bf16_t*)(ws + WS_XS);
    unsigned char* R = ws + WS_R;

    volatile LAS unsigned* bar_st = (volatile LAS unsigned*)(lds + 131072);
    unsigned* bar_words = (unsigned*)(ws + WS_BAR);
    {
        FRESH_IDS
        if (tid < 2) bar_st[tid] = 0u;
        if (bx == 0) for (int i = tid; i < XCD_BAR_WORDS; i += 512) bar_words[i] = 0u;
        LAS float* scr = (LAS float*)(lds + wave * 8704);
        for (int rep = 0; rep < (PROBE == 6 ? 2 : 1); ++rep) {
        __syncthreads();
        for (int it = gw; it < args.nitems; it += NGW) {
            int ji = 0;
#pragma unroll
            for (int q = 1; q < NJOBS; ++q) if (it >= args.jobs[q].item0) ji = q;
            Job jb = args.jobs[0];
#pragma unroll
            for (int q = 1; q < NJOBS; ++q) if (ji == q) jb = args.jobs[q];
            transpose_item(jb, scr, it - jb.item0, lane);
        }
        { bf16_t* wd = (bf16_t*)(ws + WS_WD) + (size_t)576 * 1024; const int n16 = 192 * 1024 / 8;
          for (int i = bx * 512 + tid; i < n16; i += G * 512) ((u32x4*)wd)[i] = (u32x4){0u, 0u, 0u, 0u};
 }
        for (int i = bx * 512 + tid; i < SEQ * 32; i += G * 512) { const int t = i >> 5, ai = i & 31, a = ai >> 4, ii = ai & 15;
            const float inv_freq = powf(10000.0f, -(float)(2 * ii) / 32.0f); const float pos = a == 0 ? (float)(t >> 6) : (float)(t & 63); const float ang = pos * inv_freq;
            rope[2 * i] = cosf(ang); rope[2 * i + 1] = sinf(ang); }
        __syncthreads();
        LAS float* sl = (LAS float*)lds;
        LAS float* red = (LAS float*)(lds + 17 * 1024 * 4);
        for (int i = tid; i < 17 * 1024; i += 512) { const float v = i < 16 * 1024 ? c_in[i] : cctx_in[i - 16 * 1024]; sl[i] = v / (1.f + expf(-v)); }
        __syncthreads();
        const int ks = tid >> 5, col = tid & 31;
        for (int u = vcu; u < 2 * (NMOD / 32); u += G) { const int l = u / (NMOD / 32), c0 = (u % (NMOD / 32)) * 32;
            float acc[17];
#pragma unroll
            for (int r = 0; r < 17; ++r) acc[r] = 0.f;
            const float* wp = w_mod + (size_t)l * D_MODEL * NMOD + (size_t)(ks * 64) * NMOD + c0 + col;
#pragma unroll 4
            for (int k = 0; k < 64; ++k) { const float wv = wp[(size_t)k * NMOD];
#pragma unroll
                for (int r = 0; r < 17; ++r) acc[r] += sl[r * 1024 + ks * 64 + k] * wv; }
#pragma unroll
            for (int r = 0; r < 17; ++r) red[(ks * 17 + r) * 32 + col] = acc[r];
            __syncthreads();
            for (int i = tid; i < 17 * 32; i += 512) { const int r = i >> 5, cc = i & 31; float s = b_mod[l * NMOD + c0 + cc];
#pragma unroll
                for (int q = 0; q < 16; ++q) s += red[(q * 17 + r) * 32 + cc];
                mod[((size_t)l * 17 + r) * NMOD + c0 + cc] = s; }
            __syncthreads();
        }
        }
    }
    grid.sync();
    const XcdBarrier xbar = xcd_barrier_post(bar_words, bar_st);
#define GSYNC() xcd_barrier(xbar)

#define NORM_PHASE(F32, LAYER, WHICH, SRCX, SRCH, DST, MROWS) do { FRESH_IDS \
        const float* g_ = g_norm + ((LAYER) * 3 + (WHICH)) * D_MODEL; const float* modl_ = mod + (size_t)(LAYER) * 17 * NMOD + (size_t)(3 * (WHICH)) * D_MODEL; \
        for (int row_ = gw; row_ < (MROWS); row_ += NGW) { const int mi_ = row_ < MX ? row_ / SEQ : 16; \
            const void* xr_ = row_ < MX ? (const void*)((SRCX) + (size_t)row_ * D_MODEL) : (const void*)((SRCH) + (size_t)(row_ - MX) * D_MODEL); \
            norm_mod_row<F32>(xr_, g_, modl_ + (size_t)mi_ * NMOD, modl_ + (size_t)mi_ * NMOD + D_MODEL, (DST) + (size_t)row_ * D_MODEL, lane, (!((LAYER) == 0 && (WHICH) == 0) && row_ >= MX) ? (const bf16_t*)(ws + WS_PART) + (size_t)(row_ - MX) * D_MODEL : (const bf16_t*)nullptr, xs + (size_t)row_ * D_MODEL); } } while (0)

#define FFN_PHASES(F32, LAYER, WHICH, S, SRCX, SRCH, MROWS) do { \
        NORM_PHASE(F32, LAYER, WHICH, SRCX, SRCH, (bf16_t*)(R + R_XN), MROWS); \
        GSYNC(); \
        if (PROBE == 2) { pg8::Gemm g_{(const bf16_t*)(R + R_XN), (const bf16_t*)(ws + WS_WIN + (size_t)((LAYER) * 2 + (S)) * W_IN_BYTES), (MROWS), 2 * D_FF, D_MODEL, D_MODEL, D_MODEL}; \
          pg8::StaticOrder S_; S_.init((MROWS), 2 * D_FF, D_MODEL, G, bx); pg8::EpiSwiglu E_{(bf16_t*)(R + R_ACT), D_FF}; pg8::gemm_phase(lds, g_, S_, E_); GSYNC(); } \
        { pg8::Gemm g_{(const bf16_t*)(R + R_XN), (const bf16_t*)(ws + WS_WIN + (size_t)((LAYER) * 2 + (S)) * W_IN_BYTES), (MROWS), 2 * D_FF, D_MODEL, D_MODEL, D_MODEL}; \
          pg8::StaticOrder S_; S_.init((MROWS), 2 * D_FF, D_MODEL, G, bx); pg8::EpiSwiglu E_{(bf16_t*)(R + R_ACT), D_FF}; pg8::gemm_phase(lds, g_, S_, E_); } \
        GSYNC(); \
        { pg8::Gemm g_{(const bf16_t*)(R + R_ACT), (const bf16_t*)(ws + WS_WOUT + (size_t)((LAYER) * 2 + (S)) * W_OUT_BYTES), (MROWS), D_MODEL, D_FF, D_FF, D_FF}; \
          pg8::EpiResid<F32> E_{(SRCX), (SRCH), xs, mod + (size_t)(LAYER) * 17 * NMOD + (size_t)(3 * (WHICH) + 2) * D_MODEL, (bf16_t*)(ws + WS_PART), 0.5f, 0}; \
          if ((MROWS) == MT) { pg8::SplitOrder S_; S_.init(D_MODEL, D_FF, G, bx); pg8::gemm_phase(lds, g_, S_, E_); } \
          else { pg8::StaticOrder S_; S_.init((MROWS), D_MODEL, D_FF, G, bx); pg8::gemm_phase(lds, g_, S_, E_); } } \
        GSYNC(); if (PROBE == 5) { GSYNC(); GSYNC(); GSYNC(); GSYNC(); GSYNC(); } } while (0)

    const bf16_t* xs_h = xs + (size_t)MX * D_MODEL;
    FFN_PHASES(true, 0, 0, 0, x_in, ctx_in, MT);
    NORM_PHASE(false, 0, 1, xs, xs_h, (bf16_t*)(R + R_XN), MT);
    GSYNC();
    { pg8::Gemm g_{(const bf16_t*)(R + R_XN), (const bf16_t*)(ws + WS_WABIN), MT, 1792, D_MODEL, D_MODEL, D_MODEL};
      pg8::StaticOrder S_; S_.init(MT, 1792, D_MODEL, G, bx);
      pg8::EpiABIn E_{(bf16_t*)(R + R_Q), (bf16_t*)(R + R_KV), (bf16_t*)(R + R_Y), rope, 0.125f * LOG2E}; pg8::gemm_phase(lds, g_, S_, E_); }
    GSYNC();
    {
        const bf16_t* Qb = (const bf16_t*)(R + R_Q); const bf16_t* KVb = (const bf16_t*)(R + R_KV); bf16_t* cat = (bf16_t*)(R + R_CAT);
        for (int rep = 0; rep < (PROBE == 4 ? 2 : 1); ++rep) {
        const int apw = (1152 + G - 1) / G;
        const bool bal = (G == 256);
        for (int ui = 0; ui < (bal ? 5 : apw); ++ui) {
            int u = bal ? (ui < 4 ? vcu * 4 + ui : (vcu < 128 ? 1024 + vcu : 1152)) : vcu * apw + ui;
            if (u >= 1152) break;
            AttnU a; int b, hq;
            if (u < 1024) { b = u >> 6; hq = (u >> 3) & 7; const int qb = u & 7; const int q0 = qb * 256;
                const int lo = q0 - 128 < 0 ? 0 : q0 - 128, hi = q0 + 384 > SEQ ? SEQ : q0 + 384;
                a.Q = Qb + (size_t)(b * SEQ + q0) * 512 + hq * 64; a.O = cat + (size_t)(b * SEQ + q0) * 1024 + hq * 64;
                a.nt_lat = (hi - lo) / 64; a.lat_row0 = b * SEQ + lo; a.kpos0 = lo; a.qpos0 = q0;
            } else { const int v = u - 1024; b = v >> 3; hq = v & 7;
                a.Q = Qb + (size_t)(MX + b * CTX) * 512 + hq * 64; a.O = cat + (size_t)(MX + b * CTX) * 1024 + hq * 64;
                a.nt_lat = 0; a.lat_row0 = 0; a.kpos0 = 0; a.qpos0 = 0; }
            a.ldq = 512; a.ldo = 1024; const int hkv = hq >> 2;
            a.K1 = KVb + hkv * 64; a.ldk1 = 256; a.K2 = a.K1; a.ldk2 = 256; a.V = KVb + 128 + hkv * 64; a.ldv = 256;
            a.nt_ctx = 4; a.ctx_row0 = MX + b * CTX; a.m0 = a_sink[hq] * LOG2E; a.l0 = 1.f;
            attn_unit<64, 64, 64, true>(lds, a);
        }
        __syncthreads();
        for (int ci = 0; ci < 8; ++ci) { int u = vcu + ci * G; if (bal && ci == 4) { if (vcu < 128) break; u = 1024 + vcu - 128; } if (bal && ci > 4) break; if (u >= 1152) break; int row_base, seqlen, t0;
            if (u < 1024) { row_base = (u >> 6) * SEQ; seqlen = SEQ; t0 = (u & 63) * 32; } else { const int v = u - 1024; row_base = MX + (v >> 3) * CTX; seqlen = CTX; t0 = (v & 7) * 32; }
            conv_unit(lds, (const bf16_t*)(R + R_Y), row_base, seqlen, t0, b_w_dw, b_b_dw, b_ln_g, b_ln_b, cat); }
        }
    }
    GSYNC();
    { pg8::Gemm g_{(const bf16_t*)(R + R_CAT), (const bf16_t*)(ws + WS_WABOUT), MT, D_MODEL, D_MODEL, D_MODEL, D_MODEL};
      pg8::SplitOrder S_; S_.init(D_MODEL, D_MODEL, G, bx);
      pg8::EpiResid<false> E_{xs, xs_h, xs, mod + (size_t)5 * D_MODEL, (bf16_t*)(ws + WS_PART), 1.0f, 0}; pg8::gemm_phase(lds, g_, S_, E_); }
    GSYNC();
    FFN_PHASES(false, 0, 2, 1, xs, xs_h, MT);

    FFN_PHASES(false, 1, 0, 0, xs, xs_h, MT);
    NORM_PHASE(false, 1, 1, xs, xs_h, (bf16_t*)(R + R_XN), MT);
    GSYNC();
    { pg8::Gemm g_{(const bf16_t*)(R + R_XN), (const bf16_t*)(ws + WS_WD), MT, 768, D_MODEL, D_MODEL, D_MODEL};
      pg8::StaticOrder S_; S_.init(MT, 768, D_MODEL, G, bx);
      pg8::EpiPlain E_{(bf16_t*)(R + R_D), (bf16_t*)(R + R_D), 1000, LDD, LDD}; pg8::gemm_phase(lds, g_, S_, E_); }
    GSYNC();
    {
        FRESH_IDS
        bf16_t* Db = (bf16_t*)(R + R_D);
        for (int row = gw; row < MT; row += NGW) { bf16_t* dr = Db + (size_t)row * LDD;
            const u32x2 qa = ((const u32x2*)dr)[lane], ka = ((const u32x2*)(dr + 256))[lane]; const float kr = bf2f(dr[512 + lane]);
            f32x4 q = {__uint_as_float(qa.x << 16), __uint_as_float(qa.x & 0xffff0000u), __uint_as_float(qa.y << 16), __uint_as_float(qa.y & 0xffff0000u)};
            f32x4 k = {__uint_as_float(ka.x << 16), __uint_as_float(ka.x & 0xffff0000u), __uint_as_float(ka.y << 16), __uint_as_float(ka.y & 0xffff0000u)};
            const float rq = 1.f / sqrtf(wave_sum((q[0] * q[0] + q[1] * q[1]) + (q[2] * q[2] + q[3] * q[3])) * (1.f / 256.f) + 1e-6f);
            const float rk = 1.f / sqrtf(wave_sum((k[0] * k[0] + k[1] * k[1]) + (k[2] * k[2] + k[3] * k[3])) * (1.f / 256.f) + 1e-6f);
            q = q * rq * ((const f32x4*)c_g_q)[lane]; k = k * rk * ((const f32x4*)c_g_kv)[lane];
            float kro = kr;
            const float partner = __shfl_xor(kr, 16);
            if (row < MX) { const int t = row & (SEQ - 1); const float cs = rope[(size_t)t * 64 + ((lane >> 5) * 16 + (lane & 15)) * 2], sn = rope[(size_t)t * 64 + ((lane >> 5) * 16 + (lane & 15)) * 2 + 1];
                const float rot = (lane & 16) ? partner : -partner; kro = kr * cs + rot * sn; }
            ((u32x2*)dr)[lane] = pack4(q); ((u32x2*)(dr + 256))[lane] = pack4(k); dr[512 + lane] = (bf16_t)(cvt_pk_bf16(kro, 0.f) & 0xffffu); }
    }
    GSYNC();
    { pg8::Gemm g_{(const bf16_t*)(R + R_D), (const bf16_t*)(ws + WS_WUQ), MX, 1536, 256, LDD, 256};
      pg8::StaticOrder S_; S_.init(MX, 1536, 256, G, bx);
      pg8::EpiUq E_{(bf16_t*)(R + R_Q2), rope, 0.07216878364870322f * LOG2E}; pg8::gemm_phase(lds, g_, S_, E_); }
    { pg8::Gemm g_{(const bf16_t*)(R + R_D) + 256, (const bf16_t*)(ws + WS_WUKV), MT, 2048, 256, LDD, 256};
      pg8::StaticOrder S_; S_.init(MT, 2048, 256, G, bx);
      pg8::EpiPlain E_{(bf16_t*)(R + R_KN), (bf16_t*)(R + R_V), 4, D_MODEL, 1 << 30}; pg8::gemm_phase(lds, g_, S_, E_); }
    GSYNC();
    {
        bf16_t* Q2 = (bf16_t*)(R + R_Q2); const bf16_t* Kn = (const bf16_t*)(R + R_KN); const bf16_t* Db = (const bf16_t*)(R + R_D); const bf16_t* Vb = (const bf16_t*)(R + R_V);
        const int mpw = (1024 + G - 1) / G;
        for (int u = vcu * mpw; u < vcu * mpw + mpw; ++u) { if (u >= 1024) break; const int b = u >> 6, hh = (u >> 3) & 7, qb = u & 7;
            AttnU a; a.Q = Q2 + (size_t)(b * SEQ + qb * 256) * 1536 + hh * 192; a.ldq = 1536; a.O = Q2 + (size_t)(b * SEQ + qb * 256) * 1536 + hh * 192; a.ldo = 1536;
            a.K1 = Kn + hh * 128; a.ldk1 = D_MODEL; a.K2 = Db + 512; a.ldk2 = LDD; a.V = Vb + hh * 128; a.ldv = D_MODEL;
            a.nt_lat = SEQ / 64; a.lat_row0 = b * SEQ; a.kpos0 = 0; a.nt_ctx = 4; a.ctx_row0 = MX + b * CTX; a.qpos0 = 0; a.m0 = -1e30f; a.l0 = 0.f;
            if (PROBE == 1) attn_unit<192, 128, 128, false, 1>(lds, a);
            if (PROBE == 7) attn_unit<192, 128, 128, false, 4>(lds, a);
            if (PROBE == 8) attn_unit<192, 128, 128, false, 3>(lds, a);
            if (PROBE == 9) attn_unit<192, 128, 128, false, 2>(lds, a);
            attn_unit<192, 128, 128, false>(lds, a); }
        __syncthreads();
    }
    GSYNC();
    { pg8::Gemm g_{(const bf16_t*)(R + R_Q2), (const bf16_t*)(ws + WS_WO), MX, D_MODEL, D_MODEL, 1536, D_MODEL, 1};
      pg8::StaticOrder S_; S_.init(MX, D_MODEL, D_MODEL, G, bx);
      pg8::EpiResid<false> E_{xs, xs_h, xs, mod + (size_t)17 * NMOD + (size_t)5 * D_MODEL, (bf16_t*)(ws + WS_PART), 1.0f, 0}; pg8::gemm_phase(lds, g_, S_, E_); }
    GSYNC();
    FFN_PHASES(false, 1, 2, 1, xs, xs_h, MX);
    FRESH_IDS
    for (int row = gw; row < MX; row += NGW) { const bf16_t* xr = xs + (size_t)row * D_MODEL;
        f32x4 v[4]; float sq = 0.f;
#pragma unroll
        for (int j = 0; j < 2; ++j) unpack8h(*(const u32x4*)(xr + 8 * (lane + 64 * j)), v[2 * j], v[2 * j + 1]);
#pragma unroll
        for (int j = 0; j < 4; ++j) sq += (v[j][0] * v[j][0] + v[j][1] * v[j][1]) + (v[j][2] * v[j][2] + v[j][3] * v[j][3]);
        const float rstd = 1.f / sqrtf(wave_sum(sq) * (1.f / D_MODEL) + 1e-6f);
        float* orow = args.out + (size_t)row * D_MODEL;
#pragma unroll
        for (int j = 0; j < 2; ++j) { const int c = 8 * (lane + 64 * j);
            *(f32x4*)(orow + c) = v[2 * j] * rstd * *(const f32x4*)(g_final + c); *(f32x4*)(orow + c + 4) = v[2 * j + 1] * rstd * *(const f32x4*)(g_final + c + 4); } }
}

extern "C" void kernel_launch(void* const* d_in, const int* in_sizes, int n_in, void* d_out, int out_size, void* d_ws, size_t ws_size, hipStream_t stream) {
    static int grid = 0;
    if (grid == 0) {
        if (n_in != 25 || ws_size < WS_END || out_size != MX * D_MODEL) { fprintf(stderr, "kernel_launch: unexpected shapes: n_in %d ws %zu out %d\n", n_in, ws_size, out_size); grid = -1; return; }
        int dev = 0, cus = 0, per_cu = 0;
        if (hipGetDevice(&dev) != hipSuccess || hipDeviceGetAttribute(&cus, hipDeviceAttributeMultiprocessorCount, dev) != hipSuccess) { grid = -1; return; }
        if (hipFuncSetAttribute((const void*)fwd_kernel, hipFuncAttributeMaxDynamicSharedMemorySize, LDS_BYTES) != hipSuccess) { fprintf(stderr, "kernel_launch: hipFuncSetAttribute failed\n"); grid = -1; return; }
        if (hipOccupancyMaxActiveBlocksPerMultiprocessor(&per_cu, (const void*)fwd_kernel, 512, LDS_BYTES) != hipSuccess || per_cu < 1) { fprintf(stderr, "kernel_launch: occupancy query says %d\n", per_cu); per_cu = 1; }
        (void)hipGetLastError();
        grid = cus;
    }
    if (grid < 0) return;
    Args a{};
    for (int i = 0; i < 25; ++i) a.in[i] = (const float*)d_in[i];
    a.out = (float*)d_out; a.ws = (unsigned char*)d_ws;
    unsigned char* ws = (unsigned char*)d_ws;
    int nj = 0, items = 0;
    auto add = [&](const float* src, size_t dst_off, int K, int N, int ldd, int map, int row_off) {
        Job& j = a.jobs[nj++]; j.src = src; j.dst = (bf16_t*)(ws + dst_off); j.K = K; j.N = N; j.ldd = ldd; j.map = map; j.row_off = row_off; j.item0 = items; items += (K / 64) * (N / 32); };
    const float* ffn_w_in = (const float*)d_in[7]; const float* ffn_w_out = (const float*)d_in[8];
    for (int i = 0; i < 4; ++i) add(ffn_w_in + (size_t)i * D_MODEL * 2 * D_FF, WS_WIN + i * W_IN_BYTES, D_MODEL, 2 * D_FF, D_MODEL, 1, 0);
    for (int i = 0; i < 4; ++i) add(ffn_w_out + (size_t)i * D_FF * D_MODEL, WS_WOUT + i * W_OUT_BYTES, D_FF, D_MODEL, D_FF, 0, 0);
    add((const float*)d_in[9], WS_WABIN, D_MODEL, 1792, D_MODEL, 2, 0);
    add((const float*)d_in[15], WS_WABOUT, D_MODEL, D_MODEL, D_MODEL, 0, 0);
    add((const float*)d_in[16], WS_WD, D_MODEL, 256, D_MODEL, 0, 0);
    add((const float*)d_in[19], WS_WD, D_MODEL, 320, D_MODEL, 0, 256);
    add((const float*)d_in[18], WS_WUQ, 256, 1536, 256, 0, 0);
    add((const float*)d_in[21], WS_WUKV, 256, 1024, 256, 0, 0);
    add((const float*)d_in[22], WS_WUKV, 256, 1024, 256, 0, 1024);
    add((const float*)d_in[23], WS_WO, D_MODEL, D_MODEL, D_MODEL, 0, 0);
    a.nitems = items;
    void* kargs[] = {&a};
    hipError_t e = hipLaunchCooperativeKernel((const void*)fwd_kernel, dim3(grid), dim3(512), kargs, LDS_BYTES, stream);
    if (e != hipSuccess) fprintf(stderr, "kernel_launch: cooperative launch failed: %s (grid %d)\n", hipGetErrorString(e), grid);
}
```

```cpp
#include <hip/hip_runtime.h>
#include <hip/hip_cooperative_groups.h>
#include <cstdio>
#include <cstdint>
namespace cg = cooperative_groups;

#define LAS __attribute__((address_space(3)))
#define DI __device__ __forceinline__
typedef unsigned short bf16_t;
typedef short bf16x8 __attribute__((ext_vector_type(8)));
typedef short s16x4 __attribute__((ext_vector_type(4)));
typedef float f32x4 __attribute__((ext_vector_type(4)));
typedef float f32x16 __attribute__((ext_vector_type(16)));
typedef unsigned u32x4 __attribute__((ext_vector_type(4)));
typedef unsigned u32x2 __attribute__((ext_vector_type(2)));

constexpr int D_MODEL = 1024, BATCH = 16, SEQ = 2048, CTX = 256, D_FF = 2816;
constexpr int MX = BATCH * SEQ;
constexpr int MH = BATCH * CTX;
constexpr int MT = MX + MH;
constexpr int NMOD = 9 * D_MODEL;
constexpr float LOG2E = 1.4426950408889634f;

constexpr size_t MiB = 1u << 20;
constexpr size_t WS_ROPE = 0;
constexpr size_t WS_MOD = 512 * 1024;
constexpr size_t WS_BAR = 1792 * 1024;
constexpr size_t WS_W = 2 * MiB;
constexpr size_t W_IN_BYTES = (size_t)2 * D_FF * D_MODEL * 2;
constexpr size_t W_OUT_BYTES = (size_t)D_MODEL * D_FF * 2;
constexpr size_t WS_WIN = WS_W;
constexpr size_t WS_WOUT = WS_WIN + 4 * W_IN_BYTES;
constexpr size_t WS_WABIN = WS_WOUT + 4 * W_OUT_BYTES;
constexpr size_t WS_WABOUT = WS_WABIN + (size_t)1792 * 1024 * 2;
constexpr size_t WS_WD = WS_WABOUT + (size_t)1024 * 1024 * 2;
constexpr size_t WS_WUQ = WS_WD + (size_t)768 * 1024 * 2;
constexpr size_t WS_WUKV = WS_WUQ + (size_t)1536 * 256 * 2;
constexpr size_t WS_WO = WS_WUKV + (size_t)2048 * 256 * 2;
constexpr size_t WS_WEND = WS_WO + (size_t)1024 * 1536 * 2;
static_assert(WS_WEND <= 80 * MiB, "weights");
constexpr size_t WS_XS = 80 * MiB;
constexpr size_t WS_PART = 152 * MiB;
constexpr size_t WS_R = 224 * MiB;
constexpr size_t WS_END = 512 * MiB;
constexpr size_t R_XN = 0;
constexpr size_t R_ACT = 72 * MiB;
constexpr size_t R_PART = 270 * MiB;
constexpr size_t R_CAT = 0;
constexpr size_t R_Q = 72 * MiB;
constexpr size_t R_KV = 108 * MiB;
constexpr size_t R_Y = 126 * MiB;
constexpr size_t R_KN = 0;
constexpr int LDD = 576;
constexpr size_t R_D = 72 * MiB;
constexpr size_t R_Q2 = 113 * MiB;
constexpr size_t R_V = 209 * MiB;
static_assert(R_V + 72 * MiB <= 288 * MiB && R_ACT + 198 * MiB <= 288 * MiB, "R map");

#ifndef PROBE
#define PROBE 0
#endif
constexpr int LDS_BYTES = 135168;

typedef float f32x2c __attribute__((ext_vector_type(2))); typedef __bf16 bf16x2c __attribute__((ext_vector_type(2)));
DI unsigned cvt_pk_bf16(float lo, float hi) { const f32x2c v = {lo, hi}; const bf16x2c b = __builtin_convertvector(v, bf16x2c); return __builtin_bit_cast(unsigned, b); }
DI float bf2f(bf16_t v) { return __uint_as_float((unsigned)v << 16); }
DI float fast_exp2(float x) { return __builtin_amdgcn_exp2f(x); }
DI float fast_rcp(float x) { return __builtin_amdgcn_rcpf(x); }
DI float sigmoid_f(float x) { return fast_rcp(1.f + fast_exp2(-x * LOG2E)); }
DI float wave_sum(float v) {
#pragma unroll
    for (int o = 1; o < 64; o <<= 1) v += __shfl_xor(v, o);
    return v;
}
typedef _Float16 h16x2 __attribute__((ext_vector_type(2)));
DI unsigned cvt_pk_f16(float lo, float hi) { const h16x2 v = {(_Float16)lo, (_Float16)hi}; return __builtin_bit_cast(unsigned, v); }
DI void unpack8h(const u32x4 w, f32x4& a, f32x4& b) {
    const unsigned w0 = w[0], w1 = w[1], w2 = w[2], w3 = w[3];
    const h16x2 p0 = __builtin_bit_cast(h16x2, w0), p1 = __builtin_bit_cast(h16x2, w1), p2 = __builtin_bit_cast(h16x2, w2), p3 = __builtin_bit_cast(h16x2, w3);
    a = (f32x4){(float)p0[0], (float)p0[1], (float)p1[0], (float)p1[1]}; b = (f32x4){(float)p2[0], (float)p2[1], (float)p3[0], (float)p3[1]};
}
DI u32x4 pack8h(const f32x4 a, const f32x4 b) { u32x4 o; o.x = cvt_pk_f16(a[0], a[1]); o.y = cvt_pk_f16(a[2], a[3]); o.z = cvt_pk_f16(b[0], b[1]); o.w = cvt_pk_f16(b[2], b[3]); return o; }
typedef float f32x2 __attribute__((ext_vector_type(2)));
DI float max3f(float a, float b, float c) { return __builtin_fmaxf(__builtin_fmaxf(a, b), c); }
DI void unpack8(const u32x4 w, f32x4& a, f32x4& b) {
    a = (f32x4){__uint_as_float(w.x << 16), __uint_as_float(w.x & 0xffff0000u), __uint_as_float(w.y << 16), __uint_as_float(w.y & 0xffff0000u)};
    b = (f32x4){__uint_as_float(w.z << 16), __uint_as_float(w.z & 0xffff0000u), __uint_as_float(w.w << 16), __uint_as_float(w.w & 0xffff0000u)};
}
DI u32x4 pack8(const f32x4 a, const f32x4 b) { u32x4 o; o.x = cvt_pk_bf16(a[0], a[1]); o.y = cvt_pk_bf16(a[2], a[3]); o.z = cvt_pk_bf16(b[0], b[1]); o.w = cvt_pk_bf16(b[2], b[3]); return o; }
DI u32x2 pack4(f32x4 v) { u32x2 w; w.x = cvt_pk_bf16(v[0], v[1]); w.y = cvt_pk_bf16(v[2], v[3]); return w; }

namespace pg8 {
constexpr int BM = 256, BK = 64, HALF = 128, HTB = HALF * BK * 2, STAGE_BYTES = 8 * HTB, NXCD = 8, WGM = 8;
DI int lds_byte(int r, int c) { const int st = (r >> 4) * 2 + (c >> 5), rr = r & 15, cc = c & 31, ob = rr * 64 + cc * 2; return st * 1024 + (ob ^ (((ob >> 9) & 1) << 5)); }
DI void stage_rc(int b, int& R, int& C) { const int st = b / 1024, sb = b % 1024, swz = sb ^ (((sb >> 9) & 1) << 5); R = (st >> 1) * 16 + swz / 64; C = (st & 1) * 32 + (swz % 64) / 2; }
DI int perm32(int rho) { const int n = rho >> 4, i = rho & 15; return 8 * (i >> 2) + 4 * n + (i & 3); }

struct Unit { int pm, pn, k0, nk, part; };
struct Gemm { const bf16_t* A; const bf16_t* Bt; int M, N, K, lda, ldb; int amode = 0; };

struct StaticOrder {
    int nM, nN, nwg, G, c;
    int ntk;
    DI void init(int M, int N, int K, int G_, int c_) { nM = M / BM; nN = N / BM; nwg = nM * nN; G = G_; c = c_; ntk = K / BK; }
    DI Unit get(int i, bool& ok) const { return at((long)i * G + c, ok); }
    DI Unit at(long L, bool& ok) const {
        Unit u; u.pm = 0; u.pn = 0; u.k0 = 0; u.nk = ntk; u.part = 0; ok = L < nwg; if (!ok) return u;
        int wgid = (int)L; { const int q = nwg / NXCD, r = nwg % NXCD, xcd = wgid % NXCD, off = wgid / NXCD; wgid = (xcd < r ? xcd * (q + 1) : r * (q + 1) + (xcd - r) * q) + off; }
        const int nig = WGM * nN, gid = wgid / nig, fm = gid * WGM, gsz = (nM - fm) < WGM ? (nM - fm) : WGM;
        u.pm = fm + ((wgid % nig) % gsz); u.pn = (wgid % nig) / gsz; return u;
    }
};
struct SplitOrder {
    StaticOrder full; int G, c, ntk;
    DI void init(int N, int K, int G_, int c_) { full.init(MX, N, K, G_, c_); G = G_; c = c_; ntk = K / BK; }
    DI Unit get(int i, bool& ok) const {
        const long L = (long)i * G + c;
        if (L < full.nwg) return full.at(L, ok);
        const int q = (int)(L - full.nwg); ok = q < 256;
        Unit u; u.pm = MX / BM + (q >> 4); u.pn = (q >> 2) & 3; const int part = q & 3; u.part = part;
        if (ntk == 44) { u.k0 = part * 11 + (part & 1); u.nk = 12 - 2 * (part & 1); }
        else { u.nk = ntk / 4; u.k0 = part * u.nk; }
        return u;
    }
};

template <class Epi, class Sched>
DI void gemm_phase(LAS unsigned char* lds, const Gemm g, const Sched& S, const Epi& E) {
    int tid = threadIdx.x; asm volatile("" : "+v"(tid));
    const int wid = __builtin_amdgcn_readfirstlane(tid >> 6), lane = tid & 63, wr = wid >> 2, wc = wid & 3, fr = lane & 15, fq = lane >> 4;
    unsigned voffA[2], voffB[2];
#pragma unroll
    for (int i = 0; i < 2; ++i) { int R, C; stage_rc(tid * 16 + i * 8192, R, C); const int Rb = Epi::PERM ? ((R & ~31) + perm32(R & 31)) : R;
        voffA[i] = (unsigned)(R * g.lda + C) * 2u; voffB[i] = (unsigned)(Rb * g.ldb + C) * 2u; }
    const size_t kstep = (size_t)(BK * 2);
    const size_t hstepA = (size_t)HALF * g.lda * 2, hstepB = (size_t)HALF * g.ldb * 2;
    const size_t tstepA = 2 * hstepA, tstepB = 2 * hstepB;
    const unsigned ldsw = (unsigned)wid * 1024u;
    const int aoff = lds_byte(wr * 64 + fr, fq * 8), boff = lds_byte(wc * 32 + fr, fq * 8);
#define PG8_SA(b, h) (((b) * 2 + (h)) * HTB)
#define PG8_SB(b, h) ((4 + (b) * 2 + (h)) * HTB)
#define PG8_STAGE(bufoff, gbase, voff) do { _Pragma("unroll") for (int _i = 0; _i < 2; ++_i) \
        __builtin_amdgcn_global_load_lds((const unsigned*)((const char*)(gbase) + (voff)[_i]), (LAS unsigned*)(lds + (bufoff) + ldsw + _i * 8192), 16, 0, 0); } while (0)
#define PG8_LDA(dst, b, h) do { _Pragma("unroll") for (int m = 0; m < 4; ++m) _Pragma("unroll") for (int k = 0; k < 2; ++k) dst[m][k] = *(const LAS bf16x8*)(lds + PG8_SA(b, h) + aoff + m * 2048 + k * 1024); } while (0)
#define PG8_LDB(dst, b, h) do { _Pragma("unroll") for (int n = 0; n < 2; ++n) _Pragma("unroll") for (int k = 0; k < 2; ++k) dst[n][k] = *(const LAS bf16x8*)(lds + PG8_SB(b, h) + boff + n * 2048 + k * 1024); } while (0)
#define PG8_MMA(ai, bj, At, Bt) do { __builtin_amdgcn_s_setprio(1); _Pragma("unroll") for (int m = 0; m < 4; ++m) _Pragma("unroll") for (int n = 0; n < 2; ++n) _Pragma("unroll") for (int k = 0; k < 2; ++k) \
        acc[ai][bj][m][n] = __builtin_amdgcn_mfma_f32_16x16x32_bf16(Bt[n][k], At[m][k], acc[ai][bj][m][n], 0, 0, 0); __builtin_amdgcn_s_setprio(0); } while (0)
#define PG8_WAIT_V(n) asm volatile("s_waitcnt vmcnt(" #n ")" ::: "memory")
#define PG8_WAIT_L(n) asm volatile("s_waitcnt lgkmcnt(" #n ")" ::: "memory")
#define PG8_BAR __builtin_amdgcn_s_barrier()
#define PG8_SCHED __builtin_amdgcn_sched_barrier(0)
    int ui = 0; bool ok0;
    Unit cur = S.get(0, ok0), nxt = cur;
    if (!ok0) return;
    f32x4 acc[2][2][4][2];
#pragma unroll
    for (int a = 0; a < 2; ++a)
#pragma unroll
        for (int b = 0; b < 2; ++b)
#pragma unroll
            for (int m = 0; m < 4; ++m)
#pragma unroll
                for (int n = 0; n < 2; ++n) acc[a][b][m][n] = (f32x4){0.f, 0.f, 0.f, 0.f};
    bf16x8 At[4][2], B0[2][2], B1[2][2];
    const char* cA = (const char*)g.A + (size_t)cur.pm * tstepA + (size_t)cur.k0 * kstep; const char* cB = (const char*)g.Bt + (size_t)cur.pn * tstepB + (size_t)cur.k0 * kstep;
    PG8_STAGE(PG8_SB(0, 0), cB, voffB); PG8_STAGE(PG8_SB(0, 1), cB + hstepB, voffB); PG8_STAGE(PG8_SA(0, 0), cA, voffA); PG8_STAGE(PG8_SA(0, 1), cA + hstepA, voffA);
    if (wr == 1) PG8_BAR;
    PG8_WAIT_V(2); PG8_BAR;
    PG8_STAGE(PG8_SB(1, 0), cB + kstep, voffB); PG8_STAGE(PG8_SA(1, 0), cA + kstep, voffA); PG8_STAGE(PG8_SB(1, 1), cB + hstepB + kstep, voffB);
    PG8_WAIT_V(6); PG8_BAR;
    for (;;) {
        bool has_next; nxt = S.get(ui + 1, has_next);
        const char* nA = has_next ? (const char*)g.A + (size_t)nxt.pm * tstepA + (size_t)nxt.k0 * kstep : cA; const char* nB = has_next ? (const char*)g.Bt + (size_t)nxt.pn * tstepB + (size_t)nxt.k0 * kstep : cB;
        const int nt = cur.nk;
        for (int t = 0; t < nt; t += 2) {
            const bool last = (t == nt - 2);
            const char* a1 = cA + (g.amode ? (size_t)(t + 1 + (t >> 1)) * kstep : (size_t)(t + 1) * kstep);
            const char* a2 = last ? nA : cA + (g.amode ? (size_t)(t + 2 + ((t + 2) >> 1)) * kstep : (size_t)(t + 2) * kstep); const char* b2 = last ? nB : cB + (size_t)(t + 2) * kstep;
            const char* a3 = a2 + kstep; const char* b3 = b2 + kstep;
            PG8_LDB(B0, 0, 0); PG8_LDB(B1, 0, 1); PG8_SCHED; PG8_LDA(At, 0, 0); PG8_STAGE(PG8_SA(1, 1), a1 + hstepA, voffA);
            PG8_WAIT_V(8); PG8_WAIT_L(0); PG8_BAR; PG8_MMA(0, 0, At, B0); PG8_MMA(0, 1, At, B1); PG8_BAR; PG8_SCHED;
            PG8_LDA(At, 0, 1); PG8_STAGE(PG8_SB(0, 0), b2, voffB); PG8_STAGE(PG8_SB(0, 1), b2 + hstepB, voffB); PG8_STAGE(PG8_SA(0, 0), a2, voffA);
            PG8_WAIT_V(8); PG8_WAIT_L(0); PG8_BAR; PG8_MMA(1, 0, At, B0); PG8_MMA(1, 1, At, B1); PG8_BAR; PG8_SCHED;
            PG8_LDB(B0, 1, 0); PG8_LDB(B1, 1, 1); PG8_SCHED; PG8_LDA(At, 1, 0); PG8_STAGE(PG8_SA(0, 1), a2 + hstepA, voffA);
            PG8_WAIT_V(8); PG8_WAIT_L(0); PG8_BAR; PG8_MMA(0, 0, At, B0); PG8_MMA(0, 1, At, B1); PG8_BAR; PG8_SCHED;
            PG8_LDA(At, 1, 1); PG8_STAGE(PG8_SB(1, 0), b3, voffB); PG8_STAGE(PG8_SB(1, 1), b3 + hstepB, voffB); PG8_STAGE(PG8_SA(1, 0), a3, voffA);
            PG8_WAIT_V(8); PG8_WAIT_L(0); PG8_BAR; PG8_MMA(1, 0, At, B0); PG8_MMA(1, 1, At, B1); PG8_BAR; PG8_SCHED;
        }
        if (wr == 0) PG8_BAR;
        E(acc, cur, wr, wc, fr, fq);
        if (!has_next) break;
#pragma unroll
        for (int a = 0; a < 2; ++a)
#pragma unroll
            for (int b = 0; b < 2; ++b)
#pragma unroll
                for (int m = 0; m < 4; ++m)
#pragma unroll
                    for (int n = 0; n < 2; ++n) acc[a][b][m][n] = (f32x4){0.f, 0.f, 0.f, 0.f};
        cur = nxt; cA = nA; cB = nB; ++ui;
        if (wr == 1) PG8_BAR;
    }
    PG8_WAIT_V(0);
    PG8_BAR;
#undef PG8_SA
#undef PG8_SB
#undef PG8_STAGE
#undef PG8_LDA
#undef PG8_LDB
#undef PG8_MMA
#undef PG8_WAIT_V
#undef PG8_WAIT_L
#undef PG8_BAR
#undef PG8_SCHED
}

typedef f32x4 Acc[2][2][4][2];

struct EpiPlain {
    static constexpr bool PERM = true;
    bf16_t* O0; bf16_t* O1; int split_tile; int ldc; int ncols_valid;
    DI void operator()(const Acc& acc, const Unit& u, int wr, int wc, int fr, int fq) const {
        asm volatile("" : "+v"(fr), "+v"(fq));
        const int row0 = u.pm * BM + wr * 64 + fr;
        bf16_t* base = O0; int colt = u.pn * BM; if (u.pn >= split_tile) { base = O1; colt -= split_tile * BM; }
        const int col0 = colt + wc * 32 + 8 * fq;
#pragma unroll
        for (int ai = 0; ai < 2; ++ai)
#pragma unroll
            for (int m = 0; m < 4; ++m) { bf16_t* rowp = base + (size_t)(row0 + ai * HALF + m * 16) * ldc + col0;
#pragma unroll
                for (int bj = 0; bj < 2; ++bj) { if (col0 + bj * HALF < ncols_valid) { const f32x4 v0 = acc[ai][bj][m][0], v1 = acc[ai][bj][m][1]; u32x4 w;
                    w.x = cvt_pk_bf16(v0[0], v0[1]); w.y = cvt_pk_bf16(v0[2], v0[3]); w.z = cvt_pk_bf16(v1[0], v1[1]); w.w = cvt_pk_bf16(v1[2], v1[3]);
                    *(u32x4*)(rowp + bj * HALF) = w; } } }
    }
};
struct EpiSwiglu {
    static constexpr bool PERM = true;
    bf16_t* O; int ldc;
    DI void operator()(const Acc& acc, const Unit& u, int wr, int wc, int fr, int fq) const {
        asm volatile("" : "+v"(fr), "+v"(fq));
        const int row0 = u.pm * BM + wr * 64 + fr; const int col0 = u.pn * HALF + wc * 32 + 8 * fq;
#pragma unroll
        for (int ai = 0; ai < 2; ++ai)
#pragma unroll
            for (int m = 0; m < 4; ++m) { bf16_t* rowp = O + (size_t)(row0 + ai * HALF + m * 16) * ldc + col0; float v[8];
#pragma unroll
                for (int n = 0; n < 2; ++n)
#pragma unroll
                    for (int j = 0; j < 4; ++j) { const float gg = acc[ai][0][m][n][j], uu = acc[ai][1][m][n][j]; v[n * 4 + j] = gg * sigmoid_f(gg) * uu; }
                u32x4 w; w.x = cvt_pk_bf16(v[0], v[1]); w.y = cvt_pk_bf16(v[2], v[3]); w.z = cvt_pk_bf16(v[4], v[5]); w.w = cvt_pk_bf16(v[6], v[7]);
                *(u32x4*)rowp = w; }
    }
};
template <bool BASEF32>
struct EpiResid {
    static constexpr bool PERM = true;
    const void* base_x; const void* base_h;
    bf16_t* out; const float* gate;
    bf16_t* part; float coef; int pad_;
    DI void operator()(const Acc& acc, const Unit& u, int wr, int wc, int fr, int fq) const {
        asm volatile("" : "+v"(fr), "+v"(fq));
        const int col0 = u.pn * BM + wc * 32 + 8 * fq;
        const int midx = u.pm < (MX / BM) ? (u.pm >> 3) : 16;
        const float* gp = gate + (size_t)midx * NMOD + col0;
        f32x4 gv[2][2];
#pragma unroll
        for (int bj = 0; bj < 2; ++bj)
#pragma unroll
            for (int n = 0; n < 2; ++n) gv[bj][n] = *(const f32x4*)(gp + bj * HALF + n * 4) * coef;
        if (u.part != 0) {
            bf16_t* pbase = part + (size_t)(u.part - 1) * MH * D_MODEL + (size_t)(u.pm - MX / BM) * BM * D_MODEL;
#pragma unroll
            for (int ai = 0; ai < 2; ++ai)
#pragma unroll
                for (int m = 0; m < 4; ++m) { const size_t off = (size_t)(ai * HALF + wr * 64 + m * 16 + fr) * D_MODEL + col0;
#pragma unroll
                    for (int bj = 0; bj < 2; ++bj) *(u32x4*)(pbase + off + bj * HALF) = pack8(gv[bj][0] * acc[ai][bj][m][0], gv[bj][1] * acc[ai][bj][m][1]); }
            return;
        }
        const size_t tile_off = u.pm < (MX / BM) ? (size_t)u.pm * BM * D_MODEL : (size_t)(u.pm - MX / BM) * BM * D_MODEL;
        const void* bsel = u.pm < (MX / BM) ? base_x : base_h;
        bf16_t* obase = out + (size_t)u.pm * BM * D_MODEL;
        const size_t off0 = (size_t)(wr * 64 + fr) * D_MODEL + col0;
        if (BASEF32) {
#pragma unroll
            for (int ai = 0; ai < 2; ++ai) { f32x4 bb[4][2][2];
#pragma unroll
                for (int m = 0; m < 4; ++m)
#pragma unroll
                    for (int bj = 0; bj < 2; ++bj) { const float* bp = (const float*)bsel + tile_off + off0 + (size_t)(ai * HALF + m * 16) * D_MODEL + bj * HALF; bb[m][bj][0] = *(const f32x4*)bp; bb[m][bj][1] = *(const f32x4*)(bp + 4); }
#pragma unroll
                for (int m = 0; m < 4; ++m)
#pragma unroll
                    for (int bj = 0; bj < 2; ++bj) { const f32x4 x0 = bb[m][bj][0] + gv[bj][0] * acc[ai][bj][m][0], x1 = bb[m][bj][1] + gv[bj][1] * acc[ai][bj][m][1];
                        *(u32x4*)(obase + off0 + (size_t)(ai * HALF + m * 16) * D_MODEL + bj * HALF) = pack8h(x0, x1); } }
        } else {
            u32x4 bb[2][4][2];
#pragma unroll
            for (int ai = 0; ai < 2; ++ai)
#pragma unroll
                for (int m = 0; m < 4; ++m)
#pragma unroll
                    for (int bj = 0; bj < 2; ++bj) bb[ai][m][bj] = *(const u32x4*)((const bf16_t*)bsel + tile_off + off0 + (size_t)(ai * HALF + m * 16) * D_MODEL + bj * HALF);
#pragma unroll
            for (int ai = 0; ai < 2; ++ai)
#pragma unroll
                for (int m = 0; m < 4; ++m)
#pragma unroll
                    for (int bj = 0; bj < 2; ++bj) { f32x4 b0, b1; unpack8h(bb[ai][m][bj], b0, b1);
                        const f32x4 x0 = b0 + gv[bj][0] * acc[ai][bj][m][0], x1 = b1 + gv[bj][1] * acc[ai][bj][m][1];
                        *(u32x4*)(obase + off0 + (size_t)(ai * HALF + m * 16) * D_MODEL + bj * HALF) = pack8h(x0, x1); }
        }
    }
};
DI void rope8(f32x4& x0, f32x4& x1, const float* rt, int fq) {
    const float* cp = rt + 2 * ((8 * fq) & 15);
    const f32x4 A = *(const f32x4*)cp, B = *(const f32x4*)(cp + 4), C = *(const f32x4*)(cp + 8), D = *(const f32x4*)(cp + 12);
    const f32x4 c0 = {A[0], A[2], B[0], B[2]}, s0 = {A[1], A[3], B[1], B[3]}, c1 = {C[0], C[2], D[0], D[2]}, s1 = {C[1], C[3], D[1], D[3]};
    const bool lo = fq < 2;
    f32x4 p0, p1;
#pragma unroll
    for (int j = 0; j < 4; ++j) {
        const auto r0 = __builtin_amdgcn_permlane32_swap(__float_as_uint(x0[j]), __float_as_uint(x0[j]), false, false);
        const auto r1 = __builtin_amdgcn_permlane32_swap(__float_as_uint(x1[j]), __float_as_uint(x1[j]), false, false);
        p0[j] = __uint_as_float(lo ? r0[1] : r0[0]); p1[j] = __uint_as_float(lo ? r1[1] : r1[0]); }
    const float sg = lo ? -1.f : 1.f;
    x0 = x0 * c0 + (p0 * s0) * sg; x1 = x1 * c1 + (p1 * s1) * sg;
}
struct EpiABIn {
    static constexpr bool PERM = true;
    bf16_t* Q; bf16_t* KV; bf16_t* Y; const float* rope; float qscale;
    DI void operator()(const Acc& acc, const Unit& u, int wr, int wc, int fr, int fq) const {
        asm volatile("" : "+v"(fr), "+v"(fq));
        const int rowt = u.pm * BM + wr * 64 + fr; const bool is_x = u.pm < (MX / BM);
        if (u.pn >= 3) {
            const int col0 = (u.pn - 3) * HALF + wc * 32 + 8 * fq;
#pragma unroll
            for (int ai = 0; ai < 2; ++ai)
#pragma unroll
                for (int m = 0; m < 4; ++m) { f32x4 v0, v1;
#pragma unroll
                    for (int j = 0; j < 4; ++j) { v0[j] = acc[ai][0][m][0][j] * sigmoid_f(acc[ai][1][m][0][j]); v1[j] = acc[ai][0][m][1][j] * sigmoid_f(acc[ai][1][m][1][j]); }
                    *(u32x4*)(Y + (size_t)(rowt + ai * HALF + m * 16) * 512 + col0) = pack8(v0, v1); }
        } else {
            const int a = wc & 1;
#pragma unroll
            for (int ai = 0; ai < 2; ++ai)
#pragma unroll
                for (int m = 0; m < 4; ++m) { const int row = rowt + ai * HALF + m * 16; const float* rt = rope + (size_t)(row & (SEQ - 1)) * 64 + a * 32;
#pragma unroll
                    for (int bj = 0; bj < 2; ++bj) { f32x4 x0 = acc[ai][bj][m][0], x1 = acc[ai][bj][m][1];
                        const bool do_rope = is_x && !(u.pn == 2 && bj == 1);
                        if (do_rope) rope8(x0, x1, rt, fq);
                        bf16_t* p;
                        if (u.pn < 2) { x0 = x0 * qscale; x1 = x1 * qscale; p = Q + (size_t)row * 512 + u.pn * BM + bj * HALF + wc * 32 + 8 * fq; }
                        else p = KV + (size_t)row * 256 + bj * HALF + wc * 32 + 8 * fq;
                        *(u32x4*)p = pack8(x0, x1); } }
        }
    }
};
struct EpiUq {
    static constexpr bool PERM = true;
    bf16_t* Q; const float* rope; float qscale;
    DI void operator()(const Acc& acc, const Unit& u, int wr, int wc, int fr, int fq) const {
        asm volatile("" : "+v"(fr), "+v"(fq));
        const int rowt = u.pm * BM + wr * 64 + fr;
#pragma unroll
        for (int ai = 0; ai < 2; ++ai)
#pragma unroll
            for (int m = 0; m < 4; ++m) { const int row = rowt + ai * HALF + m * 16;
#pragma unroll
                for (int bj = 0; bj < 2; ++bj) { const int blk = u.pn * 8 + bj * 4 + wc, bh = blk % 6;
                    f32x4 x0 = acc[ai][bj][m][0], x1 = acc[ai][bj][m][1];
                    if (bh >= 4) rope8(x0, x1, rope + (size_t)(row & (SEQ - 1)) * 64 + (bh - 4) * 32, fq);
                    x0 = x0 * qscale; x1 = x1 * qscale;
                    *(u32x4*)(Q + (size_t)row * 1536 + blk * 32 + 8 * fq) = pack8(x0, x1); } }
    }
};
}

struct AttnU {
    const bf16_t* Q; int ldq;
    const bf16_t* K1; int ldk1;
    const bf16_t* K2; int ldk2;
    const bf16_t* V; int ldv;
    bf16_t* O; int ldo;
    int nt_lat, lat_row0, kpos0, nt_ctx, ctx_row0, qpos0;
    float m0, l0;
};
#define MFMA32(a, b, c) __builtin_amdgcn_mfma_f32_32x32x16_bf16((a), (b), (c), 0, 0, 0)
typedef short v4i16_t __attribute__((ext_vector_type(4)));
DI s16x4 vtr(const LAS unsigned char* p) { return __builtin_bit_cast(s16x4, __builtin_amdgcn_ds_read_tr16_b64_v4i16((LAS v4i16_t*)p)); }
template <int DQK, int NK1, int DV, bool WINDOW, int DUMMY = 0>
DI void attn_unit(LAS unsigned char* lds, const AttnU& a) {
    constexpr int KSB = (DQK + 8) * 2, VROW = DV * 2 + 64, K_BYTES = 64 * KSB, BUF_BYTES = K_BYTES + 64 * VROW;
    constexpr int C1 = NK1 / 8, C2 = (DQK - NK1) / 8, CV = DV / 8;
    constexpr int L1 = C1 / 8, L2 = C2 / 8, LV = CV / 8, NKK = DQK / 16, NDB = DV / 32;
    int tid = threadIdx.x; asm volatile("" : "+v"(tid));
    const int lane = tid & 63, wid = __builtin_amdgcn_readfirstlane(tid >> 6), r = lane & 31, h = lane >> 5;
    bf16x8 qf[NKK];
    { const bf16_t* qrow = a.Q + (size_t)(wid * 32 + r) * a.ldq + 8 * h;
#pragma unroll
      for (int kk = 0; kk < NKK; ++kk) qf[kk] = *(const bf16x8*)(qrow + 16 * kk); }
    f32x16 o[NDB];
#pragma unroll
    for (int d = 0; d < NDB; ++d)
#pragma unroll
        for (int i = 0; i < 16; ++i) o[d][i] = 0.f;
    float m = a.m0, l = (h == 0) ? a.l0 : 0.f;
    const int nt = a.nt_lat + a.nt_ctx;
    u32x4 k1reg[L1 > 0 ? L1 : 1], k2reg[L2 > 0 ? L2 : 1], vreg[LV];
#define ATT_LOAD(j) do { const int grow_ = ((j) < a.nt_lat ? a.lat_row0 + 64 * (j) : a.ctx_row0 + 64 * ((j) - a.nt_lat)); \
        _Pragma("unroll") for (int i_ = 0; i_ < L1; ++i_) { const int x_ = tid + 512 * i_; k1reg[i_] = *(const u32x4*)(a.K1 + (size_t)(grow_ + x_ / C1) * a.ldk1 + (x_ % C1) * 8); } \
        _Pragma("unroll") for (int i_ = 0; i_ < L2; ++i_) { const int x_ = tid + 512 * i_; k2reg[i_] = *(const u32x4*)(a.K2 + (size_t)(grow_ + x_ / (C2 > 0 ? C2 : 1)) * a.ldk2 + (x_ % (C2 > 0 ? C2 : 1)) * 8); } \
        _Pragma("unroll") for (int i_ = 0; i_ < LV; ++i_) { const int x_ = tid + 512 * i_; vreg[i_] = *(const u32x4*)(a.V + (size_t)(grow_ + x_ / CV) * a.ldv + (x_ % CV) * 8); } } while (0)
#define ATT_STORE(buf) do { LAS unsigned char* Kw_ = lds + (buf) * BUF_BYTES; LAS unsigned char* Vw_ = Kw_ + K_BYTES; \
        _Pragma("unroll") for (int i_ = 0; i_ < L1; ++i_) { const int x_ = tid + 512 * i_; *(LAS u32x4*)(Kw_ + (x_ / C1) * KSB + (x_ % C1) * 16) = k1reg[i_]; } \
        _Pragma("unroll") for (int i_ = 0; i_ < L2; ++i_) { const int x_ = tid + 512 * i_; *(LAS u32x4*)(Kw_ + (x_ / (C2 > 0 ? C2 : 1)) * KSB + (C1 + x_ % (C2 > 0 ? C2 : 1)) * 16) = k2reg[i_]; } \
        _Pragma("unroll") for (int i_ = 0; i_ < LV; ++i_) { const int x_ = tid + 512 * i_; *(LAS u32x4*)(Vw_ + (x_ / CV) * VROW + (x_ % CV) * 16) = vreg[i_]; } } while (0)
    if (wid >= 4) __builtin_amdgcn_s_setprio(1);
    ATT_LOAD(0);
    __syncthreads();
    ATT_STORE(0);
    if (nt > 1) ATT_LOAD(1);
    __syncthreads();
    const int qp = a.qpos0 + wid * 32 + r;
    const int voff = (4 * h + ((lane & 15) >> 2)) * VROW + (16 * ((lane >> 4) & 1) + 4 * (lane & 3)) * 2;
    for (int j = 0; j < nt; ++j) {
        const int cur = j & 1;
        LAS unsigned char* Ks = lds + cur * BUF_BYTES; LAS unsigned char* Vs = Ks + K_BYTES + voff;
        bool active = true;
        const bool lat = j < a.nt_lat;
        if (WINDOW && lat) { const int kt = a.kpos0 + 64 * j, qw = a.qpos0 + wid * 32; active = (kt <= qw + 31 + 128) && (kt + 63 >= qw - 128); }
        if (active && DUMMY != 4) {
            f32x16 p0, p1;
#pragma unroll
            for (int i = 0; i < 16; ++i) { p0[i] = 0.f; p1[i] = 0.f; }
            {
                constexpr int KB = 2, NB = NKK / KB;
                bf16x8 ka[2][KB][2];
#pragma unroll
                for (int q = 0; q < KB; ++q) { ka[0][q][0] = *(const LAS bf16x8*)(Ks + r * KSB + q * 32 + h * 16); ka[0][q][1] = *(const LAS bf16x8*)(Ks + (32 + r) * KSB + q * 32 + h * 16); }
#pragma unroll
                for (int b = 0; b < NB; ++b) {
                    if (b + 1 < NB) {
#pragma unroll
                        for (int q = 0; q < KB; ++q) { const int kk = (b + 1) * KB + q;
                            ka[(b + 1) & 1][q][0] = *(const LAS bf16x8*)(Ks + r * KSB + kk * 32 + h * 16); ka[(b + 1) & 1][q][1] = *(const LAS bf16x8*)(Ks + (32 + r) * KSB + kk * 32 + h * 16); }
                    }
                    __builtin_amdgcn_sched_barrier(0);
#pragma unroll
                    for (int q = 0; q < KB; ++q) { p0 = MFMA32(ka[b & 1][q][0], qf[b * KB + q], p0); p1 = MFMA32(ka[b & 1][q][1], qf[b * KB + q], p1); }
                    __builtin_amdgcn_sched_barrier(0);
                }
            }
            constexpr int NDH = 1;
            s16x4 vlo[NDB][4], vhi[NDB][4];
            if (DUMMY != 2) {
#pragma unroll
            for (int d = 0; d < NDH; ++d)
#pragma unroll
                for (int s2 = 0; s2 < 4; ++s2) { vlo[d][s2] = vtr(Vs + (16 * s2) * VROW + 64 * d); vhi[d][s2] = vtr(Vs + (16 * s2 + 8) * VROW + 64 * d); }
            }
            __builtin_amdgcn_sched_barrier(0);
            if (WINDOW && lat) { const int kb = a.kpos0 + 64 * j + 4 * h;
#pragma unroll
                for (int i = 0; i < 16; ++i) { const int d0 = qp - (kb + (i & 3) + 8 * (i >> 2)); const int d1 = d0 - 32;
                    if (d0 > 128 || d0 < -128) p0[i] = -1e30f; if (d1 > 128 || d1 < -128) p1[i] = -1e30f; } }
            float mxa = max3f(p0[0], p0[1], p1[0]), mxb = max3f(p0[2], p0[3], p1[1]); mxa = max3f(mxa, p1[2], p1[3]);
#pragma unroll
            for (int i = 4; i < 16; i += 4) { mxa = max3f(mxa, p0[i], p0[i + 1]); mxb = max3f(mxb, p0[i + 2], p0[i + 3]); mxa = max3f(mxa, p1[i], p1[i + 1]); mxb = max3f(mxb, p1[i + 2], p1[i + 3]); }
            float mx = fmaxf(mxa, mxb);
            { const auto rr = __builtin_amdgcn_permlane32_swap(__float_as_uint(mx), __float_as_uint(mx), false, false); mx = fmaxf(__uint_as_float(rr[0]), __uint_as_float(rr[1])); }
            if (__any(mx > m + 8.f)) {
                const float mn = fmaxf(m, mx), alpha = fast_exp2(m - mn); m = mn; l *= alpha;
#pragma unroll
                for (int d = 0; d < NDB; ++d)
#pragma unroll
                    for (int i = 0; i < 16; ++i) o[d][i] *= alpha;
            }
            float sum = 0.f;
            if (DUMMY != 3) {
#pragma unroll
            for (int i = 0; i < 16; ++i) { p0[i] = fast_exp2(p0[i] - m); p1[i] = fast_exp2(p1[i] - m); }
            { f32x2 sa = {p0[0], p0[1]}, sb = {p1[0], p1[1]};
#pragma unroll
              for (int i = 2; i < 16; i += 2) { sa += (f32x2){p0[i], p0[i + 1]}; sb += (f32x2){p1[i], p1[i + 1]}; }
              sa += sb; sum = sa[0] + sa[1]; }
            } else sum = 1.f;
            l += sum;
            bf16x8 pb[4];
#pragma unroll
            for (int s = 0; s < 4; ++s) { u32x4 w;
#pragma unroll
                for (int q2 = 0; q2 < 4; ++q2) { const int i = 8 * (s & 1) + 2 * q2; w[q2] = (s < 2) ? cvt_pk_bf16(p0[i], p0[i + 1]) : cvt_pk_bf16(p1[i], p1[i + 1]); }
                pb[s] = __builtin_bit_cast(bf16x8, w); }
            __builtin_amdgcn_sched_barrier(0);
            if (DUMMY == 2) { o[0][0] += __builtin_bit_cast(float, (int)pb[0][0] | ((int)pb[1][1] << 8) | ((int)pb[2][2] << 16) ^ (int)pb[3][3]); }
            else
#pragma unroll
            for (int d = 0; d < NDB; ++d) {
                if (d + 1 < NDB) {
#pragma unroll
                    for (int s2 = 0; s2 < 4; ++s2) { vlo[d + 1][s2] = vtr(Vs + (16 * s2) * VROW + 64 * (d + 1)); vhi[d + 1][s2] = vtr(Vs + (16 * s2 + 8) * VROW + 64 * (d + 1)); }
                }
                __builtin_amdgcn_sched_barrier(0);
#pragma unroll
                for (int s2 = 0; s2 < 4; ++s2) { const bf16x8 av = __builtin_shufflevector(vlo[d][s2], vhi[d][s2], 0, 1, 2, 3, 4, 5, 6, 7); o[d] = MFMA32(av, pb[s2], o[d]); }
                __builtin_amdgcn_sched_barrier(0);
            }
        }
        if (j + 1 < nt) ATT_STORE(cur ^ 1);
        __syncthreads();
        if (j + 2 < nt) ATT_LOAD(j + 2);
    }
#undef ATT_LOAD
#undef ATT_STORE
    __builtin_amdgcn_s_setprio(0);
    { const auto rr = __builtin_amdgcn_permlane32_swap(__float_as_uint(l), __float_as_uint(l), false, false); l = __uint_as_float(rr[0]) + __uint_as_float(rr[1]); }
    const float inv = 1.f / l;
    bf16_t* orow = a.O + (size_t)(wid * 32 + r) * a.ldo;
#pragma unroll
    for (int d = 0; d < NDB; ++d)
#pragma unroll
        for (int g = 0; g < 4; ++g) { f32x4 v = {o[d][4 * g] * inv, o[d][4 * g + 1] * inv, o[d][4 * g + 2] * inv, o[d][4 * g + 3] * inv};
            if (!DUMMY || inv < 0.f) *(u32x2*)(orow + 32 * d + 8 * g + 4 * h) = pack4(v); }
}

DI void conv_unit(LAS unsigned char* lds, const bf16_t* Y, int row_base, int seqlen, int t0, const float* wdw, const float* bdw, const float* lng, const float* lnb, bf16_t* out) {
    int c = threadIdx.x; asm volatile("" : "+v"(c));
    const int lane = c & 63, wid = c >> 6;
    float in[62];
#pragma unroll
    for (int i = 0; i < 62; ++i) { const int t = t0 - 15 + i; in[i] = (t >= 0 && t < seqlen) ? bf2f(Y[(size_t)(row_base + t) * 512 + c]) : 0.f; }
    float w[31];
#pragma unroll
    for (int j = 0; j < 31; ++j) w[j] = wdw[j * 512 + c];
    const float bias = bdw[c];
    LAS float* buf = (LAS float*)lds;
    __syncthreads();
#pragma unroll
    for (int t = 0; t < 32; ++t) { float acc = bias;
#pragma unroll
        for (int j = 0; j < 31; ++j) acc += w[j] * in[t + j];
        buf[t * 516 + c] = acc; }
    __syncthreads();
#pragma unroll
    for (int tt = 0; tt < 4; ++tt) { const int t = wid * 4 + tt;
        const f32x4 v0 = *(const LAS f32x4*)(buf + t * 516 + lane * 8), v1 = *(const LAS f32x4*)(buf + t * 516 + lane * 8 + 4);
        const float mean = wave_sum((v0[0] + v0[1]) + (v0[2] + v0[3]) + (v1[0] + v1[1]) + (v1[2] + v1[3])) * (1.f / 512.f);
        const f32x4 d0 = v0 - mean, d1 = v1 - mean;
        const float var = wave_sum((d0[0] * d0[0] + d0[1] * d0[1]) + (d0[2] * d0[2] + d0[3] * d0[3]) + (d1[0] * d1[0] + d1[1] * d1[1]) + (d1[2] * d1[2] + d1[3] * d1[3])) * (1.f / 512.f);
        const float rstd = 1.f / sqrtf(var + 1e-5f);
        const f32x4 g0 = *(const f32x4*)(lng + lane * 8), g1 = *(const f32x4*)(lng + lane * 8 + 4), b0 = *(const f32x4*)(lnb + lane * 8), b1 = *(const f32x4*)(lnb + lane * 8 + 4);
        f32x4 y0 = d0 * rstd * g0 + b0, y1 = d1 * rstd * g1 + b1;
#pragma unroll
        for (int j = 0; j < 4; ++j) { y0[j] = y0[j] * sigmoid_f(y0[j]); y1[j] = y1[j] * sigmoid_f(y1[j]); }
        u32x4 wv; wv.x = cvt_pk_bf16(y0[0], y0[1]); wv.y = cvt_pk_bf16(y0[2], y0[3]); wv.z = cvt_pk_bf16(y1[0], y1[1]); wv.w = cvt_pk_bf16(y1[2], y1[3]);
        *(u32x4*)(out + (size_t)(row_base + t0 + t) * 1024 + 512 + lane * 8) = wv; }
}


#define XB_TMO      128
#define XB_XCNT(j)  (256  + 64 * (j))
#define XB_XSUB(j)  (1280 + 64 * (j))
#define XB_XGEN(j)  (2304 + 64 * (j))
#define XB_TOP      3328
#define XB_TOPGEN   3392
#define XCD_BAR_WORDS 3456
#define XB_SPIN_CAP (1u << 22)
DI unsigned xb_ld(unsigned* p)              { return __hip_atomic_load(p, __ATOMIC_RELAXED, __HIP_MEMORY_SCOPE_AGENT); }
DI unsigned xb_add(unsigned* p, unsigned v) { return __hip_atomic_fetch_add(p, v, __ATOMIC_RELAXED, __HIP_MEMORY_SCOPE_AGENT); }
DI unsigned xb_xcc_id() { return (unsigned)__builtin_amdgcn_s_getreg((3 << 11) | 20) & 0xFu; }
#define XB_SPIN(cond, bar) do { unsigned _sp = 0; while (cond) { __builtin_amdgcn_s_sleep(1); \
    if ((++_sp & 255u) == 0u) { if (xb_ld(&(bar)[XB_TMO])) break; if (_sp > XB_SPIN_CAP) { atomicAdd(&(bar)[XB_TMO], 1u); break; } } } } while (0)
struct XcdBarrier { unsigned* bar; unsigned x; volatile LAS unsigned* st; };
DI XcdBarrier xcd_barrier_post(unsigned* bar, volatile LAS unsigned* st) {
    XcdBarrier b; b.bar = bar; b.x = xb_xcc_id(); b.st = st;
    if (threadIdx.x == 0) (void)xb_add(&bar[XB_XCNT(b.x)], 1u);
    return b;
}
DI void xcd_barrier_complete(unsigned* bar, unsigned x, unsigned& nloc, unsigned& nx) {
    const unsigned G = gridDim.x * gridDim.y * gridDim.z;
    unsigned sum, cnt, mine, sp = 0u;
    for (;;) {
        sum = 0u; cnt = 0u; mine = 0u;
#pragma unroll
        for (unsigned j = 0; j < 16; ++j) { const unsigned c = xb_ld(&bar[XB_XCNT(j)]); sum += c; cnt += (c > 0u) ? 1u : 0u; mine = (j == x) ? c : mine; }
        if (sum == G) break;
        __builtin_amdgcn_s_sleep(1);
        if ((++sp & 255u) == 0u) { if (xb_ld(&bar[XB_TMO])) break; if (sp > XB_SPIN_CAP) { atomicAdd(&bar[XB_TMO], 1u); break; } }
    }
    nloc = mine > 0u ? mine : 1u; nx = cnt > 0u ? cnt : 1u;
}
DI void xcd_barrier(const XcdBarrier& b) {
    asm volatile("s_waitcnt vmcnt(0)" ::: "memory");
    __syncthreads();
    if (threadIdx.x == 0) {
        unsigned* bar = b.bar;
        __builtin_amdgcn_s_waitcnt(0);
        unsigned nloc = b.st[0], nx = b.st[1];
        if (nloc == 0u) { xcd_barrier_complete(bar, b.x, nloc, nx); b.st[0] = nloc; b.st[1] = nx; }
        const unsigned old = xb_add(&bar[XB_XSUB(b.x)], 1u);
        const unsigned gen = old / nloc;
        if (old + 1u == (gen + 1u) * nloc) {
            __builtin_amdgcn_fence(__ATOMIC_RELEASE, "agent");
            asm volatile("s_waitcnt vmcnt(0)" ::: "memory");
            const unsigned og = xb_add(&bar[XB_TOP], 1u);
            const unsigned tg = og / nx;
            if (og + 1u == (tg + 1u) * nx) xb_add(&bar[XB_TOPGEN], 1u);
            else XB_SPIN(xb_ld(&bar[XB_TOPGEN]) == tg, bar);
            __builtin_amdgcn_fence(__ATOMIC_ACQUIRE, "agent");
            xb_add(&bar[XB_XGEN(b.x)], 1u);
            asm volatile("s_waitcnt vmcnt(0)" ::: "memory");
        } else {
            XB_SPIN(xb_ld(&bar[XB_XGEN(b.x)]) == gen, bar);
            __builtin_amdgcn_fence(__ATOMIC_ACQUIRE, "agent");
            asm volatile("s_waitcnt vmcnt(0)" ::: "memory");
        }
    }
    __syncthreads();
}

struct Job { const float* src; bf16_t* dst; int K, N, ldd, map, row_off, item0; };
constexpr int NJOBS = 16;
struct Args {
    const float* in[25]; float* out; unsigned char* ws;
    Job jobs[NJOBS]; int nitems; int pad;
};

DI int job_rowmap(int map, int row_off, int n0) {
    if (map == 1) return n0 < D_FF ? 256 * (n0 / 128) + (n0 % 128) : 256 * ((n0 - D_FF) / 128) + 128 + ((n0 - D_FF) % 128);
    if (map == 2) return n0 < 768 ? n0 : (n0 < 1280 ? 768 + 256 * ((n0 - 768) / 128) + ((n0 - 768) % 128) : 768 + 256 * ((n0 - 1280) / 128) + 128 + ((n0 - 1280) % 128));
    return row_off + n0;
}
DI void transpose_item(const Job& jb, LAS float* scr, int item, int lane) {
    const int nblk = jb.N / 32, kb = item / nblk, nb = item % nblk, k0 = 64 * kb, n0 = 32 * nb;
    const float* W = jb.src; const int N = jb.N;
    float wv[32];
#pragma unroll
    for (int i = 0; i < 32; ++i) { const int kk = 2 * i + (lane >> 5); wv[i] = W[(size_t)(k0 + kk) * N + n0 + (lane & 31)]; }
#pragma unroll
    for (int i = 0; i < 32; ++i) { const int kk = 2 * i + (lane >> 5); scr[kk * 33 + (lane & 31)] = wv[i]; }
    asm volatile("s_waitcnt lgkmcnt(0)" ::: "memory");
    const int c = lane & 7;
    const int drow0 = job_rowmap(jb.map, jb.row_off, n0);
    const int kd0 = (jb.map == 3) ? (k0 / 128) * 192 + (k0 % 128) : k0;
#pragma unroll
    for (int j = 0; j < 4; ++j) { const int n = (lane >> 3) + 8 * j; const LAS float* s = scr + (8 * c) * 33 + n;
        u32x4 o; o.x = cvt_pk_bf16(s[0 * 33], s[1 * 33]); o.y = cvt_pk_bf16(s[2 * 33], s[3 * 33]); o.z = cvt_pk_bf16(s[4 * 33], s[5 * 33]); o.w = cvt_pk_bf16(s[6 * 33], s[7 * 33]);
        *(u32x4*)(jb.dst + (size_t)(drow0 + n) * jb.ldd + kd0 + 8 * c) = o; }
    asm volatile("s_waitcnt lgkmcnt(0)" ::: "memory");
}

template <bool SRCF32>
DI void norm_mod_row(const void* xrow, const float* g, const float* shift, const float* scale, bf16_t* orow, int lane, const bf16_t* addp, bf16_t* wb) {
    f32x4 v[4]; float s = 0.f;
#pragma unroll
    for (int j = 0; j < 2; ++j) { const int c = 8 * (lane + 64 * j);
        if (SRCF32) { v[2 * j] = *(const f32x4*)((const float*)xrow + c); v[2 * j + 1] = *(const f32x4*)((const float*)xrow + c + 4); }
        else unpack8h(*(const u32x4*)((const bf16_t*)xrow + c), v[2 * j], v[2 * j + 1]); }
    if (addp) {
#pragma unroll
        for (int j = 0; j < 2; ++j) { const int c = 8 * (lane + 64 * j);
#pragma unroll
            for (int q = 0; q < 3; ++q) { f32x4 a0, a1; unpack8(*(const u32x4*)(addp + (size_t)q * MH * D_MODEL + c), a0, a1); v[2 * j] = v[2 * j] + a0; v[2 * j + 1] = v[2 * j + 1] + a1; }
            *(u32x4*)(wb + c) = pack8h(v[2 * j], v[2 * j + 1]); } }
#pragma unroll
    for (int j = 0; j < 4; ++j) s += (v[j][0] * v[j][0] + v[j][1] * v[j][1]) + (v[j][2] * v[j][2] + v[j][3] * v[j][3]);
    const float rstd = 1.f / sqrtf(wave_sum(s) * (1.f / D_MODEL) + 1e-6f);
#pragma unroll
    for (int j = 0; j < 2; ++j) { const int c = 8 * (lane + 64 * j);
        const f32x4 y0 = (v[2 * j] * rstd * *(const f32x4*)(g + c)) * (*(const f32x4*)(scale + c) + 1.f) + *(const f32x4*)(shift + c);
        const f32x4 y1 = (v[2 * j + 1] * rstd * *(const f32x4*)(g + c + 4)) * (*(const f32x4*)(scale + c + 4) + 1.f) + *(const f32x4*)(shift + c + 4);
        *(u32x4*)(orow + c) = pack8(y0, y1); }
}

__global__ void __launch_bounds__(512, 2) fwd_kernel(Args args) {
    extern __shared__ __attribute__((aligned(16))) unsigned char lds_raw[];
    LAS unsigned char* lds = (LAS unsigned char*)lds_raw;
    cg::grid_group grid = cg::this_grid();
    const int G = gridDim.x, bx = blockIdx.x;
    const int vcu = (G % 8 == 0) ? (bx % 8) * (G / 8) + bx / 8 : bx;
    const int NGW = G * 8;
#define FRESH_IDS int tid = threadIdx.x; asm volatile("" : "+v"(tid)); const int lane = tid & 63, wave = __builtin_amdgcn_readfirstlane(tid >> 6); const int gw = vcu * 8 + wave; (void)lane; (void)gw;
    unsigned char* ws = args.ws;
    const float* x_in = args.in[0]; const float* c_in = args.in[1]; const float* ctx_in = args.in[2]; const float* cctx_in = args.in[3];
    const float* w_mod = args.in[4]; const float* b_mod = args.in[5]; const float* g_norm = args.in[6];
    const float* a_sink = args.in[10]; const float* b_w_dw = args.in[11]; const float* b_b_dw = args.in[12]; const float* b_ln_g = args.in[13]; const float* b_ln_b = args.in[14];
    const float* c_g_q = args.in[17]; const float* c_g_kv = args.in[20]; const float* g_final = args.in[24];
    float* rope = (float*)(ws + WS_ROPE); float* mod = (float*)(ws + WS_MOD);
    bf16_t* xs = (bf16_t*)(ws + WS_XS);
    unsigned char* R = ws + WS_R;

    volatile LAS unsigned* bar_st = (volatile LAS unsigned*)(lds + 131072);
    unsigned* bar_words = (unsigned*)(ws + WS_BAR);
    {
        FRESH_IDS
        if (tid < 2) bar_st[tid] = 0u;
        if (bx == 0) for (int i = tid; i < XCD_BAR_WORDS; i += 512) bar_words[i] = 0u;
        LAS float* scr = (LAS float*)(lds + wave * 8704);
        for (int rep = 0; rep < (PROBE == 6 ? 2 : 1); ++rep) {
        __syncthreads();
        for (int it = gw; it < args.nitems; it += NGW) {
            int ji = 0;
#pragma unroll
            for (int q = 1; q < NJOBS; ++q) if (it >= args.jobs[q].item0) ji = q;
            Job jb = args.jobs[0];
#pragma unroll
            for (int q = 1; q < NJOBS; ++q) if (ji == q) jb = args.jobs[q];
            transpose_item(jb, scr, it - jb.item0, lane);
        }
        { bf16_t* wd = (bf16_t*)(ws + WS_WD) + (size_t)576 * 1024; const int n16 = 192 * 1024 / 8;
          for (int i = bx * 512 + tid; i < n16; i += G * 512) ((u32x4*)wd)[i] = (u32x4){0u, 0u, 0u, 0u};
 }
        for (int i = bx * 512 + tid; i < SEQ * 32; i += G * 512) { const int t = i >> 5, ai = i & 31, a = ai >> 4, ii = ai & 15;
            const float inv_freq = powf(10000.0f, -(float)(2 * ii) / 32.0f); const float pos = a == 0 ? (float)(t >> 6) : (float)(t & 63); const float ang = pos * inv_freq;
            rope[2 * i] = cosf(ang); rope[2 * i + 1] = sinf(ang); }
        __syncthreads();
        LAS float* sl = (LAS float*)lds;
        LAS float* red = (LAS float*)(lds + 17 * 1024 * 4);
        for (int i = tid; i < 17 * 1024; i += 512) { const float v = i < 16 * 1024 ? c_in[i] : cctx_in[i - 16 * 1024]; sl[i] = v / (1.f + expf(-v)); }
        __syncthreads();
        const int ks = tid >> 5, col = tid & 31;
        for (int u = vcu; u < 2 * (NMOD / 32); u += G) { const int l = u / (NMOD / 32), c0 = (u % (NMOD / 32)) * 32;
            float acc[17];
#pragma unroll
            for (int r = 0; r < 17; ++r) acc[r] = 0.f;
            const float* wp = w_mod + (size_t)l * D_MODEL * NMOD + (size_t)(ks * 64) * NMOD + c0 + col;
#pragma unroll 4
            for (int k = 0; k < 64; ++k) { const float wv = wp[(size_t)k * NMOD];
#pragma unroll
                for (int r = 0; r < 17; ++r) acc[r] += sl[r * 1024 + ks * 64 + k] * wv; }
#pragma unroll
            for (int r = 0; r < 17; ++r) red[(ks * 17 + r) * 32 + col] = acc[r];
            __syncthreads();
            for (int i = tid; i < 17 * 32; i += 512) { const int r = i >> 5, cc = i & 31; float s = b_mod[l * NMOD + c0 + cc];
#pragma unroll
                for (int q = 0; q < 16; ++q) s += red[(q * 17 + r) * 32 + cc];
                mod[((size_t)l * 17 + r) * NMOD + c0 + cc] = s; }
            __syncthreads();
        }
        }
    }
    grid.sync();
    const XcdBarrier xbar = xcd_barrier_post(bar_words, bar_st);
#define GSYNC() xcd_barrier(xbar)

#define NORM_PHASE(F32, LAYER, WHICH, SRCX, SRCH, DST, MROWS) do { FRESH_IDS \
        const float* g_ = g_norm + ((LAYER) * 3 + (WHICH)) * D_MODEL; const float* modl_ = mod + (size_t)(LAYER) * 17 * NMOD + (size_t)(3 * (WHICH)) * D_MODEL; \
        for (int row_ = gw; row_ < (MROWS); row_ += NGW) { const int mi_ = row_ < MX ? row_ / SEQ : 16; \
            const void* xr_ = row_ < MX ? (const void*)((SRCX) + (size_t)row_ * D_MODEL) : (const void*)((SRCH) + (size_t)(row_ - MX) * D_MODEL); \
            norm_mod_row<F32>(xr_, g_, modl_ + (size_t)mi_ * NMOD, modl_ + (size_t)mi_ * NMOD + D_MODEL, (DST) + (size_t)row_ * D_MODEL, lane, (!((LAYER) == 0 && (WHICH) == 0) && row_ >= MX) ? (const bf16_t*)(ws + WS_PART) + (size_t)(row_ - MX) * D_MODEL : (const bf16_t*)nullptr, xs + (size_t)row_ * D_MODEL); } } while (0)

#define FFN_PHASES(F32, LAYER, WHICH, S, SRCX, SRCH, MROWS) do { \
        NORM_PHASE(F32, LAYER, WHICH, SRCX, SRCH, (bf16_t*)(R + R_XN), MROWS); \
        GSYNC(); \
        if (PROBE == 2) { pg8::Gemm g_{(const bf16_t*)(R + R_XN), (const bf16_t*)(ws + WS_WIN + (size_t)((LAYER) * 2 + (S)) * W_IN_BYTES), (MROWS), 2 * D_FF, D_MODEL, D_MODEL, D_MODEL}; \
          pg8::StaticOrder S_; S_.init((MROWS), 2 * D_FF, D_MODEL, G, bx); pg8::EpiSwiglu E_{(bf16_t*)(R + R_ACT), D_FF}; pg8::gemm_phase(lds, g_, S_, E_); GSYNC(); } \
        { pg8::Gemm g_{(const bf16_t*)(R + R_XN), (const bf16_t*)(ws + WS_WIN + (size_t)((LAYER) * 2 + (S)) * W_IN_BYTES), (MROWS), 2 * D_FF, D_MODEL, D_MODEL, D_MODEL}; \
          pg8::StaticOrder S_; S_.init((MROWS), 2 * D_FF, D_MODEL, G, bx); pg8::EpiSwiglu E_{(bf16_t*)(R + R_ACT), D_FF}; pg8::gemm_phase(lds, g_, S_, E_); } \
        GSYNC(); \
        { pg8::Gemm g_{(const bf16_t*)(R + R_ACT), (const bf16_t*)(ws + WS_WOUT + (size_t)((LAYER) * 2 + (S)) * W_OUT_BYTES), (MROWS), D_MODEL, D_FF, D_FF, D_FF}; \
          pg8::EpiResid<F32> E_{(SRCX), (SRCH), xs, mod + (size_t)(LAYER) * 17 * NMOD + (size_t)(3 * (WHICH) + 2) * D_MODEL, (bf16_t*)(ws + WS_PART), 0.5f, 0}; \
          if ((MROWS) == MT) { pg8::SplitOrder S_; S_.init(D_MODEL, D_FF, G, bx); pg8::gemm_phase(lds, g_, S_, E_); } \
          else { pg8::StaticOrder S_; S_.init((MROWS), D_MODEL, D_FF, G, bx); pg8::gemm_phase(lds, g_, S_, E_); } } \
        GSYNC(); if (PROBE == 5) { GSYNC(); GSYNC(); GSYNC(); GSYNC(); GSYNC(); } } while (0)

    const bf16_t* xs_h = xs + (size_t)MX * D_MODEL;
    FFN_PHASES(true, 0, 0, 0, x_in, ctx_in, MT);
    NORM_PHASE(false, 0, 1, xs, xs_h, (bf16_t*)(R + R_XN), MT);
    GSYNC();
    { pg8::Gemm g_{(const bf16_t*)(R + R_XN), (const bf16_t*)(ws + WS_WABIN), MT, 1792, D_MODEL, D_MODEL, D_MODEL};
      pg8::StaticOrder S_; S_.init(MT, 1792, D_MODEL, G, bx);
      pg8::EpiABIn E_{(bf16_t*)(R + R_Q), (bf16_t*)(R + R_KV), (bf16_t*)(R + R_Y), rope, 0.125f * LOG2E}; pg8::gemm_phase(lds, g_, S_, E_); }
    GSYNC();
    {
        const bf16_t* Qb = (const bf16_t*)(R + R_Q); const bf16_t* KVb = (const bf16_t*)(R + R_KV); bf16_t* cat = (bf16_t*)(R + R_CAT);
        for (int rep = 0; rep < (PROBE == 4 ? 2 : 1); ++rep) {
        const int apw = (1152 + G - 1) / G;
        const bool bal = (G == 256);
        for (int ui = 0; ui < (bal ? 5 : apw); ++ui) {
            int u = bal ? (ui < 4 ? vcu * 4 + ui : (vcu < 128 ? 1024 + vcu : 1152)) : vcu * apw + ui;
            if (u >= 1152) break;
            AttnU a; int b, hq;
            if (u < 1024) { b = u >> 6; hq = (u >> 3) & 7; const int qb = u & 7; const int q0 = qb * 256;
                const int lo = q0 - 128 < 0 ? 0 : q0 - 128, hi = q0 + 384 > SEQ ? SEQ : q0 + 384;
                a.Q = Qb + (size_t)(b * SEQ + q0) * 512 + hq * 64; a.O = cat + (size_t)(b * SEQ + q0) * 1024 + hq * 64;
                a.nt_lat = (hi - lo) / 64; a.lat_row0 = b * SEQ + lo; a.kpos0 = lo; a.qpos0 = q0;
            } else { const int v = u - 1024; b = v >> 3; hq = v & 7;
                a.Q = Qb + (size_t)(MX + b * CTX) * 512 + hq * 64; a.O = cat + (size_t)(MX + b * CTX) * 1024 + hq * 64;
                a.nt_lat = 0; a.lat_row0 = 0; a.kpos0 = 0; a.qpos0 = 0; }
            a.ldq = 512; a.ldo = 1024; const int hkv = hq >> 2;
            a.K1 = KVb + hkv * 64; a.ldk1 = 256; a.K2 = a.K1; a.ldk2 = 256; a.V = KVb + 128 + hkv * 64; a.ldv = 256;
            a.nt_ctx = 4; a.ctx_row0 = MX + b * CTX; a.m0 = a_sink[hq] * LOG2E; a.l0 = 1.f;
            attn_unit<64, 64, 64, true>(lds, a);
        }
        __syncthreads();
        for (int ci = 0; ci < 8; ++ci) { int u = vcu + ci * G; if (bal && ci == 4) { if (vcu < 128) break; u = 1024 + vcu - 128; } if (bal && ci > 4) break; if (u >= 1152) break; int row_base, seqlen, t0;
            if (u < 1024) { row_base = (u >> 6) * SEQ; seqlen = SEQ; t0 = (u & 63) * 32; } else { const int v = u - 1024; row_base = MX + (v >> 3) * CTX; seqlen = CTX; t0 = (v & 7) * 32; }
            conv_unit(lds, (const bf16_t*)(R + R_Y), row_base, seqlen, t0, b_w_dw, b_b_dw, b_ln_g, b_ln_b, cat); }
        }
    }
    GSYNC();
    { pg8::Gemm g_{(const bf16_t*)(R + R_CAT), (const bf16_t*)(ws + WS_WABOUT), MT, D_MODEL, D_MODEL, D_MODEL, D_MODEL};
      pg8::SplitOrder S_; S_.init(D_MODEL, D_MODEL, G, bx);
      pg8::EpiResid<false> E_{xs, xs_h, xs, mod + (size_t)5 * D_MODEL, (bf16_t*)(ws + WS_PART), 1.0f, 0}; pg8::gemm_phase(lds, g_, S_, E_); }
    GSYNC();
    FFN_PHASES(false, 0, 2, 1, xs, xs_h, MT);

    FFN_PHASES(false, 1, 0, 0, xs, xs_h, MT);
    NORM_PHASE(false, 1, 1, xs, xs_h, (bf16_t*)(R + R_XN), MT);
    GSYNC();
    { pg8::Gemm g_{(const bf16_t*)(R + R_XN), (const bf16_t*)(ws + WS_WD), MT, 768, D_MODEL, D_MODEL, D_MODEL};
      pg8::StaticOrder S_; S_.init(MT, 768, D_MODEL, G, bx);
      pg8::EpiPlain E_{(bf16_t*)(R + R_D), (bf16_t*)(R + R_D), 1000, LDD, LDD}; pg8::gemm_phase(lds, g_, S_, E_); }
    GSYNC();
    {
        FRESH_IDS
        bf16_t* Db = (bf16_t*)(R + R_D);
        for (int row = gw; row < MT; row += NGW) { bf16_t* dr = Db + (size_t)row * LDD;
            const u32x2 qa = ((const u32x2*)dr)[lane], ka = ((const u32x2*)(dr + 256))[lane]; const float kr = bf2f(dr[512 + lane]);
            f32x4 q = {__uint_as_float(qa.x << 16), __uint_as_float(qa.x & 0xffff0000u), __uint_as_float(qa.y << 16), __uint_as_float(qa.y & 0xffff0000u)};
            f32x4 k = {__uint_as_float(ka.x << 16), __uint_as_float(ka.x & 0xffff0000u), __uint_as_float(ka.y << 16), __uint_as_float(ka.y & 0xffff0000u)};
            const float rq = 1.f / sqrtf(wave_sum((q[0] * q[0] + q[1] * q[1]) + (q[2] * q[2] + q[3] * q[3])) * (1.f / 256.f) + 1e-6f);
            const float rk = 1.f / sqrtf(wave_sum((k[0] * k[0] + k[1] * k[1]) + (k[2] * k[2] + k[3] * k[3])) * (1.f / 256.f) + 1e-6f);
            q = q * rq * ((const f32x4*)c_g_q)[lane]; k = k * rk * ((const f32x4*)c_g_kv)[lane];
            float kro = kr;
            const float partner = __shfl_xor(kr, 16);
            if (row < MX) { const int t = row & (SEQ - 1); const float cs = rope[(size_t)t * 64 + ((lane >> 5) * 16 + (lane & 15)) * 2], sn = rope[(size_t)t * 64 + ((lane >> 5) * 16 + (lane & 15)) * 2 + 1];
                const float rot = (lane & 16) ? partner : -partner; kro = kr * cs + rot * sn; }
            ((u32x2*)dr)[lane] = pack4(q); ((u32x2*)(dr + 256))[lane] = pack4(k); dr[512 + lane] = (bf16_t)(cvt_pk_bf16(kro, 0.f) & 0xffffu); }
    }
    GSYNC();
    { pg8::Gemm g_{(const bf16_t*)(R + R_D), (const bf16_t*)(ws + WS_WUQ), MX, 1536, 256, LDD, 256};
      pg8::StaticOrder S_; S_.init(MX, 1536, 256, G, bx);
      pg8::EpiUq E_{(bf16_t*)(R + R_Q2), rope, 0.07216878364870322f * LOG2E}; pg8::gemm_phase(lds, g_, S_, E_); }
    { pg8::Gemm g_{(const bf16_t*)(R + R_D) + 256, (const bf16_t*)(ws + WS_WUKV), MT, 2048, 256, LDD, 256};
      pg8::StaticOrder S_; S_.init(MT, 2048, 256, G, bx);
      pg8::EpiPlain E_{(bf16_t*)(R + R_KN), (bf16_t*)(R + R_V), 4, D_MODEL, 1 << 30}; pg8::gemm_phase(lds, g_, S_, E_); }
    GSYNC();
    {
        bf16_t* Q2 = (bf16_t*)(R + R_Q2); const bf16_t* Kn = (const bf16_t*)(R + R_KN); const bf16_t* Db = (const bf16_t*)(R + R_D); const bf16_t* Vb = (const bf16_t*)(R + R_V);
        const int mpw = (1024 + G - 1) / G;
        for (int ui = 0; ui < mpw; ++ui) {
            const int u = (G == 256) ? (((vcu >> 3) * 4 + ui) * 8 + (vcu & 7)) : vcu * mpw + ui;
            if (u >= 1024) break; const int b = u >> 6, hh = (u >> 3) & 7, qb = u & 7;
            AttnU a; a.Q = Q2 + (size_t)(b * SEQ + qb * 256) * 1536 + hh * 192; a.ldq = 1536; a.O = Q2 + (size_t)(b * SEQ + qb * 256) * 1536 + hh * 192; a.ldo = 1536;
            a.K1 = Kn + hh * 128; a.ldk1 = D_MODEL; a.K2 = Db + 512; a.ldk2 = LDD; a.V = Vb + hh * 128; a.ldv = D_MODEL;
            a.nt_lat = SEQ / 64; a.lat_row0 = b * SEQ; a.kpos0 = 0; a.nt_ctx = 4; a.ctx_row0 = MX + b * CTX; a.qpos0 = 0; a.m0 = -1e30f; a.l0 = 0.f;
            if (PROBE == 1) attn_unit<192, 128, 128, false, 1>(lds, a);
            if (PROBE == 7) attn_unit<192, 128, 128, false, 4>(lds, a);
            if (PROBE == 8) attn_unit<192, 128, 128, false, 3>(lds, a);
            if (PROBE == 9) attn_unit<192, 128, 128, false, 2>(lds, a);
            attn_unit<192, 128, 128, false>(lds, a); }
        __syncthreads();
    }
    GSYNC();
    { pg8::Gemm g_{(const bf16_t*)(R + R_Q2), (const bf16_t*)(ws + WS_WO), MX, D_MODEL, D_MODEL, 1536, D_MODEL, 1};
      pg8::StaticOrder S_; S_.init(MX, D_MODEL, D_MODEL, G, bx);
      pg8::EpiResid<false> E_{xs, xs_h, xs, mod + (size_t)17 * NMOD + (size_t)5 * D_MODEL, (bf16_t*)(ws + WS_PART), 1.0f, 0}; pg8::gemm_phase(lds, g_, S_, E_); }
    GSYNC();
    FFN_PHASES(false, 1, 2, 1, xs, xs_h, MX);
    FRESH_IDS
    for (int row = gw; row < MX; row += NGW) { const bf16_t* xr = xs + (size_t)row * D_MODEL;
        f32x4 v[4]; float sq = 0.f;
#pragma unroll
        for (int j = 0; j < 2; ++j) unpack8h(*(const u32x4*)(xr + 8 * (lane + 64 * j)), v[2 * j], v[2 * j + 1]);
#pragma unroll
        for (int j = 0; j < 4; ++j) sq += (v[j][0] * v[j][0] + v[j][1] * v[j][1]) + (v[j][2] * v[j][2] + v[j][3] * v[j][3]);
        const float rstd = 1.f / sqrtf(wave_sum(sq) * (1.f / D_MODEL) + 1e-6f);
        float* orow = args.out + (size_t)row * D_MODEL;
#pragma unroll
        for (int j = 0; j < 2; ++j) { const int c = 8 * (lane + 64 * j);
            *(f32x4*)(orow + c) = v[2 * j] * rstd * *(const f32x4*)(g_final + c); *(f32x4*)(orow + c + 4) = v[2 * j + 1] * rstd * *(const f32x4*)(g_final + c + 4); } }
}

extern "C" void kernel_launch(void* const* d_in, const int* in_sizes, int n_in, void* d_out, int out_size, void* d_ws, size_t ws_size, hipStream_t stream) {
    static int grid = 0;
    if (grid == 0) {
        if (n_in != 25 || ws_size < WS_END || out_size != MX * D_MODEL) { fprintf(stderr, "kernel_launch: unexpected shapes: n_in %d ws %zu out %d\n", n_in, ws_size, out_size); grid = -1; return; }
        int dev = 0, cus = 0, per_cu = 0;
        if (hipGetDevice(&dev) != hipSuccess || hipDeviceGetAttribute(&cus, hipDeviceAttributeMultiprocessorCount, dev) != hipSuccess) { grid = -1; return; }
        if (hipFuncSetAttribute((const void*)fwd_kernel, hipFuncAttributeMaxDynamicSharedMemorySize, LDS_BYTES) != hipSuccess) { fprintf(stderr, "kernel_launch: hipFuncSetAttribute failed\n"); grid = -1; return; }
        if (hipOccupancyMaxActiveBlocksPerMultiprocessor(&per_cu, (const void*)fwd_kernel, 512, LDS_BYTES) != hipSuccess || per_cu < 1) { fprintf(stderr, "kernel_launch: occupancy query says %d\n", per_cu); per_cu = 1; }
        (void)hipGetLastError();
        grid = cus;
    }
    if (grid < 0) return;
    Args a{};
    for (int i = 0; i < 25; ++i) a.in[i] = (const float*)d_in[i];
    a.out = (float*)d_out; a.ws = (unsigned char*)d_ws;
    unsigned char* ws = (unsigned char*)d_ws;
    int nj = 0, items = 0;
    auto add = [&](const float* src, size_t dst_off, int K, int N, int ldd, int map, int row_off) {
        Job& j = a.jobs[nj++]; j.src = src; j.dst = (bf16_t*)(ws + dst_off); j.K = K; j.N = N; j.ldd = ldd; j.map = map; j.row_off = row_off; j.item0 = items; items += (K / 64) * (N / 32); };
    const float* ffn_w_in = (const float*)d_in[7]; const float* ffn_w_out = (const float*)d_in[8];
    for (int i = 0; i < 4; ++i) add(ffn_w_in + (size_t)i * D_MODEL * 2 * D_FF, WS_WIN + i * W_IN_BYTES, D_MODEL, 2 * D_FF, D_MODEL, 1, 0);
    for (int i = 0; i < 4; ++i) add(ffn_w_out + (size_t)i * D_FF * D_MODEL, WS_WOUT + i * W_OUT_BYTES, D_FF, D_MODEL, D_FF, 0, 0);
    add((const float*)d_in[9], WS_WABIN, D_MODEL, 1792, D_MODEL, 2, 0);
    add((const float*)d_in[15], WS_WABOUT, D_MODEL, D_MODEL, D_MODEL, 0, 0);
    add((const float*)d_in[16], WS_WD, D_MODEL, 256, D_MODEL, 0, 0);
    add((const float*)d_in[19], WS_WD, D_MODEL, 320, D_MODEL, 0, 256);
    add((const float*)d_in[18], WS_WUQ, 256, 1536, 256, 0, 0);
    add((const float*)d_in[21], WS_WUKV, 256, 1024, 256, 0, 0);
    add((const float*)d_in[22], WS_WUKV, 256, 1024, 256, 0, 1024);
    add((const float*)d_in[23], WS_WO, D_MODEL, D_MODEL, D_MODEL, 0, 0);
    a.nitems = items;
    void* kargs[] = {&a};
    hipError_t e = hipLaunchCooperativeKernel((const void*)fwd_kernel, dim3(grid), dim3(512), kargs, LDS_BYTES, stream);
    if (e != hipSuccess) fprintf(stderr, "kernel_launch: cooperative launch failed: %s (grid %d)\n", hipGetErrorString(e), grid);
}
```
